# Optimizing an MI355X kernel written in HIP

```python
import math
import jax, jax.numpy as jnp
from jax import lax
import numpy as np

D_MODEL = 1024
BATCH = 8
SEQ = 2048
DEPTH = 1
DEC_BATCH = 128
DEC_SEQ = 4
PAST_LEN = 16384
PAGE_SIZE = 128

MIX_WIDTH = D_MODEL
DN_HEADS = 4
DN_DK = 128
DN_DV = 128
DN_WIDTH = DN_HEADS * DN_DV
SC_WIDTH = MIX_WIDTH - DN_WIDTH
SC_GROUPS = 8
DN_CONV = 4
SC_CONV = 3
CHUNK = 64
QKV_DIM = DN_HEADS * (2 * DN_DK + DN_DV)
PROJ_DIM = QKV_DIM + 2 * DN_HEADS + DN_WIDTH + 3 * SC_WIDTH
D_FF = 2816
N_SUB = 3
ALPHA = (2 * DEPTH) ** 0.25
BETA = (8 * DEPTH) ** -0.25
LN_EPS = 1e-5
RMS_EPS = 1e-6

kernel_name = "hymba_gdn_shortconv_macaron_deepnorm_step"


def layer_norm(x, g, b):
    xf = x.astype(jnp.float32)
    mu = jnp.mean(xf, -1, keepdims=True)
    var = jnp.mean(jnp.square(xf - mu), -1, keepdims=True)
    return ((xf - mu) * lax.rsqrt(var + LN_EPS) * g + b).astype(x.dtype)


def swiglu(u, wg, wu, wd):
    return (jax.nn.silu(u @ wg) * (u @ wu)) @ wd


def causal_dwconv(x, buf, w):
    W = w.shape[0]
    T = x.shape[1]
    xp = jnp.concatenate([buf.astype(x.dtype), x], axis=1)
    y = sum(xp[:, j:j + T] * w[j] for j in range(W))
    return y, xp[:, xp.shape[1] - (W - 1):]


def l2norm(x):
    xf = x.astype(jnp.float32)
    return xf * lax.rsqrt(jnp.sum(xf * xf, -1, keepdims=True) + RMS_EPS)


def gated_delta_rule(q, k, v, g, beta, s0):
    B, T, H, _ = q.shape
    C = math.gcd(T, CHUNK)
    N = T // C
    f32 = jnp.float32

    def chunks(a):
        a = a.astype(f32).reshape((B, N, C, H) + a.shape[3:])
        return jnp.moveaxis(a, 3, 1)

    q, k, v, g, beta = chunks(q), chunks(k), chunks(v), chunks(g), chunks(beta)
    gc = jnp.cumsum(g, axis=-1)
    tril = jnp.tril(jnp.ones((C, C), bool))
    strict = jnp.tril(jnp.ones((C, C), bool), -1)
    diff = gc[..., :, None] - gc[..., None, :]
    decay = jnp.where(tril, jnp.exp(jnp.where(tril, diff, 0.0)), 0.0)
    kb = k * beta[..., None]
    L = jnp.where(strict, jnp.einsum('bhnik,bhnjk->bhnij', kb, k) * decay, 0.0)
    eye = jnp.eye(C, dtype=f32)
    Tm = lax.linalg.triangular_solve(eye + L, jnp.broadcast_to(eye, L.shape),
                                     left_side=True, lower=True)
    u = jnp.einsum('bhnij,bhnjv->bhniv', Tm, v * beta[..., None])
    w = jnp.einsum('bhnij,bhnjk->bhnik', Tm, kb * jnp.exp(gc)[..., None])
    qk = jnp.where(tril, jnp.einsum('bhnik,bhnjk->bhnij', q, k) * decay, 0.0)
    q_dec = q * jnp.exp(gc)[..., None]
    k_dec = k * jnp.exp(gc[..., -1:] - gc)[..., None]
    g_last = jnp.exp(gc[..., -1])

    def step(S, xs):
        u_n, w_n, qk_n, qd_n, kd_n, gl_n = xs
        v_new = u_n - jnp.einsum('bhck,bhkv->bhcv', w_n, S)
        o = jnp.einsum('bhck,bhkv->bhcv', qd_n, S) + jnp.einsum('bhij,bhjv->bhiv', qk_n, v_new)
        S = S * gl_n[..., None, None] + jnp.einsum('bhck,bhcv->bhkv', kd_n, v_new)
        return S, o

    xs = tuple(jnp.moveaxis(a, 2, 0) for a in (u, w, qk, q_dec, k_dec, g_last))
    S, o = lax.scan(step, s0.astype(f32), xs)
    o = jnp.transpose(o, (1, 0, 3, 2, 4)).reshape(B, T, H, -1)
    return o, S.astype(s0.dtype)


def hybrid_layer(x, c, s_ssm, s_cqkv, s_cmix, w_ada, b_ada, ln_g, ln_b,
                 f1_wg, f1_wu, f1_wd, f2_wg, f2_wu, f2_wd,
                 w_in, conv_qkv_w, a_log, dt_bias, dn_norm_g, conv_mix_w, w_out):
    B, T, D = x.shape
    mod = (jax.nn.silu(c) @ w_ada + b_ada).reshape(B, N_SUB, 3, D)
    shift, scale, gate = mod[:, :, 0], mod[:, :, 1], mod[:, :, 2]

    def modulate(h, i):
        return h * (1.0 + scale[:, None, i]) + shift[:, None, i]

    def post(h, delta, i):
        return layer_norm(ALPHA * h + gate[:, None, i] * delta, ln_g[i], ln_b[i])

    x = post(x, 0.5 * swiglu(modulate(x, 0), f1_wg, f1_wu, f1_wd), 0)

    u = modulate(x, 1)
    p = u @ w_in
    cuts = np.cumsum([QKV_DIM, DN_HEADS, DN_HEADS, DN_WIDTH, SC_WIDTH, SC_WIDTH]).tolist()
    qkv, a, b, og, sc_b, sc_c, sc_h = jnp.split(p, cuts, axis=-1)

    qkv, new_cqkv = causal_dwconv(qkv, s_cqkv, conv_qkv_w)
    qkv = jax.nn.silu(qkv)
    q, k, v = jnp.split(qkv, [DN_HEADS * DN_DK, 2 * DN_HEADS * DN_DK], axis=-1)
    q = l2norm(q.reshape(B, T, DN_HEADS, DN_DK)) * (DN_DK ** -0.5)
    k = l2norm(k.reshape(B, T, DN_HEADS, DN_DK))
    v = v.reshape(B, T, DN_HEADS, DN_DV)
    beta = jax.nn.sigmoid(b.astype(jnp.float32))
    g = -jnp.exp(a_log.astype(jnp.float32)) * jax.nn.softplus(a.astype(jnp.float32) + dt_bias)
    o, new_ssm = gated_delta_rule(q, k, v, g, beta, s_ssm)
    o = o * lax.rsqrt(jnp.mean(o * o, -1, keepdims=True) + RMS_EPS) * dn_norm_g
    o = o * jax.nn.silu(og.reshape(B, T, DN_HEADS, DN_DV).astype(jnp.float32))
    o_dn = o.reshape(B, T, DN_WIDTH).astype(x.dtype)

    z = sc_c * sc_h
    zc, new_cmix = causal_dwconv(z, s_cmix, conv_mix_w)
    o_sc = sc_b * zc

    mix = jnp.concatenate([o_dn, o_sc], axis=-1) @ w_out
    x = post(x, mix, 1)

    x = post(x, 0.5 * swiglu(modulate(x, 2), f2_wg, f2_wu, f2_wd), 2)
    return x, new_ssm, new_cqkv.astype(s_cqkv.dtype), new_cmix.astype(s_cmix.dtype)


def setup_inputs(seed: int = 0) -> dict:
    key = jax.random.key(seed)
    ks = iter(jax.random.split(key, 32))
    nrm = lambda shape, s: jax.random.normal(next(ks), shape, jnp.float32) * s
    D, L = D_MODEL, DEPTH
    return {
        "x_prompt": nrm((BATCH, SEQ, D), 1.0),
        "x_sample": nrm((DEC_BATCH, DEC_SEQ, D), 1.0),
        "state_ssm": nrm((L, DEC_BATCH, DN_HEADS, DN_DK, DN_DV), 0.1),
        "state_conv_qkv": nrm((L, DEC_BATCH, DN_CONV - 1, QKV_DIM), 1.0),
        "state_conv_mix": nrm((L, DEC_BATCH, SC_CONV - 1, SC_WIDTH), 1.0),
        "c_prompt": nrm((BATCH, D), 1.0),
        "c_sample": nrm((DEC_BATCH, D), 1.0),
        "w_ada": nrm((L, D, N_SUB * 3 * D), 0.5 * D ** -0.5),
        "b_ada": nrm((L, N_SUB * 3 * D), 0.02),
        "ln_g": 1.0 + nrm((L, N_SUB, D), 0.02),
        "ln_b": nrm((L, N_SUB, D), 0.02),
        "ffn1_wg": nrm((L, D, D_FF), D ** -0.5),
        "ffn1_wu": nrm((L, D, D_FF), D ** -0.5),
        "ffn1_wd": nrm((L, D_FF, D), BETA * D_FF ** -0.5),
        "ffn2_wg": nrm((L, D, D_FF), D ** -0.5),
        "ffn2_wu": nrm((L, D, D_FF), D ** -0.5),
        "ffn2_wd": nrm((L, D_FF, D), BETA * D_FF ** -0.5),
        "w_in": nrm((L, D, PROJ_DIM), D ** -0.5),
        "conv_qkv_w": nrm((L, DN_CONV, QKV_DIM), DN_CONV ** -0.5),
        "a_log": jnp.log(jax.random.uniform(next(ks), (L, DN_HEADS), jnp.float32, 1.0, 16.0)),
        "dt_bias": nrm((L, DN_HEADS), 0.1),
        "dn_norm_g": 1.0 + nrm((L, DN_DV), 0.02),
        "conv_mix_w": nrm((L, SC_CONV, SC_WIDTH), SC_CONV ** -0.5),
        "w_out": nrm((L, MIX_WIDTH, D), BETA * MIX_WIDTH ** -0.5),
    }


def reference(x_prompt, x_sample, state_ssm, state_conv_qkv, state_conv_mix, c_prompt, c_sample,
              w_ada, b_ada, ln_g, ln_b, ffn1_wg, ffn1_wu, ffn1_wd, ffn2_wg, ffn2_wu, ffn2_wd,
              w_in, conv_qkv_w, a_log, dt_bias, dn_norm_g, conv_mix_w, w_out):
    Bp = x_prompt.shape[0]
    dt = x_prompt.dtype
    hp, hs = x_prompt, x_sample
    sp_ssm, sp_cqkv, sp_cmix = [], [], []
    ss_ssm, ss_cqkv, ss_cmix = [], [], []
    for l in range(DEPTH):
        w = (w_ada[l], b_ada[l], ln_g[l], ln_b[l], ffn1_wg[l], ffn1_wu[l], ffn1_wd[l],
             ffn2_wg[l], ffn2_wu[l], ffn2_wd[l], w_in[l], conv_qkv_w[l], a_log[l],
             dt_bias[l], dn_norm_g[l], conv_mix_w[l], w_out[l])
        z_ssm = jnp.zeros((Bp, DN_HEADS, DN_DK, DN_DV), dt)
        z_cqkv = jnp.zeros((Bp, DN_CONV - 1, QKV_DIM), dt)
        z_cmix = jnp.zeros((Bp, SC_CONV - 1, SC_WIDTH), dt)
        hp, a1, a2, a3 = hybrid_layer(hp, c_prompt, z_ssm, z_cqkv, z_cmix, *w)
        hs, b1, b2, b3 = hybrid_layer(hs, c_sample, state_ssm[l], state_conv_qkv[l],
                                      state_conv_mix[l], *w)
        sp_ssm.append(a1); sp_cqkv.append(a2); sp_cmix.append(a3)
        ss_ssm.append(b1); ss_cqkv.append(b2); ss_cmix.append(b3)
    return (hp, hs, jnp.stack(sp_ssm), jnp.stack(sp_cqkv), jnp.stack(sp_cmix),
            jnp.stack(ss_ssm), jnp.stack(ss_cqkv), jnp.stack(ss_cmix))
```

```cpp
#include <hip/hip_runtime.h>
#include <cstdio>
#include <cstdint>
namespace pg8 {
#define PG8_LAS __attribute__((address_space(3)))
typedef unsigned short bf16_t;
typedef short bf16x8 __attribute__((ext_vector_type(8)));
typedef float f32x4 __attribute__((ext_vector_type(4)));
typedef unsigned u32x4 __attribute__((ext_vector_type(4)));
constexpr int BM = 256, BK = 64, HALF = 128, HTB = HALF * BK * 2  , STAGE_BYTES = 8 * HTB, NXCD = 8, WGM = 8;

__host__ __device__ __forceinline__ int lds_byte(int r, int c) { const int st = (r >> 4) * 2 + (c >> 5), rr = r & 15, cc = c & 31, ob = rr * 64 + cc * 2; return st * 1024 + (ob ^ (((ob >> 9) & 1) << 5)); }
__host__ __device__ __forceinline__ void stage_rc(int b, int& R, int& C) { const int st = b / 1024, sb = b % 1024, swz = sb ^ (((sb >> 9) & 1) << 5); R = (st >> 1) * 16 + swz / 64; C = (st & 1) * 32 + (swz % 64) / 2; }
__host__ __device__ __forceinline__ int perm32(int rho) { const int n = rho >> 4, i = rho & 15; return 8 * (i >> 2) + 4 * n + (i & 3); }

struct Unit { int pm, pn; };
struct Gemm { const bf16_t* A; const bf16_t* Bt; int M, N, K; };

struct StaticOrder {
    int nM, nN, nwg, G, c;
    __host__ __device__ void init(int M, int N, int G_, int c_) { nM = M / BM; nN = N / BM; nwg = nM * nN; G = G_; c = c_; }
    __host__ __device__ bool next(int i, Unit& u) const {
        const long L = (long)i * G + c; if (L >= nwg) return false;
        int wgid = (int)L; { const int q = nwg / NXCD, r = nwg % NXCD, xcd = wgid % NXCD, off = wgid / NXCD; wgid = (xcd < r ? xcd * (q + 1) : r * (q + 1) + (xcd - r) * q) + off; }
        const int nig = WGM * nN, gid = wgid / nig, fm = gid * WGM, gsz = (nM - fm) < WGM ? (nM - fm) : WGM;
        u.pm = fm + ((wgid % nig) % gsz); u.pn = (wgid % nig) / gsz; return true;
    }
    __device__ __forceinline__ void a_ready(const Unit&) const {}
    __device__ __forceinline__ void done(const Unit&) const {}
};

__device__ __forceinline__ unsigned cvt_pk_bf16(float lo, float hi) { unsigned r; asm volatile("v_cvt_pk_bf16_f32 %0, %1, %2" : "=v"(r) : "v"(lo), "v"(hi)); return r; }
typedef float f32x2 __attribute__((ext_vector_type(2)));
struct EpiBf16P {
    static constexpr bool PERM = true, AFTER_DRAIN = false;
    bf16_t* O; int ldc;
    __device__ __forceinline__ void operator()(const f32x4 (&acc)[2][2][4][2], const Unit& u, int wr, int wc, int fr, int fq) const {
        const int row0 = u.pm * BM + wr * 64 + fr, col0 = u.pn * BM + wc * 32 + 8 * fq;
#pragma unroll
        for (int ai = 0; ai < 2; ++ai)
#pragma unroll
            for (int m = 0; m < 4; ++m) { bf16_t* rowp = O + (size_t)(row0 + ai * HALF + m * 16) * ldc + col0;
#pragma unroll
                for (int bj = 0; bj < 2; ++bj) { const f32x4 v0 = acc[ai][bj][m][0], v1 = acc[ai][bj][m][1];
                    u32x4 w; w.x = cvt_pk_bf16(v0[0], v0[1]); w.y = cvt_pk_bf16(v0[2], v0[3]); w.z = cvt_pk_bf16(v1[0], v1[1]); w.w = cvt_pk_bf16(v1[2], v1[3]);
                    *(u32x4*)(rowp + bj * HALF) = w; } }
    }
};
__device__ __forceinline__ float swiglu1(float g, float u) { return g * u * __builtin_amdgcn_rcpf(1.0f + __builtin_amdgcn_exp2f(-1.4426950408889634f * g)); }
struct EpiSwiglu {
    static constexpr bool PERM = true, AFTER_DRAIN = false;
    bf16_t* O; int ldc;
    __device__ __forceinline__ void operator()(const f32x4 (&acc)[2][2][4][2], const Unit& u, int wr, int wc, int fr, int fq) const {
        const int row0 = u.pm * BM + wr * 64 + fr, col0 = u.pn * HALF + wc * 32 + 8 * fq;
#pragma unroll
        for (int ai = 0; ai < 2; ++ai)
#pragma unroll
            for (int m = 0; m < 4; ++m) { bf16_t* rowp = O + (size_t)(row0 + ai * HALF + m * 16) * ldc + col0;
                const f32x4 g0 = acc[ai][0][m][0], g1 = acc[ai][0][m][1], u0 = acc[ai][1][m][0], u1 = acc[ai][1][m][1];
                u32x4 w; w.x = cvt_pk_bf16(swiglu1(g0[0], u0[0]), swiglu1(g0[1], u0[1])); w.y = cvt_pk_bf16(swiglu1(g0[2], u0[2]), swiglu1(g0[3], u0[3]));
                w.z = cvt_pk_bf16(swiglu1(g1[0], u1[0]), swiglu1(g1[1], u1[1])); w.w = cvt_pk_bf16(swiglu1(g1[2], u1[2]), swiglu1(g1[3], u1[3]));
                *(u32x4*)rowp = w; }
    }
};
template <class Epi, class Sched, bool ALIGN_EPI = false, bool SP2 = false>
__device__ __forceinline__ void gemm_phase(PG8_LAS unsigned char* lds, const Gemm g, const Sched& S, const Epi& E) {
    int tid_l = threadIdx.x; asm volatile("" : "+v"(tid_l));
    const int tid = tid_l, wid = __builtin_amdgcn_readfirstlane(tid >> 6), lane = tid & 63, wr = wid >> 2, wc = wid & 3, fr = lane & 15, fq = lane >> 4;
    const int K = g.K, nt = K / BK;
    unsigned voffA[2], voffB[2];
#pragma unroll
    for (int i = 0; i < 2; ++i) { int R, C; stage_rc(tid * 16 + i * 8192, R, C); const int Rb = Epi::PERM ? ((R & ~31) + perm32(R & 31)) : R;
        voffA[i] = (unsigned)(R * K + C) * 2u; voffB[i] = (unsigned)(Rb * K + C) * 2u; }
    const size_t kstep = (size_t)(BK * 2);
    const size_t hstep = (size_t)HALF * K * 2;
    const size_t tstep = 2 * hstep;
    const unsigned ldsw = (unsigned)wid * 1024u;
    const int aoff = lds_byte(wr * 64 + fr, fq * 8), boff = lds_byte(wc * 32 + fr, fq * 8);
#define PG8_SA(b, h) (((b) * 2 + (h)) * HTB)
#define PG8_SB(b, h) ((4 + (b) * 2 + (h)) * HTB)
#define PG8_STAGE(bufoff, gbase, voff) do { _Pragma("unroll") for (int _i = 0; _i < 2; ++_i) \
        __builtin_amdgcn_global_load_lds((const unsigned*)((const char*)(gbase) + (voff)[_i]), (PG8_LAS unsigned*)(lds + (bufoff) + ldsw + _i * 8192), 16, 0, 0); } while (0)
#define PG8_LDA(dst, b, h) do { _Pragma("unroll") for (int m = 0; m < 4; ++m) _Pragma("unroll") for (int k = 0; k < 2; ++k) dst[m][k] = *(const PG8_LAS bf16x8*)(lds + PG8_SA(b, h) + aoff + m * 2048 + k * 1024); } while (0)
#define PG8_LDB(dst, b, h) do { _Pragma("unroll") for (int n = 0; n < 2; ++n) _Pragma("unroll") for (int k = 0; k < 2; ++k) dst[n][k] = *(const PG8_LAS bf16x8*)(lds + PG8_SB(b, h) + boff + n * 2048 + k * 1024); } while (0)
#define PG8_MMA(ai, bj, At, Bt) do { __builtin_amdgcn_s_setprio(1); _Pragma("unroll") for (int m = 0; m < 4; ++m) _Pragma("unroll") for (int n = 0; n < 2; ++n) _Pragma("unroll") for (int k = 0; k < 2; ++k) \
        acc[ai][bj][m][n] = __builtin_amdgcn_mfma_f32_16x16x32_bf16(Bt[n][k], At[m][k], acc[ai][bj][m][n], 0, 0, 0); __builtin_amdgcn_s_setprio(0); } while (0)
#define PG8_WAIT_V(n) asm volatile("s_waitcnt vmcnt(" #n ")" ::: "memory")
#define PG8_WAIT_L(n) asm volatile("s_waitcnt lgkmcnt(" #n ")" ::: "memory")
#define PG8_BAR __builtin_amdgcn_s_barrier()
#define PG8_SCHED __builtin_amdgcn_sched_barrier(0)
    Unit cur, nxt; int ui = 0;
    if (!S.next(0, cur)) return;
    f32x4 acc[2][2][4][2];
#pragma unroll
    for (int a = 0; a < 2; ++a)
#pragma unroll
        for (int b = 0; b < 2; ++b)
#pragma unroll
            for (int m = 0; m < 4; ++m)
#pragma unroll
                for (int n = 0; n < 2; ++n) acc[a][b][m][n] = (f32x4){0.f, 0.f, 0.f, 0.f};
    bf16x8 At[4][2], B0[2][2], B1[2][2];
    const char* cA = (const char*)g.A + (size_t)cur.pm * tstep; const char* cB = (const char*)g.Bt + (size_t)cur.pn * tstep;
    S.a_ready(cur);
    if constexpr (SP2) {
        PG8_STAGE(PG8_SB(0, 0), cB, voffB); PG8_STAGE(PG8_SB(0, 1), cB + hstep, voffB); PG8_STAGE(PG8_SA(0, 0), cA, voffA); PG8_STAGE(PG8_SA(0, 1), cA + hstep, voffA);
        if (wr == 1) PG8_BAR;
        PG8_WAIT_V(2); PG8_BAR;
        PG8_STAGE(PG8_SB(1, 0), cB + kstep, voffB); PG8_STAGE(PG8_SA(1, 0), cA + kstep, voffA); PG8_STAGE(PG8_SB(1, 1), cB + hstep + kstep, voffB);
        PG8_WAIT_V(6); PG8_BAR;
    } else {
        PG8_STAGE(PG8_SB(0, 0), cB, voffB); PG8_STAGE(PG8_SA(0, 0), cA, voffA); PG8_STAGE(PG8_SB(0, 1), cB + hstep, voffB); PG8_STAGE(PG8_SA(0, 1), cA + hstep, voffA);
        if (wr == 1) PG8_BAR;
        PG8_WAIT_V(4); PG8_BAR;
        PG8_STAGE(PG8_SB(1, 0), cB + kstep, voffB); PG8_STAGE(PG8_SA(1, 0), cA + kstep, voffA); PG8_STAGE(PG8_SB(1, 1), cB + hstep + kstep, voffB);
        PG8_WAIT_V(6); PG8_BAR;
    }
    for (;;) {
        const bool has_next = S.next(ui + 1, nxt);
        const char* nA = has_next ? (const char*)g.A + (size_t)nxt.pm * tstep : cA; const char* nB = has_next ? (const char*)g.Bt + (size_t)nxt.pn * tstep : cB;
        for (int t = 0; t < nt; t += 2) {
            const bool last = (t == nt - 2);
            const char* a1 = cA + (size_t)(t + 1) * kstep;
            const char* a2 = last ? nA : cA + (size_t)(t + 2) * kstep; const char* b2 = last ? nB : cB + (size_t)(t + 2) * kstep;
            const char* a3 = a2 + kstep; const char* b3 = b2 + kstep;
            if (last && has_next) S.a_ready(nxt);
            if constexpr (SP2) {
            PG8_LDB(B0, 0, 0); PG8_LDB(B1, 0, 1); PG8_SCHED; PG8_LDA(At, 0, 0); PG8_STAGE(PG8_SA(1, 1), a1 + hstep, voffA);
            PG8_WAIT_V(8); PG8_WAIT_L(0); PG8_BAR; PG8_MMA(0, 0, At, B0); PG8_MMA(0, 1, At, B1); PG8_BAR; PG8_SCHED;
            PG8_LDA(At, 0, 1); PG8_STAGE(PG8_SB(0, 0), b2, voffB); PG8_STAGE(PG8_SB(0, 1), b2 + hstep, voffB); PG8_STAGE(PG8_SA(0, 0), a2, voffA);
            PG8_WAIT_V(8); PG8_WAIT_L(0); PG8_BAR; PG8_MMA(1, 0, At, B0); PG8_MMA(1, 1, At, B1); PG8_BAR; PG8_SCHED;
            PG8_LDB(B0, 1, 0); PG8_LDB(B1, 1, 1); PG8_SCHED; PG8_LDA(At, 1, 0); PG8_STAGE(PG8_SA(0, 1), a2 + hstep, voffA);
            PG8_WAIT_V(8); PG8_WAIT_L(0); PG8_BAR; PG8_MMA(0, 0, At, B0); PG8_MMA(0, 1, At, B1); PG8_BAR; PG8_SCHED;
            PG8_LDA(At, 1, 1); PG8_STAGE(PG8_SB(1, 0), b3, voffB); PG8_STAGE(PG8_SB(1, 1), b3 + hstep, voffB); PG8_STAGE(PG8_SA(1, 0), a3, voffA);
            PG8_WAIT_V(8); PG8_WAIT_L(0); PG8_BAR; PG8_MMA(1, 0, At, B0); PG8_MMA(1, 1, At, B1); PG8_BAR; PG8_SCHED;
            } else {
            PG8_LDB(B0, 0, 0); PG8_SCHED; PG8_LDA(At, 0, 0); PG8_STAGE(PG8_SA(1, 1), a1 + hstep, voffA);
            PG8_WAIT_L(8); PG8_BAR; PG8_WAIT_L(0); PG8_MMA(0, 0, At, B0); PG8_BAR; PG8_SCHED;
            PG8_LDB(B1, 0, 1); PG8_STAGE(PG8_SB(0, 0), b2, voffB);
            PG8_BAR; PG8_WAIT_L(0); PG8_MMA(0, 1, At, B1); PG8_BAR;
            PG8_LDA(At, 0, 1); PG8_STAGE(PG8_SA(0, 0), a2, voffA);
            PG8_BAR; PG8_WAIT_L(0); PG8_MMA(1, 0, At, B0); PG8_BAR; PG8_SCHED;
            PG8_STAGE(PG8_SB(0, 1), b2 + hstep, voffB);
            PG8_WAIT_V(6); PG8_BAR; PG8_MMA(1, 1, At, B1); PG8_BAR;
            PG8_LDB(B0, 1, 0); PG8_SCHED; PG8_LDA(At, 1, 0); PG8_STAGE(PG8_SA(0, 1), a2 + hstep, voffA);
            PG8_WAIT_L(8); PG8_BAR; PG8_WAIT_L(0); PG8_MMA(0, 0, At, B0); PG8_BAR; PG8_SCHED;
            PG8_LDB(B1, 1, 1); PG8_STAGE(PG8_SB(1, 0), b3, voffB);
            PG8_BAR; PG8_WAIT_L(0); PG8_MMA(0, 1, At, B1); PG8_BAR;
            PG8_LDA(At, 1, 1); PG8_STAGE(PG8_SA(1, 0), a3, voffA);
            PG8_BAR; PG8_WAIT_L(0); PG8_MMA(1, 0, At, B0); PG8_BAR; PG8_SCHED;
            PG8_STAGE(PG8_SB(1, 1), b3 + hstep, voffB);
            PG8_WAIT_V(6); PG8_BAR; PG8_MMA(1, 1, At, B1); PG8_BAR;
            }
        }
        if constexpr (ALIGN_EPI) { if (wr == 0) PG8_BAR; }
        if constexpr (!Epi::AFTER_DRAIN) { E(acc, cur, wr, wc, fr, fq); S.done(cur); }
        if (!has_next) break;
#pragma unroll
        for (int a = 0; a < 2; ++a)
#pragma unroll
            for (int b = 0; b < 2; ++b)
#pragma unroll
                for (int m = 0; m < 4; ++m)
#pragma unroll
                    for (int n = 0; n < 2; ++n) acc[a][b][m][n] = (f32x4){0.f, 0.f, 0.f, 0.f};
        cur = nxt; cA = nA; cB = nB; ++ui;
        if constexpr (ALIGN_EPI) { if (wr == 1) PG8_BAR; }
    }
    PG8_WAIT_V(0);
    if constexpr (!ALIGN_EPI) { if (wr == 0) PG8_BAR; }
    PG8_BAR;
    if constexpr (Epi::AFTER_DRAIN) { E.fused(acc, cur, wr, wc, fr, fq, lds, wid, lane); S.done(cur); }
#undef PG8_SA
#undef PG8_SB
#undef PG8_STAGE
#undef PG8_LDA
#undef PG8_LDB
#undef PG8_MMA
#undef PG8_WAIT_V
#undef PG8_WAIT_L
#undef PG8_BAR
#undef PG8_SCHED
}
}
constexpr int NWAVES = 8;
constexpr int D = 1024, NB = 8, T = 2048, NS = 128, TS = 4, FF = 2816, PROJ = 3592, QKV = 1536, NH = 4;
constexpr int MP = NB * T, MS = NS * TS, M = MP + MS, NSEQ = NB + NS;
constexpr int NUP = 2 * FF, NIN = 3584, MODW = 9 * D;
constexpr float ALPHA = 1.189207115002721f, LN_EPS = 1e-5f;
constexpr size_t O_Y = 0, O_SSM_P = (size_t)M * D, O_CQ_P = O_SSM_P + (size_t)NB * NH * 128 * 128, O_CM_P = O_CQ_P + (size_t)NB * 3 * QKV,
                 O_SSM_S = O_CM_P + (size_t)NB * 2 * 512, O_CQ_S = O_SSM_S + (size_t)NS * NH * 128 * 128, O_CM_S = O_CQ_S + (size_t)NS * 3 * QKV,
                 O_END = O_CM_S + (size_t)NS * 2 * 512;
constexpr size_t MiB = 1u << 20, KiB = 1u << 10;
constexpr size_t WS_CTL = 0, CTL_ZERO_BYTES = 1 * MiB;
constexpr size_t WS_MOD = 1 * MiB;
constexpr size_t WS_W1U = 6 * MiB, WS_W1D = 17 * MiB, WS_W2U = 22 * MiB + 512 * KiB, WS_W2D = 33 * MiB + 512 * KiB, WS_WIN = 39 * MiB, WS_WOUT = 46 * MiB;
constexpr size_t WS_GB = 48 * MiB;
constexpr size_t WS_XM = 49 * MiB, WS_Y = 82 * MiB, WS_HP = 115 * MiB, WS_END = 256 * MiB;
static_assert(WS_MOD + (size_t)NSEQ * MODW * 4 <= WS_W1U && WS_W1U + (size_t)NUP * D * 2 <= WS_W1D && WS_W1D + (size_t)D * FF * 2 <= WS_W2U && WS_W2U + (size_t)NUP * D * 2 <= WS_W2D &&
              WS_W2D + (size_t)D * FF * 2 <= WS_WIN && WS_WIN + (size_t)NIN * D * 2 <= WS_WOUT && WS_WOUT + (size_t)D * D * 2 <= WS_GB && WS_GB + (size_t)M * 8 * 4 <= WS_XM &&
              WS_XM + (size_t)M * D * 2 <= WS_Y && WS_Y + (size_t)M * D * 2 <= WS_HP && WS_HP + (size_t)M * NIN * 2 <= WS_END, "d_ws map");
constexpr int CW_TMO = 0, CW_CODE = 1, CW_BAR = 4096;
constexpr int RING_OFF = 0, RING_BYTES = 131072, LDSCTL_OFF = RING_BYTES, MISC_OFF = LDSCTL_OFF + 320, LDS_BYTES = 147456;

#define GAS __attribute__((address_space(1)))
#define LAS __attribute__((address_space(3)))
typedef unsigned short bf16;
typedef unsigned v4u __attribute__((ext_vector_type(4)));
typedef unsigned v2u __attribute__((ext_vector_type(2)));
typedef float f32x4 __attribute__((ext_vector_type(4)));
typedef short bf16x8 __attribute__((ext_vector_type(8)));
typedef GAS unsigned gu32;
#define RLX_AGENT __ATOMIC_RELAXED, __HIP_MEMORY_SCOPE_AGENT
#define LDS_WAIT() asm volatile("s_waitcnt lgkmcnt(0)" ::: "memory")
#define VM_WAIT() asm volatile("s_waitcnt vmcnt(0)" ::: "memory")
__device__ __forceinline__ unsigned f2bf(float f) { unsigned u = __builtin_bit_cast(unsigned, f); return (u + 0x7fffu + ((u >> 16) & 1u)) >> 16; }
typedef float f32x2_t __attribute__((ext_vector_type(2))); typedef __bf16 bf16x2_t __attribute__((ext_vector_type(2)));
__device__ __forceinline__ unsigned pk2(float lo, float hi) { const f32x2_t v = {lo, hi}; const bf16x2_t b = __builtin_convertvector(v, bf16x2_t); return __builtin_bit_cast(unsigned, b); }
__device__ __forceinline__ float bf_lo(unsigned w) { return __builtin_bit_cast(float, w << 16); }
__device__ __forceinline__ float bf_hi(unsigned w) { return __builtin_bit_cast(float, w & 0xffff0000u); }
__device__ __forceinline__ float silu_f(float x) { return x * __builtin_amdgcn_rcpf(1.0f + __builtin_amdgcn_exp2f(-1.4426950408889634f * x)); }

#define XB_TMO      128
#define XB_XCNT(j)  (256  + 64 * (j))
#define XB_XSUB(j)  (1280 + 64 * (j))
#define XB_XGEN(j)  (2304 + 64 * (j))
#define XB_TOP      3328
#define XB_TOPGEN   3392
#define XCD_BAR_WORDS 3456
#define XB_SPIN_CAP (1u << 18)
__device__ __forceinline__ unsigned xb_ld(unsigned* p)              { return __hip_atomic_load(p, __ATOMIC_RELAXED, __HIP_MEMORY_SCOPE_AGENT); }
__device__ __forceinline__ unsigned xb_add(unsigned* p, unsigned v) { return __hip_atomic_fetch_add(p, v, __ATOMIC_RELAXED, __HIP_MEMORY_SCOPE_AGENT); }
__device__ __forceinline__ unsigned xb_xcc_id() { return (unsigned)__builtin_amdgcn_s_getreg((3 << 11) | 20) & 0xFu; }
#define XB_SPIN(cond, bar) do { unsigned _sp = 0; while (cond) { __builtin_amdgcn_s_sleep(1); \
    if ((++_sp & 255u) == 0u) { if (xb_ld(&(bar)[XB_TMO])) break; if (_sp > XB_SPIN_CAP) { atomicAdd(&(bar)[XB_TMO], 1u); break; } } } } while (0)
struct XcdBarrier { unsigned* bar; unsigned x; volatile LAS unsigned* st; };
__device__ __forceinline__ XcdBarrier xcd_barrier_post(unsigned* bar, volatile LAS unsigned* st) {
    XcdBarrier b; b.bar = bar; b.x = xb_xcc_id(); b.st = st;
    if (threadIdx.x == 0) (void)xb_add(&bar[XB_XCNT(b.x)], 1u);
    return b;
}
__device__ __forceinline__ void xcd_barrier_complete(unsigned* bar, unsigned x, unsigned& nloc, unsigned& nx) {
    const unsigned G = gridDim.x * gridDim.y * gridDim.z;
    unsigned sum, cnt, mine, sp = 0u;
    for (;;) {
        sum = 0u; cnt = 0u; mine = 0u;
#pragma unroll
        for (unsigned j = 0; j < 16; ++j) { const unsigned c = xb_ld(&bar[XB_XCNT(j)]); sum += c; cnt += (c > 0u) ? 1u : 0u; mine = (j == x) ? c : mine; }
        if (sum == G) break;
        __builtin_amdgcn_s_sleep(1);
        if ((++sp & 255u) == 0u) { if (xb_ld(&bar[XB_TMO])) break; if (sp > XB_SPIN_CAP) { atomicAdd(&bar[XB_TMO], 1u); break; } }
    }
    nloc = mine > 0u ? mine : 1u; nx = cnt > 0u ? cnt : 1u;
}
__device__ __forceinline__ void xcd_barrier(const XcdBarrier& b) {
    asm volatile("s_waitcnt vmcnt(0)" ::: "memory");
    __syncthreads();
    if (threadIdx.x == 0) {
        unsigned* bar = b.bar;
        __builtin_amdgcn_s_waitcnt(0);
        unsigned nloc = b.st[0], nx = b.st[1];
        if (nloc == 0u) { xcd_barrier_complete(bar, b.x, nloc, nx); b.st[0] = nloc; b.st[1] = nx; }
        const unsigned old = xb_add(&bar[XB_XSUB(b.x)], 1u);
        const unsigned gen = old / nloc;
        if (old + 1u == (gen + 1u) * nloc) {
            __builtin_amdgcn_fence(__ATOMIC_RELEASE, "agent");
            asm volatile("s_waitcnt vmcnt(0)" ::: "memory");
            const unsigned og = xb_add(&bar[XB_TOP], 1u);
            const unsigned tg = og / nx;
            if (og + 1u == (tg + 1u) * nx) xb_add(&bar[XB_TOPGEN], 1u);
            else XB_SPIN(xb_ld(&bar[XB_TOPGEN]) == tg, bar);
            __builtin_amdgcn_fence(__ATOMIC_ACQUIRE, "agent");
            xb_add(&bar[XB_XGEN(b.x)], 1u);
            asm volatile("s_waitcnt vmcnt(0)" ::: "memory");
        } else {
            XB_SPIN(xb_ld(&bar[XB_XGEN(b.x)]) == gen, bar);
            __builtin_amdgcn_fence(__ATOMIC_ACQUIRE, "agent");
            asm volatile("s_waitcnt vmcnt(0)" ::: "memory");
        }
    }
    __syncthreads();
}

struct Frame {
    LAS unsigned char* lds;
    volatile LAS unsigned* MISC;
    gu32* ctl;
    int tid, lane, wave, vcu, G;
    const float *in_0, *in_1, *in_2, *in_3, *in_4, *in_5, *in_6, *in_7, *in_8, *in_9, *in_10, *in_11, *in_12, *in_13, *in_14, *in_15, *in_16, *in_17, *in_18, *in_19, *in_20, *in_21, *in_22, *in_23; float* out; unsigned char* ws;
};
__device__ __forceinline__ float wave_sum(float v) {
#pragma unroll
    for (int o = 1; o < 64; o <<= 1) v += __shfl_xor(v, o);
    return v;
}
__device__ __forceinline__ int seq_of(int m) { return m < MP ? (m >> 11) : NB + ((m - MP) >> 2); }

__device__ __forceinline__ void p0_ada(Frame& F) {
    constexpr int RS = 528;
    const int unit = F.wave * F.G + (int)blockIdx.x;
    const bool has = unit < 576;
    const int n0 = unit * 16, m = F.lane & 15, g = F.lane >> 4;
    const float* wada = F.in_7;
    f32x4 acc[9];
#pragma unroll
    for (int i = 0; i < 9; ++i) acc[i] = (f32x4){0.f, 0.f, 0.f, 0.f};
    for (int kc = 0; kc < 4; ++kc) {
        float af[8][8];
        if (has) {
#pragma unroll
            for (int ks = 0; ks < 8; ++ks)
#pragma unroll
                for (int j = 0; j < 8; ++j) af[ks][j] = wada[(size_t)(kc * 256 + ks * 32 + 8 * g + j) * MODW + n0 + m];
        }
#pragma unroll
        for (int i = 0; i < 9; ++i) {
            const int gi = F.tid + 512 * i, row = gi >> 5, kg = gi & 31;
            v4u o = (v4u){0u, 0u, 0u, 0u};
            if (row < NSEQ) {
                const float* c = (row < NB ? F.in_5 + (size_t)row * D : F.in_6 + (size_t)(row - NB) * D) + kc * 256 + kg * 8;
                const f32x4 a = *(const f32x4*)c, b = *(const f32x4*)(c + 4);
                o.x = pk2(silu_f(a.x), silu_f(a.y)); o.y = pk2(silu_f(a.z), silu_f(a.w)); o.z = pk2(silu_f(b.x), silu_f(b.y)); o.w = pk2(silu_f(b.z), silu_f(b.w));
            }
            *(LAS v4u*)(F.lds + row * RS + kg * 16) = o;
        }
        LDS_WAIT(); __syncthreads();
        if (has) {
#pragma unroll
            for (int ks = 0; ks < 8; ++ks) {
                v4u aw; aw.x = pk2(af[ks][0], af[ks][1]); aw.y = pk2(af[ks][2], af[ks][3]); aw.z = pk2(af[ks][4], af[ks][5]); aw.w = pk2(af[ks][6], af[ks][7]);
                const bf16x8 A = __builtin_bit_cast(bf16x8, aw);
#pragma unroll
                for (int nt = 0; nt < 9; ++nt) {
                    const bf16x8 B = *(const LAS bf16x8*)(F.lds + (16 * nt + m) * RS + (ks * 32 + 8 * g) * 2);
                    acc[nt] = __builtin_amdgcn_mfma_f32_16x16x32_bf16(A, B, acc[nt], 0, 0, 0);
                }
            }
        }
        LDS_WAIT(); __syncthreads();
    }
    if (has) {
        const f32x4 bv = *(const f32x4*)(F.in_8 + n0 + 4 * g);
        float* mod = (float*)(F.ws + WS_MOD);
#pragma unroll
        for (int nt = 0; nt < 9; ++nt) { const int s = 16 * nt + m; if (s < NSEQ) *(f32x4*)(mod + (size_t)s * MODW + n0 + 4 * g) = acc[nt] + bv; }
    }
}
__device__ __forceinline__ void transpose_item(const float* W, int ldw, int src_col0, bf16* WT, int K, int dst_row0, int kb, LAS float* scr, int lane) {
    const int k0 = 64 * kb;
#pragma unroll 8
    for (int i = 0; i < 32; ++i) { const int kk = 2 * i + (lane >> 5); scr[kk * 33 + (lane & 31)] = W[(size_t)(k0 + kk) * ldw + src_col0 + (lane & 31)]; }
    LDS_WAIT(); asm volatile("" ::: "memory");
    const int c = lane & 7;
#pragma unroll
    for (int j = 0; j < 4; ++j) { const int n = (lane >> 3) + 8 * j; const LAS float* s = scr + (8 * c) * 33 + n;
        v4u o; o.x = pk2(s[0 * 33], s[1 * 33]); o.y = pk2(s[2 * 33], s[3 * 33]); o.z = pk2(s[4 * 33], s[5 * 33]); o.w = pk2(s[6 * 33], s[7 * 33]);
        *(GAS v4u*)(WT + (size_t)(dst_row0 + n) * K + k0 + 8 * c) = o; }
    LDS_WAIT(); asm volatile("" ::: "memory");
}
__device__ __forceinline__ void p0_convert(Frame& F) {
    LAS float* scr = (LAS float*)(F.lds + RING_OFF + F.wave * 16384);
    const int gw = F.vcu * NWAVES + F.wave, NGW = F.G * NWAVES;
    constexpr int I_U = 16 * 88, I_D = 44 * 32, I_IN = 16 * 112, I_O = 16 * 32;
    constexpr int NITEMS = 4 * I_U + 2 * I_D + I_IN + I_O;
    for (int it = gw; it < NITEMS; it += NGW) {
        int r = it;
        if (r < 4 * I_U) { const int w = r / I_U; r -= w * I_U; const int kb = r / 88, nb = r % 88;
            transpose_item(w == 0 ? F.in_11 : w == 1 ? F.in_12 : w == 2 ? F.in_14 : F.in_15, FF, 32 * nb, (bf16*)(F.ws + (w < 2 ? WS_W1U : WS_W2U)), D, 256 * (nb >> 2) + 32 * (nb & 3) + 128 * (w & 1), kb, scr, F.lane); continue; }
        r -= 4 * I_U;
        if (r < 2 * I_D) { const int w = r / I_D; r -= w * I_D; const int kb = r / 32, nb = r % 32;
            transpose_item(w == 0 ? F.in_13 : F.in_16, D, 32 * nb, (bf16*)(F.ws + (w == 0 ? WS_W1D : WS_W2D)), FF, 32 * nb, kb, scr, F.lane); continue; }
        r -= 2 * I_D;
        if (r < I_IN) { const int kb = r / 112, nb = r % 112;
            transpose_item(F.in_17, PROJ, nb < 48 ? 32 * nb : 1544 + 32 * (nb - 48), (bf16*)(F.ws + WS_WIN), D, nb < 48 ? 32 * nb : 1536 + 32 * (nb - 48), kb, scr, F.lane); continue; }
        r -= I_IN;
        { const int kb = r / 32, nb = r % 32; transpose_item(F.in_23, D, 32 * nb, (bf16*)(F.ws + WS_WOUT), D, 32 * nb, kb, scr, F.lane); }
    }
}
__device__ __forceinline__ void p1_mod(Frame& F) {
    const int gw = F.vcu * NWAVES + F.wave, NGW = F.G * NWAVES;
    const float* mod = (const float*)(F.ws + WS_MOD); bf16* XM = (bf16*)(F.ws + WS_XM);
    for (int m = gw; m < M; m += NGW) {
        const float* xr = m < MP ? F.in_0 + (size_t)m * D : F.in_1 + (size_t)(m - MP) * D;
        const float* ms = mod + (size_t)seq_of(m) * MODW;
#pragma unroll
        for (int j = 0; j < 4; ++j) { const int d = 4 * F.lane + 256 * j;
            const f32x4 v = *(const f32x4*)(xr + d), sh = *(const f32x4*)(ms + d), sc = *(const f32x4*)(ms + D + d);
            const f32x4 o = v * (sc + 1.0f) + sh; v2u w; w.x = pk2(o.x, o.y); w.y = pk2(o.z, o.w);
            *(GAS v2u*)(XM + (size_t)m * D + d) = w; }
    }
}
template <int I>
__device__ __forceinline__ void ln_pass(Frame& F, float yscale) {
    const int gw = F.vcu * NWAVES + F.wave, NGW = F.G * NWAVES;
    const float* mod = (const float*)(F.ws + WS_MOD); bf16* XM = (bf16*)(F.ws + WS_XM); const bf16* Y = (const bf16*)(F.ws + WS_Y);
    const float* lg = F.in_9 + I * D; const float* lb = F.in_10 + I * D;
    LAS float* W8 = (LAS float*)(F.lds + RING_OFF);
    if (I == 0) {
        for (int e = F.tid; e < 8 * D; e += NWAVES * 64) { const int d = e >> 3, j = e & 7; W8[j * D + d] = F.in_17[(size_t)d * PROJ + QKV + j]; }
        LDS_WAIT(); __syncthreads();
    }
    for (int m = gw; m < M; m += NGW) {
        const float* xr = (I == 0) ? (m < MP ? F.in_0 + (size_t)m * D : F.in_1 + (size_t)(m - MP) * D) : F.out + (size_t)m * D;
        const float* ms = mod + (size_t)seq_of(m) * MODW + I * 3 * D;
        f32x4 v[4]; float s = 0.f;
#pragma unroll
        for (int j = 0; j < 4; ++j) { const int d = 4 * F.lane + 256 * j;
            const f32x4 x = *(const f32x4*)(xr + d), gt = *(const f32x4*)(ms + 2 * D + d); const v2u yw = *(const GAS v2u*)(Y + (size_t)m * D + d);
            const f32x4 y = (f32x4){bf_lo(yw.x), bf_hi(yw.x), bf_lo(yw.y), bf_hi(yw.y)};
            v[j] = x * ALPHA + gt * y * yscale; s += (v[j].x + v[j].y) + (v[j].z + v[j].w); }
        const float mean = wave_sum(s) * (1.f / D); float s2 = 0.f;
#pragma unroll
        for (int j = 0; j < 4; ++j) { v[j] = v[j] - mean; s2 += (v[j].x * v[j].x + v[j].y * v[j].y) + (v[j].z * v[j].z + v[j].w * v[j].w); }
        const float rstd = 1.f / sqrtf(wave_sum(s2) * (1.f / D) + LN_EPS);
        float ab[8];
#pragma unroll
        for (int q = 0; q < 8; ++q) ab[q] = 0.f;
#pragma unroll
        for (int j = 0; j < 4; ++j) { const int d = 4 * F.lane + 256 * j;
            const f32x4 o = v[j] * rstd * *(const f32x4*)(lg + d) + *(const f32x4*)(lb + d);
            *(f32x4*)(F.out + (size_t)m * D + d) = o;
            if (I < 2) { const f32x4 sh = *(const f32x4*)(ms + 3 * D + d), sc = *(const f32x4*)(ms + 4 * D + d);
                const f32x4 u = o * (sc + 1.0f) + sh; v2u w; w.x = pk2(u.x, u.y); w.y = pk2(u.z, u.w);
                *(GAS v2u*)(XM + (size_t)m * D + d) = w;
                if (I == 0) {
#pragma unroll
                    for (int q = 0; q < 8; ++q) { const f32x4 wv = *(const LAS f32x4*)(W8 + q * D + d); ab[q] += (u.x * wv.x + u.y * wv.y) + (u.z * wv.z + u.w * wv.w); } } }
        }
        if (I == 0) {
#pragma unroll
            for (int q = 0; q < 8; ++q) ab[q] = wave_sum(ab[q]);
            if (F.lane < 4) { const int h = F.lane; float a = h == 0 ? ab[0] : h == 1 ? ab[1] : h == 2 ? ab[2] : ab[3], b = h == 0 ? ab[4] : h == 1 ? ab[5] : h == 2 ? ab[6] : ab[7];
                const float z = a + F.in_20[h]; const float sp = z > 20.f ? z : log1pf(__expf(z));
                float* GB = (float*)(F.ws + WS_GB);
                GB[(size_t)m * 4 + h] = -__expf(F.in_19[h]) * sp;
                GB[(size_t)M * 4 + (size_t)m * 4 + h] = 1.f / (1.f + __expf(-b)); }
        }
    }
    if (I == 0) { LDS_WAIT(); __syncthreads(); }
}
constexpr int PC_OG = 1536, PC_SB = 2048, PC_SC = 2560, PC_SH = 3072;
constexpr size_t FRB_AW = WS_Y, FRB_AQD = WS_Y + 16 * MiB;
constexpr size_t FRB_AQK = WS_HP + (size_t)M * NIN * 2, FRB_GL = FRB_AQK + 8 * MiB;
static_assert(FRB_AQD + 16 * MiB <= WS_HP && FRB_GL + 4096 <= WS_END, "fragment map");
__device__ __forceinline__ unsigned char* fr_akd(const Frame& F) { return (unsigned char*)(F.out + O_SSM_S); }
__device__ __forceinline__ unsigned char* fr_u(const Frame& F) { return (unsigned char*)(F.out + O_SSM_S) + 16 * MiB; }

__device__ __forceinline__ void unpack8(const v4u w, float (&f)[8]) {
    f[0] = bf_lo(w.x); f[1] = bf_hi(w.x); f[2] = bf_lo(w.y); f[3] = bf_hi(w.y); f[4] = bf_lo(w.z); f[5] = bf_hi(w.z); f[6] = bf_lo(w.w); f[7] = bf_hi(w.w);
}
__device__ __forceinline__ void d1_unit(Frame& F, int ci) {
    constexpr int RAW = 0, RAWS = 768, KBI = 0, KHI = 17408, QHI = 34816, IMS = 272, VB = 52224, KG = 84992, SC = 117760, CW = 118784;
    constexpr int LM = 0, QKI = 17408, QKS = 136, WIM = 34816;
    const int bh = ci >> 5, n = ci & 31, b = bh >> 2, h = bh & 3, row0 = b * T + 64 * n;
    int tid_l = F.tid; asm volatile("" : "+v"(tid_l));
    const int tid = tid_l, lane = tid & 63, wave = F.wave;
    LAS unsigned char* L = F.lds;
    LAS float* SCf = (LAS float*)(L + SC);
    LAS float* CWf = (LAS float*)(L + CW);
    const bf16* P = (const bf16*)(F.ws + WS_HP);
    const float* GB = (const float*)(F.ws + WS_GB);
    for (int p = tid; p < 67 * 48; p += 512) { const int r = p / 48, q = p % 48, part = q >> 4, c8 = q & 15, tok = r - 3;
        v4u val = (v4u){0u, 0u, 0u, 0u};
        if (n > 0 || tok >= 0) val = *(const GAS v4u*)(P + (size_t)(row0 + tok) * NIN + part * 512 + h * 128 + c8 * 8);
        *(LAS v4u*)(L + RAW + r * RAWS + q * 16) = val; }
    for (int e = tid; e < 1536; e += 512) { const int i = e / 384, q = e % 384; CWf[e] = F.in_18[i * QKV + (q >> 7) * 512 + h * 128 + (q & 127)]; }
    if (wave == 0) {
        const float gv = GB[(size_t)(row0 + lane) * 4 + h], bt = GB[(size_t)M * 4 + (size_t)(row0 + lane) * 4 + h];
        float gc = gv;
#pragma unroll
        for (int o = 1; o < 64; o <<= 1) { const float t = __shfl_up(gc, o); if (lane >= o) gc += t; }
        const float glast = __shfl(gc, 63);
        SCf[lane] = gc; SCf[64 + lane] = bt; SCf[128 + lane] = __expf(gc); SCf[192 + lane] = __expf(glast - gc);
        if (lane == 0) ((float*)(F.ws + FRB_GL))[ci] = __expf(glast);
    }
    LDS_WAIT(); __syncthreads();
    const int tok = tid >> 3, sub = tid & 7;
    float val[6][8];
#pragma unroll
    for (int i = 0; i < 6; ++i) { const int cg = (i >> 1) * 16 + (i & 1) * 8 + sub;
        float a[8];
#pragma unroll
        for (int e = 0; e < 8; ++e) a[e] = 0.f;
#pragma unroll
        for (int tap = 0; tap < 4; ++tap) { float x[8]; unpack8(*(const LAS v4u*)(L + RAW + (tok + tap) * RAWS + cg * 16), x);
            const f32x4 w0 = *(const LAS f32x4*)(CWf + tap * 384 + cg * 8), w1 = *(const LAS f32x4*)(CWf + tap * 384 + cg * 8 + 4);
            a[0] += x[0] * w0.x; a[1] += x[1] * w0.y; a[2] += x[2] * w0.z; a[3] += x[3] * w0.w; a[4] += x[4] * w1.x; a[5] += x[5] * w1.y; a[6] += x[6] * w1.z; a[7] += x[7] * w1.w; }
#pragma unroll
        for (int e = 0; e < 8; ++e) val[i][e] = silu_f(a[e]); }
    float sq = 0.f, sk = 0.f;
#pragma unroll
    for (int e = 0; e < 8; ++e) { sq += val[0][e] * val[0][e] + val[1][e] * val[1][e]; sk += val[2][e] * val[2][e] + val[3][e] * val[3][e]; }
#pragma unroll
    for (int o = 1; o < 8; o <<= 1) { sq += __shfl_xor(sq, o); sk += __shfl_xor(sk, o); }
    const float rq = rsqrtf(sq + 1e-6f) * 0.08838834764831845f, rk = rsqrtf(sk + 1e-6f);
    const float bt = SCf[64 + tok], egt = SCf[128 + tok];
    LDS_WAIT(); __syncthreads();
    unsigned char* AQD = F.ws + FRB_AQD + (size_t)ci * 16384;
#pragma unroll
    for (int i = 0; i < 2; ++i) { const int dk0 = (i * 8 + sub) * 8;
        float q[8];
#pragma unroll
        for (int e = 0; e < 8; ++e) q[e] = val[i][e] * rq;
        v4u w; w.x = pk2(q[0], q[1]); w.y = pk2(q[2], q[3]); w.z = pk2(q[4], q[5]); w.w = pk2(q[6], q[7]);
        *(LAS v4u*)(L + QHI + tok * IMS + dk0 * 2) = w;
        const int s = dk0 >> 5, jh = (dk0 >> 4) & 1, g2 = (dk0 >> 3) & 1, mt = tok >> 4, m = tok & 15;
#pragma unroll
        for (int half = 0; half < 2; ++half) { const int g = 2 * g2 + half;
            v2u o; o.x = pk2(q[4 * half] * egt, q[4 * half + 1] * egt); o.y = pk2(q[4 * half + 2] * egt, q[4 * half + 3] * egt);
            *(GAS v2u*)(AQD + ((size_t)((mt * 4 + s) * 64 + m + 16 * g) * 8 + 4 * jh) * 2) = o; } }
#pragma unroll
    for (int i = 0; i < 2; ++i) { const int dk0 = (i * 8 + sub) * 8;
        float k[8];
#pragma unroll
        for (int e = 0; e < 8; ++e) k[e] = val[2 + i][e] * rk;
        v4u w; w.x = pk2(k[0], k[1]); w.y = pk2(k[2], k[3]); w.z = pk2(k[4], k[5]); w.w = pk2(k[6], k[7]);
        *(LAS v4u*)(L + KHI + tok * IMS + dk0 * 2) = w;
        v4u wb; wb.x = pk2(k[0] * bt, k[1] * bt); wb.y = pk2(k[2] * bt, k[3] * bt); wb.z = pk2(k[4] * bt, k[5] * bt); wb.w = pk2(k[6] * bt, k[7] * bt);
        *(LAS v4u*)(L + KBI + tok * IMS + dk0 * 2) = wb;
        const float f = bt * egt;
        *(LAS f32x4*)(L + KG + tok * 512 + dk0 * 4) = (f32x4){k[0] * f, k[1] * f, k[2] * f, k[3] * f};
        *(LAS f32x4*)(L + KG + tok * 512 + dk0 * 4 + 16) = (f32x4){k[4] * f, k[5] * f, k[6] * f, k[7] * f}; }
#pragma unroll
    for (int i = 0; i < 2; ++i) { const int dv0 = (i * 8 + sub) * 8;
        *(LAS f32x4*)(L + VB + tok * 512 + dv0 * 4) = (f32x4){val[4 + i][0] * bt, val[4 + i][1] * bt, val[4 + i][2] * bt, val[4 + i][3] * bt};
        *(LAS f32x4*)(L + VB + tok * 512 + dv0 * 4 + 16) = (f32x4){val[4 + i][4] * bt, val[4 + i][5] * bt, val[4 + i][6] * bt, val[4 + i][7] * bt}; }
    LDS_WAIT(); __syncthreads();
    const int kind = wave >> 2, ti = wave & 3, m16 = lane & 15, g4 = lane >> 4;
    f32x4 acc[4];
#pragma unroll
    for (int tj = 0; tj < 4; ++tj) acc[tj] = (f32x4){0.f, 0.f, 0.f, 0.f};
#pragma unroll
    for (int s = 0; s < 4; ++s) {
        const bf16x8 A = *(const LAS bf16x8*)(L + (kind == 0 ? KBI : QHI) + (16 * ti + m16) * IMS + (32 * s + 8 * g4) * 2);
#pragma unroll
        for (int tj = 0; tj < 4; ++tj) if (tj <= ti) {
            const bf16x8 B = *(const LAS bf16x8*)(L + KHI + (16 * tj + m16) * IMS + (32 * s + 8 * g4) * 2);
            acc[tj] = __builtin_amdgcn_mfma_f32_16x16x32_bf16(A, B, acc[tj], 0, 0, 0); }
    }
    {
        unsigned char* AKD = fr_akd(F) + (size_t)ci * 16384;
#pragma unroll
        for (int rep = 0; rep < 2; ++rep) { const int lf = tid + 512 * rep, frag = lf >> 6, ln = lf & 63, Tt = frag >> 1, s2 = frag & 1, m = ln & 15, g = ln >> 4;
            float kd[8];
#pragma unroll
            for (int j = 0; j < 8; ++j) { const int tk = 32 * s2 + 16 * (j >> 2) + 4 * g + (j & 3);
                const unsigned short hv = *(const LAS unsigned short*)(L + KHI + tk * IMS + (16 * Tt + m) * 2);
                kd[j] = __builtin_bit_cast(float, (unsigned)hv << 16) * SCf[192 + tk]; }
            v4u o; o.x = pk2(kd[0], kd[1]); o.y = pk2(kd[2], kd[3]); o.z = pk2(kd[4], kd[5]); o.w = pk2(kd[6], kd[7]);
            *(GAS v4u*)(AKD + (size_t)lf * 16) = o; }
    }
    LDS_WAIT(); __syncthreads();
#pragma unroll
    for (int tj = 0; tj < 4; ++tj)
#pragma unroll
        for (int r = 0; r < 4; ++r) { const int i = 16 * ti + 4 * g4 + r, j = 16 * tj + m16;
            const float dec = (tj <= ti && i >= j) ? __expf(SCf[i] - SCf[j]) : 0.f;
            const float v = (tj <= ti) ? acc[tj][r] * dec : 0.f;
            if (kind == 0) { if (tj <= ti) *(LAS float*)(L + LM + i * 256 + j * 4) = (i > j) ? v : 0.f; }
            else *(LAS unsigned short*)(L + QKI + i * QKS + j * 2) = (unsigned short)f2bf(v); }
    LDS_WAIT(); __syncthreads();
    if (wave < 4) {
        const int c = tid;
        const LAS unsigned char* rhsp = L + (c < 128 ? VB : KG) + (c & 127) * 4;
        float x[64];
#pragma unroll
        for (int i = 0; i < 64; ++i) {
            float sum = *(const LAS float*)(rhsp + i * 512);
#pragma unroll
            for (int j4 = 0; j4 < (i + 3) / 4; ++j4) { const f32x4 l = *(const LAS f32x4*)(L + LM + i * 256 + j4 * 16);
                if (4 * j4 + 0 < i) sum -= l.x * x[4 * j4 + 0];
                if (4 * j4 + 1 < i) sum -= l.y * x[4 * j4 + 1];
                if (4 * j4 + 2 < i) sum -= l.z * x[4 * j4 + 2];
                if (4 * j4 + 3 < i) sum -= l.w * x[4 * j4 + 3]; }
            x[i] = sum;
        }
        if (c < 128) {
            unsigned char* U = fr_u(F) + (size_t)ci * 16384 + (size_t)(c >> 4) * 2048;
#pragma unroll
            for (int mt = 0; mt < 4; ++mt)
#pragma unroll
                for (int g = 0; g < 4; ++g) { const int t0 = 16 * mt + 4 * g; v2u o; o.x = pk2(x[t0], x[t0 + 1]); o.y = pk2(x[t0 + 2], x[t0 + 3]);
                    *(GAS v2u*)(U + (size_t)(mt * 64 + (c & 15) + 16 * g) * 8) = o; }
        } else {
            const int dk = c - 128;
#pragma unroll
            for (int i = 0; i < 64; ++i) *(LAS unsigned short*)(L + WIM + i * IMS + dk * 2) = (unsigned short)f2bf(x[i]);
        }
    } else {
        unsigned char* AQK = F.ws + FRB_AQK + (size_t)ci * 8192;
#pragma unroll
        for (int rep = 0; rep < 2; ++rep) { const int lf = (tid - 256) + 256 * rep, frag = lf >> 6, ln = lf & 63, mt = frag >> 1, s2 = frag & 1, m = ln & 15, g = ln >> 4;
            const v2u a = *(const LAS v2u*)(L + QKI + (16 * mt + m) * QKS + (32 * s2 + 4 * g) * 2);
            const v2u bq = *(const LAS v2u*)(L + QKI + (16 * mt + m) * QKS + (32 * s2 + 16 + 4 * g) * 2);
            *(GAS v4u*)(AQK + (size_t)lf * 16) = (v4u){a.x, a.y, bq.x, bq.y}; }
    }
    LDS_WAIT(); __syncthreads();
    {
        unsigned char* AW = F.ws + FRB_AW + (size_t)ci * 16384;
#pragma unroll
        for (int rep = 0; rep < 2; ++rep) { const int lf = tid + 512 * rep, frag = lf >> 6, ln = lf & 63, mt = frag >> 2, s = frag & 3, m = ln & 15, g = ln >> 4;
            const v2u a = *(const LAS v2u*)(L + WIM + (16 * mt + m) * IMS + (32 * s + 4 * g) * 2);
            const v2u bq = *(const LAS v2u*)(L + WIM + (16 * mt + m) * IMS + (32 * s + 16 + 4 * g) * 2);
            *(GAS v4u*)(AW + (size_t)lf * 16) = (v4u){a.x, a.y, bq.x, bq.y}; }
    }
    LDS_WAIT(); __syncthreads();
}
__device__ __forceinline__ void scan_phase(Frame& F) {
    if (F.wave != 0) return;
    constexpr int BUFB = 59392;
    const int unit = (int)blockIdx.x, bh = unit >> 3, sl = unit & 7, b = bh >> 2, h = bh & 3, lane = F.lane, dvl = lane & 15, g = lane >> 4;
    LAS unsigned char* L = F.lds;
    const unsigned char* gAW = F.ws + FRB_AW + (size_t)bh * 32 * 16384 + lane * 16;
    const unsigned char* gAQD = F.ws + FRB_AQD + (size_t)bh * 32 * 16384 + lane * 16;
    const unsigned char* gAKD = fr_akd(F) + (size_t)bh * 32 * 16384 + lane * 16;
    const unsigned char* gAQK = F.ws + FRB_AQK + (size_t)bh * 32 * 8192 + lane * 16;
    const unsigned char* gU = fr_u(F) + (size_t)bh * 32 * 16384 + (size_t)sl * 2048 + lane * 16;
    const float* GL = (const float*)(F.ws + FRB_GL) + bh * 32;
    bf16* MIX = (bf16*)(F.ws + WS_XM);
#define SCAN_ISSUE(n_, buf_) do { LAS unsigned char* B_ = L + (buf_) * BUFB; \
        _Pragma("unroll") for (int f_ = 0; f_ < 16; ++f_) __builtin_amdgcn_global_load_lds((const unsigned*)(gAW + (size_t)(n_) * 16384 + f_ * 1024), (LAS unsigned*)(B_ + f_ * 1024), 16, 0, 0); \
        _Pragma("unroll") for (int f_ = 0; f_ < 16; ++f_) __builtin_amdgcn_global_load_lds((const unsigned*)(gAQD + (size_t)(n_) * 16384 + f_ * 1024), (LAS unsigned*)(B_ + 16384 + f_ * 1024), 16, 0, 0); \
        _Pragma("unroll") for (int f_ = 0; f_ < 16; ++f_) __builtin_amdgcn_global_load_lds((const unsigned*)(gAKD + (size_t)(n_) * 16384 + f_ * 1024), (LAS unsigned*)(B_ + 32768 + f_ * 1024), 16, 0, 0); \
        _Pragma("unroll") for (int f_ = 0; f_ < 8; ++f_) __builtin_amdgcn_global_load_lds((const unsigned*)(gAQK + (size_t)(n_) * 8192 + f_ * 1024), (LAS unsigned*)(B_ + 49152 + f_ * 1024), 16, 0, 0); \
        _Pragma("unroll") for (int f_ = 0; f_ < 2; ++f_) __builtin_amdgcn_global_load_lds((const unsigned*)(gU + (size_t)(n_) * 16384 + f_ * 1024), (LAS unsigned*)(B_ + 57344 + f_ * 1024), 16, 0, 0); } while (0)
    f32x4 St[8];
#pragma unroll
    for (int t = 0; t < 8; ++t) St[t] = (f32x4){0.f, 0.f, 0.f, 0.f};
    SCAN_ISSUE(0, 0);
    float gl_next = __hip_atomic_load(GL, __ATOMIC_RELAXED, __HIP_MEMORY_SCOPE_AGENT);
    for (int n = 0; n < 32; ++n) {
        asm volatile("s_waitcnt vmcnt(0)" ::: "memory");
        asm volatile("" : "+v"(gl_next));
        const float gl = gl_next;
        if (n + 1 < 32) { SCAN_ISSUE(n + 1, (n + 1) & 1); gl_next = __hip_atomic_load(GL + n + 1, __ATOMIC_RELAXED, __HIP_MEMORY_SCOPE_AGENT); }
        const LAS unsigned char* B = L + (n & 1) * BUFB + lane * 16;
        bf16x8 Bs[4];
#pragma unroll
        for (int s = 0; s < 4; ++s) { v4u w; w.x = pk2(St[2 * s][0], St[2 * s][1]); w.y = pk2(St[2 * s][2], St[2 * s][3]); w.z = pk2(St[2 * s + 1][0], St[2 * s + 1][1]); w.w = pk2(St[2 * s + 1][2], St[2 * s + 1][3]);
            Bs[s] = __builtin_bit_cast(bf16x8, w); }
        f32x4 accA[4], accO[4];
#pragma unroll
        for (int mt = 0; mt < 4; ++mt) { accA[mt] = (f32x4){0.f, 0.f, 0.f, 0.f}; accO[mt] = (f32x4){0.f, 0.f, 0.f, 0.f}; }
#pragma unroll
        for (int mt = 0; mt < 4; ++mt)
#pragma unroll
            for (int s = 0; s < 4; ++s) accA[mt] = __builtin_amdgcn_mfma_f32_16x16x32_bf16(*(const LAS bf16x8*)(B + (mt * 4 + s) * 1024), Bs[s], accA[mt], 0, 0, 0);
#pragma unroll
        for (int mt = 0; mt < 4; ++mt)
#pragma unroll
            for (int s = 0; s < 4; ++s) accO[mt] = __builtin_amdgcn_mfma_f32_16x16x32_bf16(*(const LAS bf16x8*)(B + 16384 + (mt * 4 + s) * 1024), Bs[s], accO[mt], 0, 0, 0);
        f32x4 vn[4];
#pragma unroll
        for (int mt = 0; mt < 4; ++mt) { const v2u uw = *(const LAS v2u*)(L + (n & 1) * BUFB + 57344 + (mt * 64 + lane) * 8);
            vn[mt] = (f32x4){bf_lo(uw.x), bf_hi(uw.x), bf_lo(uw.y), bf_hi(uw.y)} - accA[mt]; }
        bf16x8 Bv[2];
#pragma unroll
        for (int s2 = 0; s2 < 2; ++s2) { v4u w; w.x = pk2(vn[2 * s2][0], vn[2 * s2][1]); w.y = pk2(vn[2 * s2][2], vn[2 * s2][3]); w.z = pk2(vn[2 * s2 + 1][0], vn[2 * s2 + 1][1]); w.w = pk2(vn[2 * s2 + 1][2], vn[2 * s2 + 1][3]);
            Bv[s2] = __builtin_bit_cast(bf16x8, w); }
#pragma unroll
        for (int mt = 0; mt < 4; ++mt)
#pragma unroll
            for (int s2 = 0; s2 < 2; ++s2) accO[mt] = __builtin_amdgcn_mfma_f32_16x16x32_bf16(*(const LAS bf16x8*)(B + 49152 + (mt * 2 + s2) * 1024), Bv[s2], accO[mt], 0, 0, 0);
#pragma unroll
        for (int mt = 0; mt < 4; ++mt)
#pragma unroll
            for (int r = 0; r < 4; ++r) MIX[(size_t)(b * T + 64 * n + 16 * mt + 4 * g + r) * D + h * 128 + 16 * sl + dvl] = (bf16)f2bf(accO[mt][r]);
#pragma unroll
        for (int t = 0; t < 8; ++t) { St[t] = St[t] * gl;
#pragma unroll
            for (int s2 = 0; s2 < 2; ++s2) St[t] = __builtin_amdgcn_mfma_f32_16x16x32_bf16(*(const LAS bf16x8*)(B + 32768 + (t * 2 + s2) * 1024), Bv[s2], St[t], 0, 0, 0); }
    }
#undef SCAN_ISSUE
    float* So = F.out + O_SSM_P + (size_t)bh * 128 * 128;
#pragma unroll
    for (int t = 0; t < 8; ++t)
#pragma unroll
        for (int r = 0; r < 4; ++r) So[(size_t)(16 * t + 4 * g + r) * 128 + 16 * sl + dvl] = St[t][r];
}
__device__ __forceinline__ void p8_rows(Frame& F) {
    const int gw = F.vcu * NWAVES + F.wave, NGW = F.G * NWAVES, lane = F.lane;
    bf16* MIX = (bf16*)(F.ws + WS_XM); const bf16* P = (const bf16*)(F.ws + WS_HP);
    for (int m = gw; m < M; m += NGW) {
        const bool prm = m < MP; const int t = prm ? (m & (T - 1)) : ((m - MP) & 3), sq = prm ? (m >> 11) : ((m - MP) >> 2);
        if (prm) {
            float o[8], og[8]; unpack8(*(const GAS v4u*)(MIX + (size_t)m * D + lane * 8), o); unpack8(*(const GAS v4u*)(P + (size_t)m * NIN + PC_OG + lane * 8), og);
            float ss = 0.f;
#pragma unroll
            for (int e = 0; e < 8; ++e) ss += o[e] * o[e];
#pragma unroll
            for (int of = 1; of < 16; of <<= 1) ss += __shfl_xor(ss, of);
            const float rn = rsqrtf(ss * (1.f / 128.f) + 1e-6f);
            const f32x4 g0 = *(const f32x4*)(F.in_21 + (lane & 15) * 8), g1 = *(const f32x4*)(F.in_21 + (lane & 15) * 8 + 4);
            const float gg[8] = {g0.x, g0.y, g0.z, g0.w, g1.x, g1.y, g1.z, g1.w};
            float r[8];
#pragma unroll
            for (int e = 0; e < 8; ++e) r[e] = o[e] * rn * gg[e] * silu_f(og[e]);
            *(GAS v4u*)(MIX + (size_t)m * D + lane * 8) = (v4u){pk2(r[0], r[1]), pk2(r[2], r[3]), pk2(r[4], r[5]), pk2(r[6], r[7])};
        }
        float zc[8], z2[8];
#pragma unroll
        for (int e = 0; e < 8; ++e) zc[e] = 0.f;
#pragma unroll
        for (int i = 0; i < 3; ++i) { const int tt = t - 2 + i; float z[8];
            if (tt >= 0) { float c[8], hh[8]; unpack8(*(const GAS v4u*)(P + (size_t)(m - 2 + i) * NIN + PC_SC + lane * 8), c); unpack8(*(const GAS v4u*)(P + (size_t)(m - 2 + i) * NIN + PC_SH + lane * 8), hh);
#pragma unroll
                for (int e = 0; e < 8; ++e) z[e] = c[e] * hh[e]; }
            else if (!prm) { const float* sb = F.in_4 + ((size_t)sq * 2 + (2 + tt)) * 512 + lane * 8; const f32x4 a = *(const f32x4*)sb, bq = *(const f32x4*)(sb + 4);
                z[0] = a.x; z[1] = a.y; z[2] = a.z; z[3] = a.w; z[4] = bq.x; z[5] = bq.y; z[6] = bq.z; z[7] = bq.w; }
            else {
#pragma unroll
                for (int e = 0; e < 8; ++e) z[e] = 0.f; }
            const f32x4 w0 = *(const f32x4*)(F.in_22 + i * 512 + lane * 8), w1 = *(const f32x4*)(F.in_22 + i * 512 + lane * 8 + 4);
            zc[0] += z[0] * w0.x; zc[1] += z[1] * w0.y; zc[2] += z[2] * w0.z; zc[3] += z[3] * w0.w; zc[4] += z[4] * w1.x; zc[5] += z[5] * w1.y; zc[6] += z[6] * w1.z; zc[7] += z[7] * w1.w;
            if (i == 2) {
#pragma unroll
                for (int e = 0; e < 8; ++e) z2[e] = z[e]; }
        }
        float sb[8]; unpack8(*(const GAS v4u*)(P + (size_t)m * NIN + PC_SB + lane * 8), sb);
        *(GAS v4u*)(MIX + (size_t)m * D + 512 + lane * 8) = (v4u){pk2(sb[0] * zc[0], sb[1] * zc[1]), pk2(sb[2] * zc[2], sb[3] * zc[3]), pk2(sb[4] * zc[4], sb[5] * zc[5]), pk2(sb[6] * zc[6], sb[7] * zc[7])};
        const int Tg = prm ? T : TS;
        if (t >= Tg - 2) { float* cm = F.out + (prm ? O_CM_P : O_CM_S) + ((size_t)(prm ? sq : sq) * 2 + (t - (Tg - 2))) * 512 + lane * 8;
            *(f32x4*)cm = (f32x4){z2[0], z2[1], z2[2], z2[3]}; *(f32x4*)(cm + 4) = (f32x4){z2[4], z2[5], z2[6], z2[7]}; }
        if (t >= Tg - 3) { float* cq = F.out + (prm ? O_CQ_P : O_CQ_S) + ((size_t)sq * 3 + (t - (Tg - 3))) * QKV;
#pragma unroll
            for (int j = 0; j < 3; ++j) { float q[8]; unpack8(*(const GAS v4u*)(P + (size_t)m * NIN + j * 512 + lane * 8), q);
                *(f32x4*)(cq + j * 512 + lane * 8) = (f32x4){q[0], q[1], q[2], q[3]}; *(f32x4*)(cq + j * 512 + lane * 8 + 4) = (f32x4){q[4], q[5], q[6], q[7]}; } }
    }
}
__device__ __forceinline__ void p8_sample_unit(Frame& F, int unit) {
    int tid_l = F.tid; asm volatile("" : "+v"(tid_l));
    const int sq = unit >> 2, h = unit & 3, tid = tid_l, lane = tid & 63, wave = F.wave;
    LAS float* Lf = (LAS float*)F.lds;
    LAS float* QKV_ = Lf;
    LAS float* RED = Lf + 1536;
    LAS float* SCAL = Lf + 2048;
    LAS float* OB = Lf + 2080;
    const bf16* P = (const bf16*)(F.ws + WS_HP); const float* GB = (const float*)(F.ws + WS_GB);
    const int m0 = MP + 4 * sq;
    if (tid < 384) { const int part = tid >> 7, ch = tid & 127, c = part * 512 + h * 128 + ch;
        float xp[7];
#pragma unroll
        for (int i = 0; i < 3; ++i) xp[i] = F.in_3[((size_t)sq * 3 + i) * QKV + c];
#pragma unroll
        for (int t = 0; t < 4; ++t) xp[3 + t] = __builtin_bit_cast(float, (unsigned)P[(size_t)(m0 + t) * NIN + c] << 16);
        const float w0 = F.in_18[c], w1 = F.in_18[QKV + c], w2 = F.in_18[2 * QKV + c], w3 = F.in_18[3 * QKV + c];
#pragma unroll
        for (int t = 0; t < 4; ++t) QKV_[(part * 4 + t) * 128 + ch] = silu_f(xp[t] * w0 + xp[t + 1] * w1 + xp[t + 2] * w2 + xp[t + 3] * w3); }
    LDS_WAIT(); __syncthreads();
    {
        const int part = wave >> 2, t = wave & 3; const float a = QKV_[(part * 4 + t) * 128 + lane], bq = QKV_[(part * 4 + t) * 128 + 64 + lane];
        const float ss = wave_sum(a * a + bq * bq); const float rn = rsqrtf(ss + 1e-6f) * (part == 0 ? 0.08838834764831845f : 1.0f);
        QKV_[(part * 4 + t) * 128 + lane] = a * rn; QKV_[(part * 4 + t) * 128 + 64 + lane] = bq * rn; }
    LDS_WAIT(); __syncthreads();
    const int kq = tid >> 7, dv = tid & 127;
    float S[32];
    const float* S0 = F.in_2 + ((size_t)(sq * 4 + h) * 128 + 32 * kq) * 128 + dv;
#pragma unroll
    for (int i = 0; i < 32; ++i) S[i] = S0[(size_t)i * 128];
#pragma unroll 1
    for (int t = 0; t < 4; ++t) {
        const float dec = __expf(GB[(size_t)(m0 + t) * 4 + h]), bt = GB[(size_t)M * 4 + (size_t)(m0 + t) * 4 + h];
        const LAS float* qv = QKV_ + (0 * 4 + t) * 128 + 32 * kq; const LAS float* kv = QKV_ + (1 * 4 + t) * 128 + 32 * kq;
        float ks = 0.f;
#pragma unroll
        for (int i = 0; i < 32; ++i) { S[i] *= dec; ks += kv[i] * S[i]; }
        RED[kq * 128 + dv] = ks;
        LDS_WAIT(); __syncthreads();
        const float kS = (RED[dv] + RED[128 + dv]) + (RED[256 + dv] + RED[384 + dv]);
        const float vn = bt * (QKV_[(2 * 4 + t) * 128 + dv] - kS);
        float o = 0.f;
#pragma unroll
        for (int i = 0; i < 32; ++i) { S[i] += kv[i] * vn; o += qv[i] * S[i]; }
        LDS_WAIT(); __syncthreads();
        RED[kq * 128 + dv] = o;
        LDS_WAIT(); __syncthreads();
        if (kq == 0) OB[t * 128 + dv] = (RED[dv] + RED[128 + dv]) + (RED[256 + dv] + RED[384 + dv]);
        LDS_WAIT(); __syncthreads();
    }
    float* So = F.out + O_SSM_S + ((size_t)(sq * 4 + h) * 128 + 32 * kq) * 128 + dv;
#pragma unroll
    for (int i = 0; i < 32; ++i) So[(size_t)i * 128] = S[i];
    if (wave < 4) { const int t = wave; const float a = OB[t * 128 + lane], bq = OB[t * 128 + 64 + lane];
        const float rn = rsqrtf(wave_sum(a * a + bq * bq) * (1.f / 128.f) + 1e-6f);
        bf16* MIX = (bf16*)(F.ws + WS_XM);
        const float og0 = __builtin_bit_cast(float, (unsigned)P[(size_t)(m0 + t) * NIN + PC_OG + h * 128 + lane] << 16), og1 = __builtin_bit_cast(float, (unsigned)P[(size_t)(m0 + t) * NIN + PC_OG + h * 128 + 64 + lane] << 16);
        MIX[(size_t)(m0 + t) * D + h * 128 + lane] = (bf16)f2bf(a * rn * F.in_21[lane] * silu_f(og0));
        MIX[(size_t)(m0 + t) * D + h * 128 + 64 + lane] = (bf16)f2bf(bq * rn * F.in_21[64 + lane] * silu_f(og1)); }
    LDS_WAIT(); __syncthreads();
}
struct Args { const float* in[24]; float* out; unsigned char* ws; int ph_lo, ph_hi; };
constexpr int N_PHASES = 14;
__global__ void __launch_bounds__(NWAVES * 64, 2) mk_fwd(Args args) {
    extern __shared__ __attribute__((aligned(16))) unsigned char lds[];
    Frame F;
    F.lds = (LAS unsigned char*)lds;
    F.MISC = (volatile LAS unsigned*)(F.lds + MISC_OFF);
    F.tid = threadIdx.x; F.lane = F.tid & 63; F.wave = __builtin_amdgcn_readfirstlane(F.tid >> 6);
    F.G = gridDim.x; { const int bx = blockIdx.x; F.vcu = (F.G % 8 == 0) ? (bx % 8) * (F.G / 8) + bx / 8 : bx; }
    F.in_0 = args.in[0]; F.in_1 = args.in[1]; F.in_2 = args.in[2]; F.in_3 = args.in[3]; F.in_4 = args.in[4]; F.in_5 = args.in[5]; F.in_6 = args.in[6]; F.in_7 = args.in[7]; F.in_8 = args.in[8]; F.in_9 = args.in[9]; F.in_10 = args.in[10]; F.in_11 = args.in[11];
    F.in_12 = args.in[12]; F.in_13 = args.in[13]; F.in_14 = args.in[14]; F.in_15 = args.in[15]; F.in_16 = args.in[16]; F.in_17 = args.in[17]; F.in_18 = args.in[18]; F.in_19 = args.in[19]; F.in_20 = args.in[20]; F.in_21 = args.in[21]; F.in_22 = args.in[22]; F.in_23 = args.in[23];
    F.out = args.out; F.ws = args.ws;
    F.ctl = (gu32*)(F.ws + WS_CTL);
    for (int u = F.tid; u < (LDS_BYTES - LDSCTL_OFF) / 4; u += NWAVES * 64) ((LAS unsigned*)(F.lds + LDSCTL_OFF))[u] = 0u;
    __syncthreads();
    XcdBarrier bar = xcd_barrier_post((unsigned*)(F.ctl + CW_BAR), F.MISC + 8);
    const int lo = args.ph_lo, hi = args.ph_hi;
#ifndef PHASE_MASK
#define PHASE_MASK 0xFFFFF
#endif
#define IN(k) (((PHASE_MASK >> (k)) & 1) && lo <= (k) && (k) < hi)
#define FRESH() do { int t_ = threadIdx.x; asm volatile("" : "+v"(t_)); F.tid = t_; F.lane = t_ & 63; } while (0)
#define SEAM(k) do { if (IN(k) && IN((k) + 1)) xcd_barrier(bar); } while (0)
    bf16* const XM = (bf16*)(F.ws + WS_XM); bf16* const Yb = (bf16*)(F.ws + WS_Y); bf16* const HB = (bf16*)(F.ws + WS_HP);

    if (IN(0)) { FRESH(); p0_ada(F); p0_convert(F); } SEAM(0);
    if (IN(1)) { FRESH(); p1_mod(F); } SEAM(1);
    if (IN(2)) { FRESH();
        pg8::Gemm g{XM, (const bf16*)(F.ws + WS_W1U), M, NUP, D}; pg8::StaticOrder S; S.init(M, NUP, F.G, (int)blockIdx.x);
        pg8::EpiSwiglu E{HB, FF};
        pg8::gemm_phase<pg8::EpiSwiglu, pg8::StaticOrder, true, true>(F.lds + RING_OFF, g, S, E);
    } SEAM(2);
    if (IN(3)) { FRESH();
        pg8::Gemm g{HB, (const bf16*)(F.ws + WS_W1D), M, D, FF}; pg8::StaticOrder S; S.init(M, D, F.G, (int)blockIdx.x);
        pg8::EpiBf16P E{Yb, D};
        pg8::gemm_phase<pg8::EpiBf16P, pg8::StaticOrder, true, true>(F.lds + RING_OFF, g, S, E);
    } SEAM(3);
    if (IN(4)) { FRESH(); ln_pass<0>(F, 0.5f); } SEAM(4);
    if (IN(5)) { FRESH();
        pg8::Gemm g{XM, (const bf16*)(F.ws + WS_WIN), M, NIN, D}; pg8::StaticOrder S; S.init(M, NIN, F.G, (int)blockIdx.x);
        pg8::EpiBf16P E{HB, NIN};
        pg8::gemm_phase<pg8::EpiBf16P, pg8::StaticOrder, true, true>(F.lds + RING_OFF, g, S, E);
    } SEAM(5);
    if (IN(6)) { FRESH(); for (int ci = (int)blockIdx.x; ci < 1024; ci += F.G) d1_unit(F, ci); } SEAM(6);
    if (IN(7)) { FRESH(); scan_phase(F); } SEAM(7);
    if (IN(8)) { FRESH(); p8_rows(F); for (int u = (int)blockIdx.x; u < 4 * NS; u += F.G) p8_sample_unit(F, u); } SEAM(8);
    if (IN(9)) { FRESH();
        pg8::Gemm g{XM, (const bf16*)(F.ws + WS_WOUT), M, D, D}; pg8::StaticOrder S; S.init(M, D, F.G, (int)blockIdx.x);
        pg8::EpiBf16P E{Yb, D};
        pg8::gemm_phase<pg8::EpiBf16P, pg8::StaticOrder, true, true>(F.lds + RING_OFF, g, S, E);
    } SEAM(9);
    if (IN(10)) { FRESH(); ln_pass<1>(F, 1.0f); } SEAM(10);
    if (IN(11)) { FRESH();
        pg8::Gemm g{XM, (const bf16*)(F.ws + WS_W2U), M, NUP, D}; pg8::StaticOrder S; S.init(M, NUP, F.G, (int)blockIdx.x);
        pg8::EpiSwiglu E{HB, FF};
        pg8::gemm_phase<pg8::EpiSwiglu, pg8::StaticOrder, true, true>(F.lds + RING_OFF, g, S, E);
    } SEAM(11);
    if (IN(12)) { FRESH();
        pg8::Gemm g{HB, (const bf16*)(F.ws + WS_W2D), M, D, FF}; pg8::StaticOrder S; S.init(M, D, F.G, (int)blockIdx.x);
        pg8::EpiBf16P E{Yb, D};
        pg8::gemm_phase<pg8::EpiBf16P, pg8::StaticOrder, true, true>(F.lds + RING_OFF, g, S, E);
    } SEAM(12);
    if (IN(13)) { FRESH(); ln_pass<2>(F, 0.5f); }
#undef IN
#undef SEAM
}
extern "C" void kernel_launch(void* const* d_in, const int* in_sizes, int n_in, void* d_out, int out_size, void* d_ws, size_t ws_size, hipStream_t stream) {
    static int ok = 0;
    if (ok == 0) {
        int dev = 0, cus = 0;
        if (n_in != 24 || out_size != (int)O_END || ws_size < WS_END || hipGetDevice(&dev) != hipSuccess || hipDeviceGetAttribute(&cus, hipDeviceAttributeMultiprocessorCount, dev) != hipSuccess || cus < 256 ||
            hipFuncSetAttribute((const void*)mk_fwd, hipFuncAttributeMaxDynamicSharedMemorySize, LDS_BYTES) != hipSuccess) {
            fprintf(stderr, "kernel_launch: unexpected problem/device (n_in %d out %d ws %zu cus %d); nothing launched\n", n_in, out_size, ws_size, cus); ok = -1; return; }
        ok = 1;
    }
    if (ok < 0) return;
    (void)hipMemsetAsync((char*)d_ws + WS_CTL, 0, CTL_ZERO_BYTES, stream);
    Args a{};
    for (int i = 0; i < 24; ++i) a.in[i] = (const float*)d_in[i];
    a.out = (float*)d_out; a.ws = (unsigned char*)d_ws; a.ph_lo = 0; a.ph_hi = N_PHASES;
    hipLaunchKernelGGL(mk_fwd, dim3(256), dim3(NWAVES * 64), LDS_BYTES, stream, a);
}
```

```cpp
#include <hip/hip_runtime.h>
#include <cstdio>
#include <cstdint>
namespace pg8 {
#define PG8_LAS __attribute__((address_space(3)))
typedef unsigned short bf16_t;
typedef short bf16x8 __attribute__((ext_vector_type(8)));
typedef float f32x4 __attribute__((ext_vector_type(4)));
typedef unsigned u32x4 __attribute__((ext_vector_type(4)));
constexpr int BM = 256, BK = 64, HALF = 128, HTB = HALF * BK * 2  , STAGE_BYTES = 8 * HTB, NXCD = 8, WGM = 8;

__host__ __device__ __forceinline__ int lds_byte(int r, int c) { const int st = (r >> 4) * 2 + (c >> 5), rr = r & 15, cc = c & 31, ob = rr * 64 + cc * 2; return st * 1024 + (ob ^ (((ob >> 9) & 1) << 5)); }
__host__ __device__ __forceinline__ void stage_rc(int b, int& R, int& C) { const int st = b / 1024, sb = b % 1024, swz = sb ^ (((sb >> 9) & 1) << 5); R = (st >> 1) * 16 + swz / 64; C = (st & 1) * 32 + (swz % 64) / 2; }
__host__ __device__ __forceinline__ int perm32(int rho) { const int n = rho >> 4, i = rho & 15; return 8 * (i >> 2) + 4 * n + (i & 3); }

struct Unit { int pm, pn; };
struct Gemm { const bf16_t* A; const bf16_t* Bt; int M, N, K; };

struct StaticOrder {
    int nM, nN, nwg, G, c;
    __host__ __device__ void init(int M, int N, int G_, int c_) { nM = M / BM; nN = N / BM; nwg = nM * nN; G = G_; c = c_; }
    __host__ __device__ bool next(int i, Unit& u) const {
        const long L = (long)i * G + c; if (L >= nwg) return false;
        int wgid = (int)L; { const int q = nwg / NXCD, r = nwg % NXCD, xcd = wgid % NXCD, off = wgid / NXCD; wgid = (xcd < r ? xcd * (q + 1) : r * (q + 1) + (xcd - r) * q) + off; }
        const int nig = WGM * nN, gid = wgid / nig, fm = gid * WGM, gsz = (nM - fm) < WGM ? (nM - fm) : WGM;
        u.pm = fm + ((wgid % nig) % gsz); u.pn = (wgid % nig) / gsz; return true;
    }
    __device__ __forceinline__ void a_ready(const Unit&) const {}
    __device__ __forceinline__ void done(const Unit&) const {}
};

__device__ __forceinline__ unsigned cvt_pk_bf16(float lo, float hi) { unsigned r; asm volatile("v_cvt_pk_bf16_f32 %0, %1, %2" : "=v"(r) : "v"(lo), "v"(hi)); return r; }
typedef float f32x2 __attribute__((ext_vector_type(2)));
struct EpiBf16P {
    static constexpr bool PERM = true, AFTER_DRAIN = false;
    bf16_t* O; int ldc; int split_pn; bf16_t* O2; int ldc2;
    __device__ __forceinline__ void operator()(const f32x4 (&acc)[2][2][4][2], const Unit& u, int wr, int wc, int fr, int fq) const {
        const bool second = split_pn > 0 && u.pn >= split_pn;
        bf16_t* const base = second ? O2 : O; const int ld = second ? ldc2 : ldc;
        const int row0 = u.pm * BM + wr * 64 + fr, col0 = (second ? u.pn - split_pn : u.pn) * BM + wc * 32 + 8 * fq;
#pragma unroll
        for (int ai = 0; ai < 2; ++ai)
#pragma unroll
            for (int m = 0; m < 4; ++m) { bf16_t* rowp = base + (size_t)(row0 + ai * HALF + m * 16) * ld + col0;
#pragma unroll
                for (int bj = 0; bj < 2; ++bj) { const f32x4 v0 = acc[ai][bj][m][0], v1 = acc[ai][bj][m][1];
                    u32x4 w; w.x = cvt_pk_bf16(v0[0], v0[1]); w.y = cvt_pk_bf16(v0[2], v0[3]); w.z = cvt_pk_bf16(v1[0], v1[1]); w.w = cvt_pk_bf16(v1[2], v1[3]);
                    *(u32x4*)(rowp + bj * HALF) = w; } }
    }
};
__device__ __forceinline__ float swiglu1(float g, float u) { return g * u * __builtin_amdgcn_rcpf(1.0f + __builtin_amdgcn_exp2f(-1.4426950408889634f * g)); }
struct EpiSwiglu {
    static constexpr bool PERM = true, AFTER_DRAIN = false;
    bf16_t* O; int ldc;
    __device__ __forceinline__ void operator()(const f32x4 (&acc)[2][2][4][2], const Unit& u, int wr, int wc, int fr, int fq) const {
        const int row0 = u.pm * BM + wr * 64 + fr, col0 = u.pn * HALF + wc * 32 + 8 * fq;
#pragma unroll
        for (int ai = 0; ai < 2; ++ai)
#pragma unroll
            for (int m = 0; m < 4; ++m) { bf16_t* rowp = O + (size_t)(row0 + ai * HALF + m * 16) * ldc + col0;
                const f32x4 g0 = acc[ai][0][m][0], g1 = acc[ai][0][m][1], u0 = acc[ai][1][m][0], u1 = acc[ai][1][m][1];
                u32x4 w; w.x = cvt_pk_bf16(swiglu1(g0[0], u0[0]), swiglu1(g0[1], u0[1])); w.y = cvt_pk_bf16(swiglu1(g0[2], u0[2]), swiglu1(g0[3], u0[3]));
                w.z = cvt_pk_bf16(swiglu1(g1[0], u1[0]), swiglu1(g1[1], u1[1])); w.w = cvt_pk_bf16(swiglu1(g1[2], u1[2]), swiglu1(g1[3], u1[3]));
                *(u32x4*)rowp = w; }
    }
};
template <class Epi, class Sched, bool ALIGN_EPI = false, bool SP2 = false>
__device__ __forceinline__ void gemm_phase(PG8_LAS unsigned char* lds, const Gemm g, const Sched& S, const Epi& E) {
    int tid_l = threadIdx.x; asm volatile("" : "+v"(tid_l));
    const int tid = tid_l, wid = __builtin_amdgcn_readfirstlane(tid >> 6), lane = tid & 63, wr = wid >> 2, wc = wid & 3, fr = lane & 15, fq = lane >> 4;
    const int K = g.K, nt = K / BK;
    unsigned voffA[2], voffB[2];
#pragma unroll
    for (int i = 0; i < 2; ++i) { int R, C; stage_rc(tid * 16 + i * 8192, R, C); const int Rb = Epi::PERM ? ((R & ~31) + perm32(R & 31)) : R;
        voffA[i] = (unsigned)(R * K + C) * 2u; voffB[i] = (unsigned)(Rb * K + C) * 2u; }
    const size_t kstep = (size_t)(BK * 2);
    const size_t hstep = (size_t)HALF * K * 2;
    const size_t tstep = 2 * hstep;
    const unsigned ldsw = (unsigned)wid * 1024u;
    const int aoff = lds_byte(wr * 64 + fr, fq * 8), boff = lds_byte(wc * 32 + fr, fq * 8);
#define PG8_SA(b, h) (((b) * 2 + (h)) * HTB)
#define PG8_SB(b, h) ((4 + (b) * 2 + (h)) * HTB)
#define PG8_STAGE(bufoff, gbase, voff) do { _Pragma("unroll") for (int _i = 0; _i < 2; ++_i) \
        __builtin_amdgcn_global_load_lds((const unsigned*)((const char*)(gbase) + (voff)[_i]), (PG8_LAS unsigned*)(lds + (bufoff) + ldsw + _i * 8192), 16, 0, 0); } while (0)
#define PG8_LDA(dst, b, h) do { _Pragma("unroll") for (int m = 0; m < 4; ++m) _Pragma("unroll") for (int k = 0; k < 2; ++k) dst[m][k] = *(const PG8_LAS bf16x8*)(lds + PG8_SA(b, h) + aoff + m * 2048 + k * 1024); } while (0)
#define PG8_LDB(dst, b, h) do { _Pragma("unroll") for (int n = 0; n < 2; ++n) _Pragma("unroll") for (int k = 0; k < 2; ++k) dst[n][k] = *(const PG8_LAS bf16x8*)(lds + PG8_SB(b, h) + boff + n * 2048 + k * 1024); } while (0)
#define PG8_MMA(ai, bj, At, Bt) do { __builtin_amdgcn_s_setprio(1); _Pragma("unroll") for (int m = 0; m < 4; ++m) _Pragma("unroll") for (int n = 0; n < 2; ++n) _Pragma("unroll") for (int k = 0; k < 2; ++k) \
        acc[ai][bj][m][n] = __builtin_amdgcn_mfma_f32_16x16x32_bf16(Bt[n][k], At[m][k], acc[ai][bj][m][n], 0, 0, 0); __builtin_amdgcn_s_setprio(0); } while (0)
#define PG8_WAIT_V(n) asm volatile("s_waitcnt vmcnt(" #n ")" ::: "memory")
#define PG8_WAIT_L(n) asm volatile("s_waitcnt lgkmcnt(" #n ")" ::: "memory")
#define PG8_BAR __builtin_amdgcn_s_barrier()
#define PG8_SCHED __builtin_amdgcn_sched_barrier(0)
    Unit cur, nxt; int ui = 0;
    if (!S.next(0, cur)) return;
    f32x4 acc[2][2][4][2];
#pragma unroll
    for (int a = 0; a < 2; ++a)
#pragma unroll
        for (int b = 0; b < 2; ++b)
#pragma unroll
            for (int m = 0; m < 4; ++m)
#pragma unroll
                for (int n = 0; n < 2; ++n) acc[a][b][m][n] = (f32x4){0.f, 0.f, 0.f, 0.f};
    bf16x8 At[4][2], B0[2][2], B1[2][2];
    const char* cA = (const char*)g.A + (size_t)cur.pm * tstep; const char* cB = (const char*)g.Bt + (size_t)cur.pn * tstep;
    S.a_ready(cur);
    if constexpr (SP2) {
        PG8_STAGE(PG8_SB(0, 0), cB, voffB); PG8_STAGE(PG8_SB(0, 1), cB + hstep, voffB); PG8_STAGE(PG8_SA(0, 0), cA, voffA); PG8_STAGE(PG8_SA(0, 1), cA + hstep, voffA);
        if (wr == 1) PG8_BAR;
        PG8_WAIT_V(2); PG8_BAR;
        PG8_STAGE(PG8_SB(1, 0), cB + kstep, voffB); PG8_STAGE(PG8_SA(1, 0), cA + kstep, voffA); PG8_STAGE(PG8_SB(1, 1), cB + hstep + kstep, voffB);
        PG8_WAIT_V(6); PG8_BAR;
    } else {
        PG8_STAGE(PG8_SB(0, 0), cB, voffB); PG8_STAGE(PG8_SA(0, 0), cA, voffA); PG8_STAGE(PG8_SB(0, 1), cB + hstep, voffB); PG8_STAGE(PG8_SA(0, 1), cA + hstep, voffA);
        if (wr == 1) PG8_BAR;
        PG8_WAIT_V(4); PG8_BAR;
        PG8_STAGE(PG8_SB(1, 0), cB + kstep, voffB); PG8_STAGE(PG8_SA(1, 0), cA + kstep, voffA); PG8_STAGE(PG8_SB(1, 1), cB + hstep + kstep, voffB);
        PG8_WAIT_V(6); PG8_BAR;
    }
    for (;;) {
        const bool has_next = S.next(ui + 1, nxt);
        const char* nA = has_next ? (const char*)g.A + (size_t)nxt.pm * tstep : cA; const char* nB = has_next ? (const char*)g.Bt + (size_t)nxt.pn * tstep : cB;
        for (int t = 0; t < nt; t += 2) {
            const bool last = (t == nt - 2);
            const char* a1 = cA + (size_t)(t + 1) * kstep;
            const char* a2 = last ? nA : cA + (size_t)(t + 2) * kstep; const char* b2 = last ? nB : cB + (size_t)(t + 2) * kstep;
            const char* a3 = a2 + kstep; const char* b3 = b2 + kstep;
            if (last && has_next) S.a_ready(nxt);
            if constexpr (SP2) {
            PG8_LDB(B0, 0, 0); PG8_LDB(B1, 0, 1); PG8_SCHED; PG8_LDA(At, 0, 0); PG8_STAGE(PG8_SA(1, 1), a1 + hstep, voffA);
            PG8_WAIT_V(8); PG8_WAIT_L(0); PG8_BAR; PG8_MMA(0, 0, At, B0); PG8_MMA(0, 1, At, B1); PG8_BAR; PG8_SCHED;
            PG8_LDA(At, 0, 1); PG8_STAGE(PG8_SB(0, 0), b2, voffB); PG8_STAGE(PG8_SB(0, 1), b2 + hstep, voffB); PG8_STAGE(PG8_SA(0, 0), a2, voffA);
            PG8_WAIT_V(8); PG8_WAIT_L(0); PG8_BAR; PG8_MMA(1, 0, At, B0); PG8_MMA(1, 1, At, B1); PG8_BAR; PG8_SCHED;
            PG8_LDB(B0, 1, 0); PG8_LDB(B1, 1, 1); PG8_SCHED; PG8_LDA(At, 1, 0); PG8_STAGE(PG8_SA(0, 1), a2 + hstep, voffA);
            PG8_WAIT_V(8); PG8_WAIT_L(0); PG8_BAR; PG8_MMA(0, 0, At, B0); PG8_MMA(0, 1, At, B1); PG8_BAR; PG8_SCHED;
            PG8_LDA(At, 1, 1); PG8_STAGE(PG8_SB(1, 0), b3, voffB); PG8_STAGE(PG8_SB(1, 1), b3 + hstep, voffB); PG8_STAGE(PG8_SA(1, 0), a3, voffA);
            PG8_WAIT_V(8); PG8_WAIT_L(0); PG8_BAR; PG8_MMA(1, 0, At, B0); PG8_MMA(1, 1, At, B1); PG8_BAR; PG8_SCHED;
            } else {
            PG8_LDB(B0, 0, 0); PG8_SCHED; PG8_LDA(At, 0, 0); PG8_STAGE(PG8_SA(1, 1), a1 + hstep, voffA);
            PG8_WAIT_L(8); PG8_BAR; PG8_WAIT_L(0); PG8_MMA(0, 0, At, B0); PG8_BAR; PG8_SCHED;
            PG8_LDB(B1, 0, 1); PG8_STAGE(PG8_SB(0, 0), b2, voffB);
            PG8_BAR; PG8_WAIT_L(0); PG8_MMA(0, 1, At, B1); PG8_BAR;
            PG8_LDA(At, 0, 1); PG8_STAGE(PG8_SA(0, 0), a2, voffA);
            PG8_BAR; PG8_WAIT_L(0); PG8_MMA(1, 0, At, B0); PG8_BAR; PG8_SCHED;
            PG8_STAGE(PG8_SB(0, 1), b2 + hstep, voffB);
            PG8_WAIT_V(6); PG8_BAR; PG8_MMA(1, 1, At, B1); PG8_BAR;
            PG8_LDB(B0, 1, 0); PG8_SCHED; PG8_LDA(At, 1, 0); PG8_STAGE(PG8_SA(0, 1), a2 + hstep, voffA);
            PG8_WAIT_L(8); PG8_BAR; PG8_WAIT_L(0); PG8_MMA(0, 0, At, B0); PG8_BAR; PG8_SCHED;
            PG8_LDB(B1, 1, 1); PG8_STAGE(PG8_SB(1, 0), b3, voffB);
            PG8_BAR; PG8_WAIT_L(0); PG8_MMA(0, 1, At, B1); PG8_BAR;
            PG8_LDA(At, 1, 1); PG8_STAGE(PG8_SA(1, 0), a3, voffA);
            PG8_BAR; PG8_WAIT_L(0); PG8_MMA(1, 0, At, B0); PG8_BAR; PG8_SCHED;
            PG8_STAGE(PG8_SB(1, 1), b3 + hstep, voffB);
            PG8_WAIT_V(6); PG8_BAR; PG8_MMA(1, 1, At, B1); PG8_BAR;
            }
        }
        if constexpr (ALIGN_EPI) { if (wr == 0) PG8_BAR; }
        if constexpr (!Epi::AFTER_DRAIN) { E(acc, cur, wr, wc, fr, fq); S.done(cur); }
        if (!has_next) break;
#pragma unroll
        for (int a = 0; a < 2; ++a)
#pragma unroll
            for (int b = 0; b < 2; ++b)
#pragma unroll
                for (int m = 0; m < 4; ++m)
#pragma unroll
                    for (int n = 0; n < 2; ++n) acc[a][b][m][n] = (f32x4){0.f, 0.f, 0.f, 0.f};
        cur = nxt; cA = nA; cB = nB; ++ui;
        if constexpr (ALIGN_EPI) { if (wr == 1) PG8_BAR; }
    }
    PG8_WAIT_V(0);
    if constexpr (!ALIGN_EPI) { if (wr == 0) PG8_BAR; }
    PG8_BAR;
    if constexpr (Epi::AFTER_DRAIN) { E.fused(acc, cur, wr, wc, fr, fq, lds, wid, lane); S.done(cur); }
#undef PG8_SA
#undef PG8_SB
#undef PG8_STAGE
#undef PG8_LDA
#undef PG8_LDB
#undef PG8_MMA
#undef PG8_WAIT_V
#undef PG8_WAIT_L
#undef PG8_BAR
#undef PG8_SCHED
}
}
constexpr int NWAVES = 8;
constexpr int D = 1024, NB = 8, T = 2048, NS = 128, TS = 4, FF = 2816, PROJ = 3592, QKV = 1536, NH = 4;
constexpr int MP = NB * T, MS = NS * TS, M = MP + MS, NSEQ = NB + NS;
constexpr int NUP = 2 * FF, NIN = 3584, MODW = 9 * D;
constexpr float ALPHA = 1.189207115002721f, LN_EPS = 1e-5f;
constexpr size_t O_Y = 0, O_SSM_P = (size_t)M * D, O_CQ_P = O_SSM_P + (size_t)NB * NH * 128 * 128, O_CM_P = O_CQ_P + (size_t)NB * 3 * QKV,
                 O_SSM_S = O_CM_P + (size_t)NB * 2 * 512, O_CQ_S = O_SSM_S + (size_t)NS * NH * 128 * 128, O_CM_S = O_CQ_S + (size_t)NS * 3 * QKV,
                 O_END = O_CM_S + (size_t)NS * 2 * 512;
constexpr size_t MiB = 1u << 20, KiB = 1u << 10;
constexpr size_t WS_CTL = 0, CTL_ZERO_BYTES = 1 * MiB;
constexpr size_t WS_MOD = 1 * MiB;
constexpr size_t WS_W1U = 6 * MiB, WS_W1D = 17 * MiB, WS_W2U = 22 * MiB + 512 * KiB, WS_W2D = 33 * MiB + 512 * KiB, WS_WIN = 39 * MiB, WS_WOUT = 46 * MiB;
constexpr size_t WS_GB = 48 * MiB;
constexpr size_t WS_XM = 49 * MiB, WS_Y = 82 * MiB, WS_HP = 115 * MiB, WS_END = 256 * MiB;
static_assert(WS_MOD + (size_t)NSEQ * MODW * 4 <= WS_W1U && WS_W1U + (size_t)NUP * D * 2 <= WS_W1D && WS_W1D + (size_t)D * FF * 2 <= WS_W2U && WS_W2U + (size_t)NUP * D * 2 <= WS_W2D &&
              WS_W2D + (size_t)D * FF * 2 <= WS_WIN && WS_WIN + (size_t)NIN * D * 2 <= WS_WOUT && WS_WOUT + (size_t)D * D * 2 <= WS_GB && WS_GB + (size_t)M * 8 * 4 <= WS_XM &&
              WS_XM + (size_t)M * D * 2 <= WS_Y && WS_Y + (size_t)M * D * 2 <= WS_HP && WS_HP + (size_t)M * NIN * 2 <= WS_END, "d_ws map");
constexpr int CW_TMO = 0, CW_CODE = 1, CW_BAR = 4096;
constexpr int RING_OFF = 0, RING_BYTES = 131072, LDSCTL_OFF = RING_BYTES, MISC_OFF = LDSCTL_OFF + 320, LDS_BYTES = 147456;

#define GAS __attribute__((address_space(1)))
#define LAS __attribute__((address_space(3)))
typedef unsigned short bf16;
typedef unsigned v4u __attribute__((ext_vector_type(4)));
typedef unsigned v2u __attribute__((ext_vector_type(2)));
typedef float f32x4 __attribute__((ext_vector_type(4)));
typedef short bf16x8 __attribute__((ext_vector_type(8)));
typedef GAS unsigned gu32;
#define RLX_AGENT __ATOMIC_RELAXED, __HIP_MEMORY_SCOPE_AGENT
#define LDS_WAIT() asm volatile("s_waitcnt lgkmcnt(0)" ::: "memory")
#define VM_WAIT() asm volatile("s_waitcnt vmcnt(0)" ::: "memory")
__device__ __forceinline__ unsigned f2bf(float f) { unsigned u = __builtin_bit_cast(unsigned, f); return (u + 0x7fffu + ((u >> 16) & 1u)) >> 16; }
typedef float f32x2_t __attribute__((ext_vector_type(2))); typedef __bf16 bf16x2_t __attribute__((ext_vector_type(2)));
__device__ __forceinline__ unsigned pk2(float lo, float hi) { const f32x2_t v = {lo, hi}; const bf16x2_t b = __builtin_convertvector(v, bf16x2_t); return __builtin_bit_cast(unsigned, b); }
__device__ __forceinline__ float bf_lo(unsigned w) { return __builtin_bit_cast(float, w << 16); }
__device__ __forceinline__ float bf_hi(unsigned w) { return __builtin_bit_cast(float, w & 0xffff0000u); }
__device__ __forceinline__ float silu_f(float x) { return x * __builtin_amdgcn_rcpf(1.0f + __builtin_amdgcn_exp2f(-1.4426950408889634f * x)); }

#define XB_TMO      128
#define XB_XCNT(j)  (256  + 64 * (j))
#define XB_XSUB(j)  (1280 + 64 * (j))
#define XB_XGEN(j)  (2304 + 64 * (j))
#define XB_TOP      3328
#define XB_TOPGEN   3392
#define XCD_BAR_WORDS 3456
#define XB_SPIN_CAP (1u << 18)
__device__ __forceinline__ unsigned xb_ld(unsigned* p)              { return __hip_atomic_load(p, __ATOMIC_RELAXED, __HIP_MEMORY_SCOPE_AGENT); }
__device__ __forceinline__ unsigned xb_add(unsigned* p, unsigned v) { return __hip_atomic_fetch_add(p, v, __ATOMIC_RELAXED, __HIP_MEMORY_SCOPE_AGENT); }
__device__ __forceinline__ unsigned xb_xcc_id() { return (unsigned)__builtin_amdgcn_s_getreg((3 << 11) | 20) & 0xFu; }
#define XB_SPIN(cond, bar) do { unsigned _sp = 0; while (cond) { __builtin_amdgcn_s_sleep(1); \
    if ((++_sp & 255u) == 0u) { if (xb_ld(&(bar)[XB_TMO])) break; if (_sp > XB_SPIN_CAP) { atomicAdd(&(bar)[XB_TMO], 1u); break; } } } } while (0)
struct XcdBarrier { unsigned* bar; unsigned x; volatile LAS unsigned* st; };
__device__ __forceinline__ XcdBarrier xcd_barrier_post(unsigned* bar, volatile LAS unsigned* st) {
    XcdBarrier b; b.bar = bar; b.x = xb_xcc_id(); b.st = st;
    if (threadIdx.x == 0) (void)xb_add(&bar[XB_XCNT(b.x)], 1u);
    return b;
}
__device__ __forceinline__ void xcd_barrier_complete(unsigned* bar, unsigned x, unsigned& nloc, unsigned& nx) {
    const unsigned G = gridDim.x * gridDim.y * gridDim.z;
    unsigned sum, cnt, mine, sp = 0u;
    for (;;) {
        sum = 0u; cnt = 0u; mine = 0u;
#pragma unroll
        for (unsigned j = 0; j < 16; ++j) { const unsigned c = xb_ld(&bar[XB_XCNT(j)]); sum += c; cnt += (c > 0u) ? 1u : 0u; mine = (j == x) ? c : mine; }
        if (sum == G) break;
        __builtin_amdgcn_s_sleep(1);
        if ((++sp & 255u) == 0u) { if (xb_ld(&bar[XB_TMO])) break; if (sp > XB_SPIN_CAP) { atomicAdd(&bar[XB_TMO], 1u); break; } }
    }
    nloc = mine > 0u ? mine : 1u; nx = cnt > 0u ? cnt : 1u;
}
__device__ __forceinline__ void xcd_barrier_census(const XcdBarrier& b) {
    if (threadIdx.x == 0) { unsigned nloc, nx; xcd_barrier_complete(b.bar, b.x, nloc, nx); b.st[0] = nloc; b.st[1] = nx; }
    __syncthreads();
}
__device__ __forceinline__ void xcd_barrier(const XcdBarrier& b) {
    asm volatile("s_waitcnt vmcnt(0)" ::: "memory");
    __syncthreads();
    if (threadIdx.x == 0) {
        unsigned* bar = b.bar;
        __builtin_amdgcn_s_waitcnt(0);
        unsigned nloc = b.st[0], nx = b.st[1];
        const unsigned old = xb_add(&bar[XB_XSUB(b.x)], 1u);
        const unsigned gen = old / nloc;
        if (old + 1u == (gen + 1u) * nloc) {
            __builtin_amdgcn_fence(__ATOMIC_RELEASE, "agent");
            asm volatile("s_waitcnt vmcnt(0)" ::: "memory");
            const unsigned og = xb_add(&bar[XB_TOP], 1u);
            const unsigned tg = og / nx;
            if (og + 1u == (tg + 1u) * nx) xb_add(&bar[XB_TOPGEN], 1u);
            else XB_SPIN(xb_ld(&bar[XB_TOPGEN]) == tg, bar);
            __builtin_amdgcn_fence(__ATOMIC_ACQUIRE, "agent");
            xb_add(&bar[XB_XGEN(b.x)], 1u);
            asm volatile("s_waitcnt vmcnt(0)" ::: "memory");
        } else {
            XB_SPIN(xb_ld(&bar[XB_XGEN(b.x)]) == gen, bar);
            __builtin_amdgcn_fence(__ATOMIC_ACQUIRE, "agent");
            asm volatile("s_waitcnt vmcnt(0)" ::: "memory");
        }
    }
    __syncthreads();
}

struct Args { const float* in[24]; float* out; unsigned char* ws; int ph_lo, ph_hi; };
struct Frame {
    LAS unsigned char* lds;
    volatile LAS unsigned* MISC;
    gu32* ctl;
    int tid, lane, wave, vcu, G;
    const struct Args* a; float* out; unsigned char* ws;
};
__device__ __forceinline__ float wave_sum(float v) {
#pragma unroll
    for (int o = 1; o < 64; o <<= 1) v += __shfl_xor(v, o);
    return v;
}
__device__ __forceinline__ int seq_of(int m) { return m < MP ? (m >> 11) : NB + ((m - MP) >> 2); }

__device__ __forceinline__ void p0_ada(Frame& F) {
    constexpr int RS = 528;
    const int unit = F.wave * F.G + (int)blockIdx.x;
    const bool has = unit < 576;
    const int n0 = unit * 16, m = F.lane & 15, g = F.lane >> 4;
    const float* wada = F.a->in[7];
    f32x4 acc[9];
#pragma unroll
    for (int i = 0; i < 9; ++i) acc[i] = (f32x4){0.f, 0.f, 0.f, 0.f};
    for (int kc = 0; kc < 4; ++kc) {
        float af[8][8];
        if (has) {
#pragma unroll
            for (int ks = 0; ks < 8; ++ks)
#pragma unroll
                for (int j = 0; j < 8; ++j) af[ks][j] = wada[(size_t)(kc * 256 + ks * 32 + 8 * g + j) * MODW + n0 + m];
        }
#pragma unroll
        for (int i = 0; i < 9; ++i) {
            const int gi = F.tid + 512 * i, row = gi >> 5, kg = gi & 31;
            v4u o = (v4u){0u, 0u, 0u, 0u};
            if (row < NSEQ) {
                const float* c = (row < NB ? F.a->in[5] + (size_t)row * D : F.a->in[6] + (size_t)(row - NB) * D) + kc * 256 + kg * 8;
                const f32x4 a = *(const f32x4*)c, b = *(const f32x4*)(c + 4);
                o.x = pk2(silu_f(a.x), silu_f(a.y)); o.y = pk2(silu_f(a.z), silu_f(a.w)); o.z = pk2(silu_f(b.x), silu_f(b.y)); o.w = pk2(silu_f(b.z), silu_f(b.w));
            }
            *(LAS v4u*)(F.lds + row * RS + kg * 16) = o;
        }
        LDS_WAIT(); __syncthreads();
        if (has) {
#pragma unroll
            for (int ks = 0; ks < 8; ++ks) {
                v4u aw; aw.x = pk2(af[ks][0], af[ks][1]); aw.y = pk2(af[ks][2], af[ks][3]); aw.z = pk2(af[ks][4], af[ks][5]); aw.w = pk2(af[ks][6], af[ks][7]);
                const bf16x8 A = __builtin_bit_cast(bf16x8, aw);
#pragma unroll
                for (int nt = 0; nt < 9; ++nt) {
                    const bf16x8 B = *(const LAS bf16x8*)(F.lds + (16 * nt + m) * RS + (ks * 32 + 8 * g) * 2);
                    acc[nt] = __builtin_amdgcn_mfma_f32_16x16x32_bf16(A, B, acc[nt], 0, 0, 0);
                }
            }
        }
        LDS_WAIT(); __syncthreads();
    }
    if (has) {
        const f32x4 bv = *(const f32x4*)(F.a->in[8] + n0 + 4 * g);
        float* mod = (float*)(F.ws + WS_MOD);
#pragma unroll
        for (int nt = 0; nt < 9; ++nt) { const int s = 16 * nt + m; if (s < NSEQ) *(f32x4*)(mod + (size_t)s * MODW + n0 + 4 * g) = acc[nt] + bv; }
    }
}
__device__ __forceinline__ void transpose_item(const float* W, int ldw, int src_col0, bf16* WT, int K, int dst_row0, int kb, LAS float* scr, int lane) {
    const int k0 = 64 * kb;
#pragma unroll 8
    for (int i = 0; i < 32; ++i) { const int kk = 2 * i + (lane >> 5); scr[kk * 33 + (lane & 31)] = W[(size_t)(k0 + kk) * ldw + src_col0 + (lane & 31)]; }
    LDS_WAIT(); asm volatile("" ::: "memory");
    const int c = lane & 7;
#pragma unroll
    for (int j = 0; j < 4; ++j) { const int n = (lane >> 3) + 8 * j; const LAS float* s = scr + (8 * c) * 33 + n;
        v4u o; o.x = pk2(s[0 * 33], s[1 * 33]); o.y = pk2(s[2 * 33], s[3 * 33]); o.z = pk2(s[4 * 33], s[5 * 33]); o.w = pk2(s[6 * 33], s[7 * 33]);
        *(GAS v4u*)(WT + (size_t)(dst_row0 + n) * K + k0 + 8 * c) = o; }
    LDS_WAIT(); asm volatile("" ::: "memory");
}
template <int W>
__device__ __forceinline__ void p_convert(Frame& F) {
    LAS float* scr = (LAS float*)(F.lds + RING_OFF + F.wave * 16384);
    const int gw = F.vcu * NWAVES + F.wave, NGW = F.G * NWAVES;
    constexpr int I_U = 16 * 88, I_D = 44 * 32, I_IN = 16 * 112, I_O = 16 * 32;
    constexpr int NITEMS = W == 0 ? 2 * I_U + I_D + I_IN + I_O : 2 * I_U + I_D;
    const float* wg = W == 0 ? F.a->in[11] : F.a->in[14]; const float* wu = W == 0 ? F.a->in[12] : F.a->in[15]; const float* wd = W == 0 ? F.a->in[13] : F.a->in[16];
    bf16* WU = (bf16*)(F.ws + (W == 0 ? WS_W1U : WS_W2U)); bf16* WD = (bf16*)(F.ws + (W == 0 ? WS_W1D : WS_W2D));
    for (int it = gw; it < NITEMS; it += NGW) {
        int r = it;
        if (r < 2 * I_U) { const int w = r / I_U; r -= w * I_U; const int kb = r / 88, nb = r % 88;
            transpose_item(w == 0 ? wg : wu, FF, 32 * nb, WU, D, 256 * (nb >> 2) + 32 * (nb & 3) + 128 * w, kb, scr, F.lane); continue; }
        r -= 2 * I_U;
        if (r < I_D) { const int kb = r / 32, nb = r % 32; transpose_item(wd, D, 32 * nb, WD, FF, 32 * nb, kb, scr, F.lane); continue; }
        r -= I_D;
        if (W == 0) {
            if (r < I_IN) { const int kb = r / 112, nb = r % 112;
                transpose_item(F.a->in[17], PROJ, nb < 48 ? 32 * nb : 1544 + 32 * (nb - 48), (bf16*)(F.ws + WS_WIN), D, nb < 48 ? 32 * nb : 1536 + 32 * (nb - 48), kb, scr, F.lane); continue; }
            r -= I_IN;
            { const int kb = r / 32, nb = r % 32; transpose_item(F.a->in[23], D, 32 * nb, (bf16*)(F.ws + WS_WOUT), D, 32 * nb, kb, scr, F.lane); }
        }
    }
}
template <int K>
__device__ __forceinline__ void sample_gemm(Frame& F, const bf16* A, const bf16* Bt, bf16* C) {
    static_assert(K % 256 == 0, "K split over 8 waves in 32-deep steps");
    int tid_l = F.tid; asm volatile("" : "+v"(tid_l));
    const int tid = tid_l, lane = tid & 63, wave = F.wave, m = lane & 15, g = lane >> 4;
    for (int tile = (int)blockIdx.x; tile < 256; tile += F.G) {
        const int rm = tile >> 4, cn = tile & 15;
        const bf16* a0 = A + (size_t)(32 * rm + m) * K + wave * (K / 8) + 8 * g;
        const bf16* b0 = Bt + (size_t)(64 * cn + m) * K + wave * (K / 8) + 8 * g;
        f32x4 acc[2][4];
#pragma unroll
        for (int i = 0; i < 2; ++i)
#pragma unroll
            for (int j = 0; j < 4; ++j) acc[i][j] = (f32x4){0.f, 0.f, 0.f, 0.f};
#pragma unroll 2
        for (int ks = 0; ks < K / 256; ++ks) {
            bf16x8 a[2], b[4];
#pragma unroll
            for (int i = 0; i < 2; ++i) a[i] = *(const GAS bf16x8*)(a0 + (size_t)(16 * i) * K + 32 * ks);
#pragma unroll
            for (int j = 0; j < 4; ++j) b[j] = *(const GAS bf16x8*)(b0 + (size_t)(16 * j) * K + 32 * ks);
#pragma unroll
            for (int i = 0; i < 2; ++i)
#pragma unroll
                for (int j = 0; j < 4; ++j) acc[i][j] = __builtin_amdgcn_mfma_f32_16x16x32_bf16(a[i], b[j], acc[i][j], 0, 0, 0);
        }
        LAS float* red = (LAS float*)(F.lds + RING_OFF);
#pragma unroll
        for (int i = 0; i < 2; ++i)
#pragma unroll
            for (int j = 0; j < 4; ++j)
#pragma unroll
                for (int r = 0; r < 4; ++r) red[(wave * 32 + 16 * i + 4 * g + r) * 64 + 16 * j + m] = acc[i][j][r];
        LDS_WAIT(); __syncthreads();
        const int row = tid >> 4, c4 = (tid & 15) * 4;
        f32x4 s = (f32x4){0.f, 0.f, 0.f, 0.f};
#pragma unroll
        for (int w = 0; w < 8; ++w) s = s + *(const LAS f32x4*)(red + (w * 32 + row) * 64 + c4);
        v2u o; o.x = pk2(s.x, s.y); o.y = pk2(s.z, s.w);
        *(GAS v2u*)(C + (size_t)(32 * rm + row) * D + 64 * cn + c4) = o;
        LDS_WAIT(); __syncthreads();
    }
}
__device__ __forceinline__ void p1_mod(Frame& F) {
    const int gw = F.vcu * NWAVES + F.wave, NGW = F.G * NWAVES;
    const float* mod = (const float*)(F.ws + WS_MOD); bf16* XM = (bf16*)(F.ws + WS_XM);
    for (int m = gw; m < M; m += NGW) {
        const float* xr = m < MP ? F.a->in[0] + (size_t)m * D : F.a->in[1] + (size_t)(m - MP) * D;
        const float* ms = mod + (size_t)seq_of(m) * MODW;
#pragma unroll
        for (int j = 0; j < 4; ++j) { const int d = 4 * F.lane + 256 * j;
            const f32x4 v = *(const f32x4*)(xr + d), sh = *(const f32x4*)(ms + d), sc = *(const f32x4*)(ms + D + d);
            const f32x4 o = v * (sc + 1.0f) + sh; v2u w; w.x = pk2(o.x, o.y); w.y = pk2(o.z, o.w);
            *(GAS v2u*)(XM + (size_t)m * D + d) = w; }
    }
}
template <int I, bool AB, int NR>
__device__ __forceinline__ void ln_rows(Frame& F, int m0, float yscale, LAS float* W8) {
    const float* mod = (const float*)(F.ws + WS_MOD); bf16* XM = (bf16*)(F.ws + WS_XM); const bf16* Y = (const bf16*)(F.ws + WS_Y);
    const float* ms = mod + (size_t)seq_of(m0) * MODW + I * 3 * D;
    const int lane = F.lane;
    f32x4 gt[4], lg[4], lb[4], sh[4], sc[4];
#pragma unroll
    for (int j = 0; j < 4; ++j) { const int d = 4 * lane + 256 * j;
        gt[j] = *(const f32x4*)(ms + 2 * D + d) * yscale; lg[j] = *(const f32x4*)(F.a->in[9] + I * D + d); lb[j] = *(const f32x4*)(F.a->in[10] + I * D + d);
        if (I < 2) { sh[j] = *(const f32x4*)(ms + 3 * D + d); sc[j] = *(const f32x4*)(ms + 4 * D + d) + 1.0f; } }
    f32x4 xn[4]; v2u yn[4];
#define LN_LOAD(m_) do { const float* xr_ = (I == 0) ? ((m_) < MP ? F.a->in[0] + (size_t)(m_) * D : F.a->in[1] + (size_t)((m_) - MP) * D) : F.out + (size_t)(m_) * D; \
        _Pragma("unroll") for (int j = 0; j < 4; ++j) { const int d = 4 * lane + 256 * j; xn[j] = *(const f32x4*)(xr_ + d); yn[j] = *(const GAS v2u*)(Y + (size_t)(m_) * D + d); } } while (0)
    LN_LOAD(m0);
#pragma unroll 1
    for (int i = 0; i < NR; ++i) {
        const int m = m0 + i;
        f32x4 v[4]; float s = 0.f;
#pragma unroll
        for (int j = 0; j < 4; ++j) { const f32x4 y = (f32x4){bf_lo(yn[j].x), bf_hi(yn[j].x), bf_lo(yn[j].y), bf_hi(yn[j].y)};
            v[j] = xn[j] * ALPHA + gt[j] * y; s += (v[j].x + v[j].y) + (v[j].z + v[j].w); }
        if (i + 1 < NR) LN_LOAD(m + 1);
        const float mean = wave_sum(s) * (1.f / D); float s2 = 0.f;
#pragma unroll
        for (int j = 0; j < 4; ++j) { v[j] = v[j] - mean; s2 += (v[j].x * v[j].x + v[j].y * v[j].y) + (v[j].z * v[j].z + v[j].w * v[j].w); }
        const float rstd = 1.f / sqrtf(wave_sum(s2) * (1.f / D) + LN_EPS);
        float ab[8]; f32x4 uu[4];
#pragma unroll
        for (int j = 0; j < 4; ++j) { const int d = 4 * lane + 256 * j;
            const f32x4 o = v[j] * rstd * lg[j] + lb[j];
            *(f32x4*)(F.out + (size_t)m * D + d) = o;
            if (I < 2) { const f32x4 u = o * sc[j] + sh[j]; v2u w; w.x = pk2(u.x, u.y); w.y = pk2(u.z, u.w);
                *(GAS v2u*)(XM + (size_t)m * D + d) = w; uu[j] = u; }
        }
        if (AB) {
#pragma unroll
            for (int q = 0; q < 8; ++q) { float a_ = 0.f;
#pragma unroll
                for (int j = 0; j < 4; ++j) { const f32x4 wv = *(const LAS f32x4*)(W8 + q * D + 4 * lane + 256 * j); a_ += (uu[j].x * wv.x + uu[j].y * wv.y) + (uu[j].z * wv.z + uu[j].w * wv.w); }
                asm volatile("" : "+v"(a_));
                ab[q] = wave_sum(a_); }
            if (lane < 4) { const int h = lane; float a = h == 0 ? ab[0] : h == 1 ? ab[1] : h == 2 ? ab[2] : ab[3], b = h == 0 ? ab[4] : h == 1 ? ab[5] : h == 2 ? ab[6] : ab[7];
                const float z = a + F.a->in[20][h]; const float sp = z > 20.f ? z : log1pf(__expf(z));
                float* GB = (float*)(F.ws + WS_GB);
                GB[(size_t)m * 4 + h] = -__expf(F.a->in[19][h]) * sp;
                GB[(size_t)M * 4 + (size_t)m * 4 + h] = 1.f / (1.f + __expf(-b)); }
        }
    }
#undef LN_LOAD
}
template <int I, bool AB = (I == 0)>
__device__ __forceinline__ void ln_pass(Frame& F, float yscale) {
    const int gw = F.vcu * NWAVES + F.wave, NGW = F.G * NWAVES;
    LAS float* W8 = (LAS float*)(F.lds + RING_OFF);
    if (AB) {
        for (int e = F.tid; e < 8 * D; e += NWAVES * 64) { const int d = e >> 3, j = e & 7; W8[j * D + d] = F.a->in[17][(size_t)d * PROJ + QKV + j]; }
        LDS_WAIT(); __syncthreads();
    }
    for (int m0 = 8 * gw; m0 < MP; m0 += 8 * NGW) ln_rows<I, AB, 8>(F, m0, yscale, W8);
    for (int m = MP + gw; m < M; m += NGW) ln_rows<I, AB, 1>(F, m, yscale, W8);
    if (AB) { LDS_WAIT(); __syncthreads(); }
}
constexpr int PQ_LD = 1536, PR_LD = 2048, PR_OG = 0, PR_SB = 512, PR_SC = 1024, PR_SH = 1536;
constexpr size_t WS_PQ = WS_HP, WS_PR = WS_HP + (size_t)M * PQ_LD * 2, WS_TAIL = WS_HP + (size_t)M * NIN * 2;
constexpr size_t FRB_AW = WS_Y, FRB_AQD = WS_Y + 16 * MiB;
constexpr size_t FRB_AQK = WS_TAIL, FRB_U = WS_TAIL + 8 * MiB, FRB_GL = WS_TAIL + 24 * MiB;
constexpr size_t FRB_SH = WS_PQ;
static_assert(FRB_AQD + 16 * MiB <= WS_HP && FRB_GL + 4096 <= WS_END && (size_t)32 * MiB <= (size_t)MP * PQ_LD * 2, "fragment map");
__device__ __forceinline__ unsigned char* fr_akd(const Frame& F) { return (unsigned char*)(F.out + O_SSM_S); }

__device__ __forceinline__ void unpack8(const v4u w, float (&f)[8]) {
    f[0] = bf_lo(w.x); f[1] = bf_hi(w.x); f[2] = bf_lo(w.y); f[3] = bf_hi(w.y); f[4] = bf_lo(w.z); f[5] = bf_hi(w.z); f[6] = bf_lo(w.w); f[7] = bf_hi(w.w);
}
__device__ __forceinline__ void d1_unit(Frame& F, int ci) {
    constexpr int RAW = 0, RAWS = 768, KBI = 0, KHI = 17408, QHI = 34816, IMS = 272, VB = 52224, KG = 84992, SC = 117760, CW = 118784;
    constexpr int LM = 0, QKI = 17408, QKS = 136, WIM = 34816;
    const int bh = ci >> 5, n = ci & 31, b = bh >> 2, h = bh & 3, row0 = b * T + 64 * n;
    int tid_l = F.tid; asm volatile("" : "+v"(tid_l));
    const int tid = tid_l, lane = tid & 63, wave = F.wave;
    LAS unsigned char* L = F.lds;
    LAS float* SCf = (LAS float*)(L + SC);
    LAS float* CWf = (LAS float*)(L + CW);
    const bf16* P = (const bf16*)(F.ws + WS_PQ);
    const float* GB = (const float*)(F.ws + WS_GB);
    {
        v4u rv[7]; float cwv[3];
#pragma unroll
        for (int it = 0; it < 7; ++it) { const int p = tid + 512 * it, r = p / 48, q = p % 48, part = q >> 4, c8 = q & 15, tok = r - 3;
            rv[it] = (v4u){0u, 0u, 0u, 0u};
            if (p < 67 * 48 && (n > 0 || tok >= 0)) rv[it] = *(const GAS v4u*)(P + (size_t)(row0 + tok) * PQ_LD + part * 512 + h * 128 + c8 * 8); }
#pragma unroll
        for (int it = 0; it < 3; ++it) { const int e = tid + 512 * it, i = e / 384, q = e % 384; cwv[it] = F.a->in[18][i * QKV + (q >> 7) * 512 + h * 128 + (q & 127)]; }
#pragma unroll
        for (int it = 0; it < 7; ++it) { const int p = tid + 512 * it, r = p / 48, q = p % 48; if (p < 67 * 48) *(LAS v4u*)(L + RAW + r * RAWS + q * 16) = rv[it]; }
        if (n == 31) {
#pragma unroll
            for (int it = 6; it < 7; ++it) { const int p = tid + 512 * it, r = p / 48, q = p % 48, part = q >> 4, c8 = q & 15;
                if (p < 67 * 48 && r >= 64) { float x[8]; unpack8(rv[it], x); float* cq = F.out + O_CQ_P + ((size_t)b * 3 + (r - 64)) * QKV + part * 512 + h * 128 + c8 * 8;
                    *(f32x4*)cq = (f32x4){x[0], x[1], x[2], x[3]}; *(f32x4*)(cq + 4) = (f32x4){x[4], x[5], x[6], x[7]}; } }
        }
#pragma unroll
        for (int it = 0; it < 3; ++it) CWf[tid + 512 * it] = cwv[it];
    }
    if (wave == 0) {
        const float gv = GB[(size_t)(row0 + lane) * 4 + h], bt = GB[(size_t)M * 4 + (size_t)(row0 + lane) * 4 + h];
        float gc = gv;
#pragma unroll
        for (int o = 1; o < 64; o <<= 1) { const float t = __shfl_up(gc, o); if (lane >= o) gc += t; }
        const float glast = __shfl(gc, 63);
        SCf[lane] = gc; SCf[64 + lane] = bt; SCf[128 + lane] = __expf(gc); SCf[192 + lane] = __expf(glast - gc);
        if (lane == 0) ((float*)(F.ws + FRB_GL))[ci] = __expf(glast);
    }
    LDS_WAIT(); __syncthreads();
    const int tok = tid >> 3, sub = tid & 7;
    float val[6][8];
#pragma unroll
    for (int i = 0; i < 6; ++i) { const int cg = (i >> 1) * 16 + (i & 1) * 8 + sub;
        float a[8];
#pragma unroll
        for (int e = 0; e < 8; ++e) a[e] = 0.f;
#pragma unroll
        for (int tap = 0; tap < 4; ++tap) { float x[8]; unpack8(*(const LAS v4u*)(L + RAW + (tok + tap) * RAWS + cg * 16), x);
            const f32x4 w0 = *(const LAS f32x4*)(CWf + tap * 384 + cg * 8), w1 = *(const LAS f32x4*)(CWf + tap * 384 + cg * 8 + 4);
            a[0] += x[0] * w0.x; a[1] += x[1] * w0.y; a[2] += x[2] * w0.z; a[3] += x[3] * w0.w; a[4] += x[4] * w1.x; a[5] += x[5] * w1.y; a[6] += x[6] * w1.z; a[7] += x[7] * w1.w; }
#pragma unroll
        for (int e = 0; e < 8; ++e) val[i][e] = silu_f(a[e]); }
    float sq = 0.f, sk = 0.f;
#pragma unroll
    for (int e = 0; e < 8; ++e) { sq += val[0][e] * val[0][e] + val[1][e] * val[1][e]; sk += val[2][e] * val[2][e] + val[3][e] * val[3][e]; }
#pragma unroll
    for (int o = 1; o < 8; o <<= 1) { sq += __shfl_xor(sq, o); sk += __shfl_xor(sk, o); }
    const float rq = rsqrtf(sq + 1e-6f) * 0.08838834764831845f, rk = rsqrtf(sk + 1e-6f);
    const float bt = SCf[64 + tok], egt = SCf[128 + tok];
    LDS_WAIT(); __syncthreads();
    unsigned char* AQD = F.ws + FRB_AQD + (size_t)ci * 16384;
#pragma unroll
    for (int i = 0; i < 2; ++i) { const int dk0 = (i * 8 + sub) * 8;
        float q[8];
#pragma unroll
        for (int e = 0; e < 8; ++e) q[e] = val[i][e] * rq;
        v4u w; w.x = pk2(q[0], q[1]); w.y = pk2(q[2], q[3]); w.z = pk2(q[4], q[5]); w.w = pk2(q[6], q[7]);
        *(LAS v4u*)(L + QHI + tok * IMS + dk0 * 2) = w;
        const int s = dk0 >> 5, jh = (dk0 >> 4) & 1, g2 = (dk0 >> 3) & 1, mt = tok >> 4, m = tok & 15;
#pragma unroll
        for (int half = 0; half < 2; ++half) { const int g = 2 * g2 + half;
            v2u o; o.x = pk2(q[4 * half] * egt, q[4 * half + 1] * egt); o.y = pk2(q[4 * half + 2] * egt, q[4 * half + 3] * egt);
            *(GAS v2u*)(AQD + ((size_t)((mt * 4 + s) * 64 + m + 16 * g) * 8 + 4 * jh) * 2) = o; } }
#pragma unroll
    for (int i = 0; i < 2; ++i) { const int dk0 = (i * 8 + sub) * 8;
        float k[8];
#pragma unroll
        for (int e = 0; e < 8; ++e) k[e] = val[2 + i][e] * rk;
        v4u w; w.x = pk2(k[0], k[1]); w.y = pk2(k[2], k[3]); w.z = pk2(k[4], k[5]); w.w = pk2(k[6], k[7]);
        *(LAS v4u*)(L + KHI + tok * IMS + dk0 * 2) = w;
        v4u wb; wb.x = pk2(k[0] * bt, k[1] * bt); wb.y = pk2(k[2] * bt, k[3] * bt); wb.z = pk2(k[4] * bt, k[5] * bt); wb.w = pk2(k[6] * bt, k[7] * bt);
        *(LAS v4u*)(L + KBI + tok * IMS + dk0 * 2) = wb;
        const float f = bt * egt;
        *(LAS f32x4*)(L + KG + tok * 512 + dk0 * 4) = (f32x4){k[0] * f, k[1] * f, k[2] * f, k[3] * f};
        *(LAS f32x4*)(L + KG + tok * 512 + dk0 * 4 + 16) = (f32x4){k[4] * f, k[5] * f, k[6] * f, k[7] * f}; }
#pragma unroll
    for (int i = 0; i < 2; ++i) { const int dv0 = (i * 8 + sub) * 8;
        *(LAS f32x4*)(L + VB + tok * 512 + dv0 * 4) = (f32x4){val[4 + i][0] * bt, val[4 + i][1] * bt, val[4 + i][2] * bt, val[4 + i][3] * bt};
        *(LAS f32x4*)(L + VB + tok * 512 + dv0 * 4 + 16) = (f32x4){val[4 + i][4] * bt, val[4 + i][5] * bt, val[4 + i][6] * bt, val[4 + i][7] * bt}; }
    LDS_WAIT(); __syncthreads();
    const int kind = wave >> 2, ti = wave & 3, m16 = lane & 15, g4 = lane >> 4;
    f32x4 acc[4];
#pragma unroll
    for (int tj = 0; tj < 4; ++tj) acc[tj] = (f32x4){0.f, 0.f, 0.f, 0.f};
#pragma unroll
    for (int s = 0; s < 4; ++s) {
        const bf16x8 A = *(const LAS bf16x8*)(L + (kind == 0 ? KBI : QHI) + (16 * ti + m16) * IMS + (32 * s + 8 * g4) * 2);
#pragma unroll
        for (int tj = 0; tj < 4; ++tj) if (tj <= ti) {
            const bf16x8 B = *(const LAS bf16x8*)(L + KHI + (16 * tj + m16) * IMS + (32 * s + 8 * g4) * 2);
            acc[tj] = __builtin_amdgcn_mfma_f32_16x16x32_bf16(A, B, acc[tj], 0, 0, 0); }
    }
    {
        unsigned char* AKD = fr_akd(F) + (size_t)ci * 16384;
#pragma unroll
        for (int rep = 0; rep < 2; ++rep) { const int lf = tid + 512 * rep, frag = lf >> 6, ln = lf & 63, Tt = frag >> 1, s2 = frag & 1, m = ln & 15, g = ln >> 4;
            float kd[8];
#pragma unroll
            for (int j = 0; j < 8; ++j) { const int tk = 32 * s2 + 16 * (j >> 2) + 4 * g + (j & 3);
                const unsigned short hv = *(const LAS unsigned short*)(L + KHI + tk * IMS + (16 * Tt + m) * 2);
                kd[j] = __builtin_bit_cast(float, (unsigned)hv << 16) * SCf[192 + tk]; }
            v4u o; o.x = pk2(kd[0], kd[1]); o.y = pk2(kd[2], kd[3]); o.z = pk2(kd[4], kd[5]); o.w = pk2(kd[6], kd[7]);
            *(GAS v4u*)(AKD + (size_t)lf * 16) = o; }
    }
    LDS_WAIT(); __syncthreads();
#pragma unroll
    for (int tj = 0; tj < 4; ++tj)
#pragma unroll
        for (int r = 0; r < 4; ++r) { const int i = 16 * ti + 4 * g4 + r, j = 16 * tj + m16;
            const float dec = (tj <= ti && i >= j) ? __expf(SCf[i] - SCf[j]) : 0.f;
            const float v = (tj <= ti) ? acc[tj][r] * dec : 0.f;
            if (kind == 0) { if (tj <= ti) *(LAS float*)(L + LM + i * 256 + j * 4) = (i > j) ? v : 0.f; }
            else *(LAS unsigned short*)(L + QKI + i * QKS + j * 2) = (unsigned short)f2bf(v); }
    LDS_WAIT(); __syncthreads();
    if (wave < 4) {
        const int c = tid;
        const LAS unsigned char* rhsp = L + (c < 128 ? VB : KG) + (c & 127) * 4;
        float x[64];
#pragma unroll
        for (int i = 0; i < 64; ++i) {
            float sum = *(const LAS float*)(rhsp + i * 512);
#pragma unroll
            for (int j4 = 0; j4 < (i + 3) / 4; ++j4) { const f32x4 l = *(const LAS f32x4*)(L + LM + i * 256 + j4 * 16);
                if (4 * j4 + 0 < i) sum -= l.x * x[4 * j4 + 0];
                if (4 * j4 + 1 < i) sum -= l.y * x[4 * j4 + 1];
                if (4 * j4 + 2 < i) sum -= l.z * x[4 * j4 + 2];
                if (4 * j4 + 3 < i) sum -= l.w * x[4 * j4 + 3]; }
            x[i] = sum;
        }
        if (c < 128) {
            unsigned char* U = F.ws + FRB_U + (size_t)ci * 16384 + (size_t)(c >> 4) * 2048;
#pragma unroll
            for (int mt = 0; mt < 4; ++mt)
#pragma unroll
                for (int g = 0; g < 4; ++g) { const int t0 = 16 * mt + 4 * g; v2u o; o.x = pk2(x[t0], x[t0 + 1]); o.y = pk2(x[t0 + 2], x[t0 + 3]);
                    *(GAS v2u*)(U + (size_t)(mt * 64 + (c & 15) + 16 * g) * 8) = o; }
        } else {
            const int dk = c - 128;
#pragma unroll
            for (int i = 0; i < 64; ++i) *(LAS unsigned short*)(L + WIM + i * IMS + dk * 2) = (unsigned short)f2bf(x[i]);
        }
    } else {
        unsigned char* AQK = F.ws + FRB_AQK + (size_t)ci * 8192;
#pragma unroll
        for (int rep = 0; rep < 2; ++rep) { const int lf = (tid - 256) + 256 * rep, frag = lf >> 6, ln = lf & 63, mt = frag >> 1, s2 = frag & 1, m = ln & 15, g = ln >> 4;
            const v2u a = *(const LAS v2u*)(L + QKI + (16 * mt + m) * QKS + (32 * s2 + 4 * g) * 2);
            const v2u bq = *(const LAS v2u*)(L + QKI + (16 * mt + m) * QKS + (32 * s2 + 16 + 4 * g) * 2);
            *(GAS v4u*)(AQK + (size_t)lf * 16) = (v4u){a.x, a.y, bq.x, bq.y}; }
    }
    LDS_WAIT(); __syncthreads();
    {
        unsigned char* AW = F.ws + FRB_AW + (size_t)ci * 16384;
#pragma unroll
        for (int rep = 0; rep < 2; ++rep) { const int lf = tid + 512 * rep, frag = lf >> 6, ln = lf & 63, mt = frag >> 2, s = frag & 3, m = ln & 15, g = ln >> 4;
            const v2u a = *(const LAS v2u*)(L + WIM + (16 * mt + m) * IMS + (32 * s + 4 * g) * 2);
            const v2u bq = *(const LAS v2u*)(L + WIM + (16 * mt + m) * IMS + (32 * s + 16 + 4 * g) * 2);
            *(GAS v4u*)(AW + (size_t)lf * 16) = (v4u){a.x, a.y, bq.x, bq.y}; }
    }
    LDS_WAIT(); __syncthreads();
}
template <int ABL = 0>
__device__ __forceinline__ void scan_phase(Frame& F) {
    if ((int)blockIdx.x >= 64) return;
    constexpr int BUFB = 40960;
    const int unit = (int)blockIdx.x, bh = unit & 31, half = unit >> 5, lane = F.lane, wave = F.wave;
    LAS unsigned char* L = F.lds;
    if (wave >= 4) {
        const int lw = wave - 4;
        const unsigned char* src[10];
#pragma unroll
        for (int i = 0; i < 10; ++i) { const int p = 10 * lw + i;
            src[i] = (p < 16 ? F.ws + FRB_AW + (size_t)p * 1024 : p < 32 ? fr_akd(F) + (size_t)(p - 16) * 1024 : F.ws + FRB_U + (size_t)half * 8192 + (size_t)(p - 32) * 1024) + (size_t)bh * 32 * 16384 + lane * 16; }
#define SCAN_ISSUE(c_, buf_) do { _Pragma("unroll") for (int i_ = 0; i_ < 10; ++i_) \
            __builtin_amdgcn_global_load_lds((const unsigned*)(src[i_] + (size_t)(c_) * 16384), (LAS unsigned*)(L + (buf_) * BUFB + (10 * lw + i_) * 1024), 16, 0, 0); } while (0)
        if (!(ABL & 8)) { SCAN_ISSUE(0, 0); SCAN_ISSUE(1, 1); }
        int nb = 2;
        for (int n = 0; n < 32; ++n) {
            if (!(ABL & 8)) asm volatile("s_waitcnt vmcnt(10)" ::: "memory");
            __builtin_amdgcn_s_barrier();
            asm volatile("" ::: "memory");
            const int c = n + 2 < 32 ? n + 2 : 31;
            if (!(ABL & 8)) SCAN_ISSUE(c, nb); nb = nb == 2 ? 0 : nb + 1;
        }
        asm volatile("s_waitcnt vmcnt(0)" ::: "memory");
#undef SCAN_ISSUE
    } else {
        const int dvl = lane & 15, g = lane >> 4, sl = 4 * half + wave;
        const float* GL = (const float*)(F.ws + FRB_GL) + bh * 32;
        unsigned char* SH = F.ws + FRB_SH + ((size_t)bh * 32 * 8 + sl) * 4096 + lane * 16;
        f32x4 St[8];
#pragma unroll
        for (int t = 0; t < 8; ++t) St[t] = (f32x4){0.f, 0.f, 0.f, 0.f};
        const float glv = __hip_atomic_load(GL + (lane & 31), __ATOMIC_RELAXED, __HIP_MEMORY_SCOPE_AGENT);
        int cb = 0;
        for (int n = 0; n < 32; ++n) {
            const float gl = __builtin_bit_cast(float, __builtin_amdgcn_readlane(__builtin_bit_cast(int, glv), n));
            v4u Bw[4];
#pragma unroll
            for (int s = 0; s < 4; ++s) { Bw[s].x = pk2(St[2 * s][0], St[2 * s][1]); Bw[s].y = pk2(St[2 * s][2], St[2 * s][3]); Bw[s].z = pk2(St[2 * s + 1][0], St[2 * s + 1][1]); Bw[s].w = pk2(St[2 * s + 1][2], St[2 * s + 1][3]);
                if (ABL & 1) asm volatile("" :: "v"(Bw[s])); else *(GAS v4u*)(SH + (size_t)n * 32768 + s * 1024) = Bw[s]; }
            __builtin_amdgcn_s_barrier();
            asm volatile("" ::: "memory");
            const LAS unsigned char* B = L + cb * BUFB + lane * 16;
            f32x4 accA[4];
#pragma unroll
            for (int mt = 0; mt < 4; ++mt) { accA[mt] = (f32x4){0.f, 0.f, 0.f, 0.f};
#pragma unroll
                for (int s = 0; s < 4; ++s) accA[mt] = __builtin_amdgcn_mfma_f32_16x16x32_bf16(*(const LAS bf16x8*)(B + (mt * 4 + s) * 1024), __builtin_bit_cast(bf16x8, Bw[s]), accA[mt], 0, 0, 0); }
            f32x4 vn[4];
#pragma unroll
            for (int mt = 0; mt < 4; ++mt) { const v2u uw = *(const LAS v2u*)(L + cb * BUFB + 32768 + wave * 2048 + (mt * 64 + lane) * 8);
                vn[mt] = (f32x4){bf_lo(uw.x), bf_hi(uw.x), bf_lo(uw.y), bf_hi(uw.y)} - accA[mt]; }
            bf16x8 Bv[2];
#pragma unroll
            for (int s2 = 0; s2 < 2; ++s2) { v4u w; w.x = pk2(vn[2 * s2][0], vn[2 * s2][1]); w.y = pk2(vn[2 * s2][2], vn[2 * s2][3]); w.z = pk2(vn[2 * s2 + 1][0], vn[2 * s2 + 1][1]); w.w = pk2(vn[2 * s2 + 1][2], vn[2 * s2 + 1][3]);
                Bv[s2] = __builtin_bit_cast(bf16x8, w); }
#pragma unroll
            for (int t = 0; t < 8; ++t) { St[t] = St[t] * gl;
#pragma unroll
                for (int s2 = 0; s2 < 2; ++s2) St[t] = __builtin_amdgcn_mfma_f32_16x16x32_bf16(*(const LAS bf16x8*)(B + 16384 + (t * 2 + s2) * 1024), Bv[s2], St[t], 0, 0, 0); }
            cb = cb == 2 ? 0 : cb + 1;
        }
        float* So = F.out + O_SSM_P + (size_t)bh * 128 * 128;
#pragma unroll
        for (int t = 0; t < 8; ++t)
#pragma unroll
            for (int r = 0; r < 4; ++r) So[(size_t)(16 * t + 4 * g + r) * 128 + 16 * sl + dvl] = St[t][r];
    }
}
__device__ __forceinline__ float dpp_add(float v, const int ctrl_sel) {
    const int iv = __builtin_bit_cast(int, v); int o;
    if (ctrl_sel == 0) o = __builtin_amdgcn_update_dpp(0, iv, 0xB1, 0xF, 0xF, true);
    else if (ctrl_sel == 1) o = __builtin_amdgcn_update_dpp(0, iv, 0x4E, 0xF, 0xF, true);
    else if (ctrl_sel == 2) o = __builtin_amdgcn_update_dpp(0, iv, 0x141, 0xF, 0xF, true);
    else o = __builtin_amdgcn_update_dpp(0, iv, 0x140, 0xF, 0xF, true);
    return v + __builtin_bit_cast(float, o);
}
__device__ __forceinline__ f32x4 row16_sum4(f32x4 v) {
#pragma unroll
    for (int st = 0; st < 4; ++st) { v.x = dpp_add(v.x, st); v.y = dpp_add(v.y, st); v.z = dpp_add(v.z, st); v.w = dpp_add(v.w, st); }
    return v;
}
template <int ABL = 0>
__device__ __forceinline__ void d3_phase(Frame& F) {
    constexpr int BUFB = 57344, RED = 114688;
    int tid_l = F.tid; asm volatile("" : "+v"(tid_l));
    const int lane = tid_l & 63, wave = F.wave, dvl = lane & 15, g = lane >> 4;
    LAS unsigned char* L = F.lds;
    LAS float* red = (LAS float*)(L + RED);
    bf16* MIX = (bf16*)(F.ws + WS_XM); const bf16* PR = (const bf16*)(F.ws + WS_PR);
    const float gdn = F.a->in[21][16 * wave + dvl];
    const int nk = (1024 - (int)blockIdx.x + F.G - 1) / F.G;
#define D3_ISSUE(ci_, buf_) do { _Pragma("unroll") for (int i_ = 0; i_ < 7; ++i_) { const int p_ = 7 * wave + i_; \
            const unsigned char* s_ = (p_ < 16 ? F.ws + FRB_AW + (size_t)(ci_) * 16384 + (size_t)p_ * 1024 : p_ < 32 ? F.ws + FRB_AQD + (size_t)(ci_) * 16384 + (size_t)(p_ - 16) * 1024 : \
                                       p_ < 40 ? F.ws + FRB_AQK + (size_t)(ci_) * 8192 + (size_t)(p_ - 32) * 1024 : F.ws + FRB_U + (size_t)(ci_) * 16384 + (size_t)(p_ - 40) * 1024) + lane * 16; \
            __builtin_amdgcn_global_load_lds((const unsigned*)s_, (LAS unsigned*)(L + (buf_) * BUFB + p_ * 1024), 16, 0, 0); } } while (0)
#define D3_LOADS(ci_, dst_) do { const unsigned char* sh_ = F.ws + FRB_SH + ((size_t)(ci_) * 8 + wave) * 4096 + lane * 16; \
            _Pragma("unroll") for (int s_ = 0; s_ < 4; ++s_) dst_[s_] = *(const GAS v4u*)(sh_ + s_ * 1024); } while (0)
#define D3_OG(ci_) do { const int bh_ = (ci_) >> 5, n_ = (ci_) & 31, r0_ = (bh_ >> 2) * T + 64 * n_, h_ = bh_ & 3; \
            _Pragma("unroll") for (int mt_ = 0; mt_ < 4; ++mt_) _Pragma("unroll") for (int r_ = 0; r_ < 4; ++r_) ogn[mt_][r_] = PR[(size_t)(r0_ + 16 * mt_ + 4 * g + r_) * PR_LD + PR_OG + h_ * 128 + 16 * wave + dvl]; } while (0)
    v4u Bn[4]; unsigned short ogn[4][4];
    if (nk > 0) { if (!(ABL & 8)) D3_ISSUE((int)blockIdx.x, 0); D3_LOADS((int)blockIdx.x, Bn); D3_OG((int)blockIdx.x); }
    for (int k = 0; k < nk; ++k) {
        const int ci = (int)blockIdx.x + k * F.G, bh = ci >> 5, n = ci & 31, b = bh >> 2, h = bh & 3, row0 = b * T + 64 * n;
        asm volatile("s_waitcnt vmcnt(0)" ::: "memory");
        __builtin_amdgcn_s_barrier();
        asm volatile("" ::: "memory");
        v4u Bw[4];
#pragma unroll
        for (int s = 0; s < 4; ++s) Bw[s] = Bn[s];
        if (k + 1 < nk) { if (!(ABL & 8)) D3_ISSUE(ci + F.G, (k + 1) & 1); if (!(ABL & 16)) D3_LOADS(ci + F.G, Bn); }
        unsigned short ogv[4][4];
#pragma unroll
        for (int mt = 0; mt < 4; ++mt)
#pragma unroll
            for (int r = 0; r < 4; ++r) ogv[mt][r] = ogn[mt][r];
        if (k + 1 < nk) D3_OG(ci + F.G);
        const LAS unsigned char* B = L + (k & 1) * BUFB + lane * 16;
        f32x4 accA[4], accO[4];
#pragma unroll
        for (int mt = 0; mt < 4; ++mt) { accA[mt] = (f32x4){0.f, 0.f, 0.f, 0.f}; accO[mt] = (f32x4){0.f, 0.f, 0.f, 0.f};
#pragma unroll
            for (int s = 0; s < 4; ++s) { accA[mt] = __builtin_amdgcn_mfma_f32_16x16x32_bf16(*(const LAS bf16x8*)(B + (mt * 4 + s) * 1024), __builtin_bit_cast(bf16x8, Bw[s]), accA[mt], 0, 0, 0);
                accO[mt] = __builtin_amdgcn_mfma_f32_16x16x32_bf16(*(const LAS bf16x8*)(B + 16384 + (mt * 4 + s) * 1024), __builtin_bit_cast(bf16x8, Bw[s]), accO[mt], 0, 0, 0); } }
        f32x4 vn[4];
#pragma unroll
        for (int mt = 0; mt < 4; ++mt) { const v2u uw = *(const LAS v2u*)(L + (k & 1) * BUFB + 40960 + wave * 2048 + (mt * 64 + lane) * 8);
            vn[mt] = (f32x4){bf_lo(uw.x), bf_hi(uw.x), bf_lo(uw.y), bf_hi(uw.y)} - accA[mt]; }
        bf16x8 Bv[2];
#pragma unroll
        for (int s2 = 0; s2 < 2; ++s2) { v4u w; w.x = pk2(vn[2 * s2][0], vn[2 * s2][1]); w.y = pk2(vn[2 * s2][2], vn[2 * s2][3]); w.z = pk2(vn[2 * s2 + 1][0], vn[2 * s2 + 1][1]); w.w = pk2(vn[2 * s2 + 1][2], vn[2 * s2 + 1][3]);
            Bv[s2] = __builtin_bit_cast(bf16x8, w); }
#pragma unroll
        for (int mt = 0; mt < 4; ++mt)
#pragma unroll
            for (int s2 = 0; s2 < 2; ++s2) accO[mt] = __builtin_amdgcn_mfma_f32_16x16x32_bf16(*(const LAS bf16x8*)(B + 32768 + (mt * 2 + s2) * 1024), Bv[s2], accO[mt], 0, 0, 0);
#pragma unroll
        for (int mt = 0; mt < 4; ++mt) { f32x4 ss = accO[mt] * accO[mt];
            ss = row16_sum4(ss);
            if (dvl == 0) *(LAS f32x4*)(red + wave * 64 + 16 * mt + 4 * g) = ss; }
        asm volatile("s_waitcnt lgkmcnt(0)" ::: "memory"); __builtin_amdgcn_s_barrier(); asm volatile("" ::: "memory");
        f32x4 tot[4];
#pragma unroll
        for (int mt = 0; mt < 4; ++mt) { f32x4 pr[8];
#pragma unroll
            for (int w = 0; w < 8; ++w) pr[w] = *(const LAS f32x4*)(red + w * 64 + 16 * mt + 4 * g);
            tot[mt] = ((pr[0] + pr[1]) + (pr[2] + pr[3])) + ((pr[4] + pr[5]) + (pr[6] + pr[7])); }
#pragma unroll
        for (int mt = 0; mt < 4; ++mt)
#pragma unroll
            for (int r = 0; r < 4; ++r) { const int tk = 16 * mt + 4 * g + r;
                const float rn = rsqrtf(tot[mt][r] * (1.f / 128.f) + 1e-6f);
                const float ogf = __builtin_bit_cast(float, (unsigned)ogv[mt][r] << 16);
                const unsigned ov = pk2(accO[mt][r] * rn * gdn * silu_f(ogf), 0.f) & 0xffffu;
                if (ABL & 1) asm volatile("" :: "v"(ov)); else MIX[(size_t)(row0 + tk) * D + h * 128 + 16 * wave + dvl] = (bf16)ov; }
    }
    asm volatile("s_waitcnt vmcnt(0) lgkmcnt(0)" ::: "memory"); __builtin_amdgcn_s_barrier();
#undef D3_ISSUE
#undef D3_LOADS
#undef D3_OG
}
__device__ __forceinline__ void sc_rows(Frame& F, int first_wg) {
    const int gw = ((int)blockIdx.x - first_wg) * NWAVES + F.wave, NGW = (F.G - first_wg) * NWAVES, lane = F.lane;
    if (gw < 0) return;
    bf16* MIX = (bf16*)(F.ws + WS_XM); const bf16* PR = (const bf16*)(F.ws + WS_PR);
    f32x4 w0[3], w1[3];
#pragma unroll
    for (int i = 0; i < 3; ++i) { w0[i] = *(const f32x4*)(F.a->in[22] + i * 512 + lane * 8); w1[i] = *(const f32x4*)(F.a->in[22] + i * 512 + lane * 8 + 4); }
    for (int m = gw; m < M; m += NGW) {
        const bool prm = m < MP; const int t = prm ? (m & (T - 1)) : ((m - MP) & 3), sq = prm ? (m >> 11) : ((m - MP) >> 2);
        v4u cw[3], hw[3]; f32x4 sa[2], sbq[2];
#pragma unroll
        for (int i = 0; i < 3; ++i) { const int tt = t - 2 + i; cw[i] = (v4u){0u, 0u, 0u, 0u}; hw[i] = cw[i];
            if (tt >= 0) { cw[i] = *(const GAS v4u*)(PR + (size_t)(m - 2 + i) * PR_LD + PR_SC + lane * 8); hw[i] = *(const GAS v4u*)(PR + (size_t)(m - 2 + i) * PR_LD + PR_SH + lane * 8); } }
        const v4u sbw = *(const GAS v4u*)(PR + (size_t)m * PR_LD + PR_SB + lane * 8);
        if (!prm && t < 2) {
#pragma unroll
            for (int i = 0; i < 2; ++i) { sa[i] = (f32x4){0.f, 0.f, 0.f, 0.f}; sbq[i] = sa[i];
                if (t - 2 + i < 0) { const float* sb = F.a->in[4] + ((size_t)sq * 2 + (t + i)) * 512 + lane * 8; sa[i] = *(const f32x4*)sb; sbq[i] = *(const f32x4*)(sb + 4); } } }
        float zc[8], z2[8];
#pragma unroll
        for (int e = 0; e < 8; ++e) zc[e] = 0.f;
#pragma unroll
        for (int i = 0; i < 3; ++i) { const int tt = t - 2 + i; float z[8];
            if (tt >= 0) { float c[8], hh[8]; unpack8(cw[i], c); unpack8(hw[i], hh);
#pragma unroll
                for (int e = 0; e < 8; ++e) z[e] = c[e] * hh[e]; }
            else if (!prm && i < 2) { z[0] = sa[i].x; z[1] = sa[i].y; z[2] = sa[i].z; z[3] = sa[i].w; z[4] = sbq[i].x; z[5] = sbq[i].y; z[6] = sbq[i].z; z[7] = sbq[i].w; }
            else {
#pragma unroll
                for (int e = 0; e < 8; ++e) z[e] = 0.f; }
            zc[0] += z[0] * w0[i].x; zc[1] += z[1] * w0[i].y; zc[2] += z[2] * w0[i].z; zc[3] += z[3] * w0[i].w; zc[4] += z[4] * w1[i].x; zc[5] += z[5] * w1[i].y; zc[6] += z[6] * w1[i].z; zc[7] += z[7] * w1[i].w;
            if (i == 2) {
#pragma unroll
                for (int e = 0; e < 8; ++e) z2[e] = z[e]; }
        }
        float sb[8]; unpack8(sbw, sb);
        *(GAS v4u*)(MIX + (size_t)m * D + 512 + lane * 8) = (v4u){pk2(sb[0] * zc[0], sb[1] * zc[1]), pk2(sb[2] * zc[2], sb[3] * zc[3]), pk2(sb[4] * zc[4], sb[5] * zc[5]), pk2(sb[6] * zc[6], sb[7] * zc[7])};
        const int Tg = prm ? T : TS;
        if (t >= Tg - 2) { float* cm = F.out + (prm ? O_CM_P : O_CM_S) + ((size_t)sq * 2 + (t - (Tg - 2))) * 512 + lane * 8;
            *(f32x4*)cm = (f32x4){z2[0], z2[1], z2[2], z2[3]}; *(f32x4*)(cm + 4) = (f32x4){z2[4], z2[5], z2[6], z2[7]}; }
    }
}
__device__ __forceinline__ void p8_sample_unit(Frame& F, int unit) {
    int tid_l = F.tid; asm volatile("" : "+v"(tid_l));
    const int sq = unit >> 2, h = unit & 3, tid = tid_l, lane = tid & 63, wave = F.wave;
    LAS float* Lf = (LAS float*)F.lds;
    LAS float* QKV_ = Lf;
    LAS float* RED = Lf + 1536;
    LAS float* SCAL = Lf + 2048;
    LAS float* OB = Lf + 2080;
    const bf16* P = (const bf16*)(F.ws + WS_PQ); const bf16* PR = (const bf16*)(F.ws + WS_PR); const float* GB = (const float*)(F.ws + WS_GB);
    const int m0 = MP + 4 * sq;
    const int kq = tid >> 7, dv = tid & 127;
    float S[32];
    const float* S0 = F.a->in[2] + ((size_t)(sq * 4 + h) * 128 + 32 * kq) * 128 + dv;
#pragma unroll
    for (int i = 0; i < 32; ++i) S[i] = S0[(size_t)i * 128];
    float decv[4], btv[4];
#pragma unroll
    for (int t = 0; t < 4; ++t) { decv[t] = GB[(size_t)(m0 + t) * 4 + h]; btv[t] = GB[(size_t)M * 4 + (size_t)(m0 + t) * 4 + h]; }
    if (tid < 384) { const int part = tid >> 7, ch = tid & 127, c = part * 512 + h * 128 + ch;
        float xp[7];
#pragma unroll
        for (int i = 0; i < 3; ++i) xp[i] = F.a->in[3][((size_t)sq * 3 + i) * QKV + c];
#pragma unroll
        for (int t = 0; t < 4; ++t) xp[3 + t] = __builtin_bit_cast(float, (unsigned)P[(size_t)(m0 + t) * PQ_LD + c] << 16);
#pragma unroll
        for (int t = 1; t < 4; ++t) F.out[O_CQ_S + ((size_t)sq * 3 + (t - 1)) * QKV + c] = xp[3 + t];
        const float w0 = F.a->in[18][c], w1 = F.a->in[18][QKV + c], w2 = F.a->in[18][2 * QKV + c], w3 = F.a->in[18][3 * QKV + c];
#pragma unroll
        for (int t = 0; t < 4; ++t) QKV_[(part * 4 + t) * 128 + ch] = silu_f(xp[t] * w0 + xp[t + 1] * w1 + xp[t + 2] * w2 + xp[t + 3] * w3); }
    LDS_WAIT(); __syncthreads();
    {
        const int part = wave >> 2, t = wave & 3; const float a = QKV_[(part * 4 + t) * 128 + lane], bq = QKV_[(part * 4 + t) * 128 + 64 + lane];
        const float ss = wave_sum(a * a + bq * bq); const float rn = rsqrtf(ss + 1e-6f) * (part == 0 ? 0.08838834764831845f : 1.0f);
        QKV_[(part * 4 + t) * 128 + lane] = a * rn; QKV_[(part * 4 + t) * 128 + 64 + lane] = bq * rn; }
    LDS_WAIT(); __syncthreads();
#pragma unroll
    for (int t = 0; t < 4; ++t) {
        const float dec = __expf(decv[t]), bt = btv[t];
        const LAS float* qv = QKV_ + (0 * 4 + t) * 128 + 32 * kq; const LAS float* kv = QKV_ + (1 * 4 + t) * 128 + 32 * kq;
        float ks = 0.f;
#pragma unroll
        for (int i = 0; i < 32; ++i) { S[i] *= dec; ks += kv[i] * S[i]; }
        RED[kq * 128 + dv] = ks;
        LDS_WAIT(); __syncthreads();
        const float kS = (RED[dv] + RED[128 + dv]) + (RED[256 + dv] + RED[384 + dv]);
        const float vn = bt * (QKV_[(2 * 4 + t) * 128 + dv] - kS);
        float o = 0.f;
#pragma unroll
        for (int i = 0; i < 32; ++i) { S[i] += kv[i] * vn; o += qv[i] * S[i]; }
        LDS_WAIT(); __syncthreads();
        RED[kq * 128 + dv] = o;
        LDS_WAIT(); __syncthreads();
        if (kq == 0) OB[t * 128 + dv] = (RED[dv] + RED[128 + dv]) + (RED[256 + dv] + RED[384 + dv]);
        LDS_WAIT(); __syncthreads();
    }
    float* So = F.out + O_SSM_S + ((size_t)(sq * 4 + h) * 128 + 32 * kq) * 128 + dv;
#pragma unroll
    for (int i = 0; i < 32; ++i) So[(size_t)i * 128] = S[i];
    if (wave < 4) { const int t = wave; const float a = OB[t * 128 + lane], bq = OB[t * 128 + 64 + lane];
        const float rn = rsqrtf(wave_sum(a * a + bq * bq) * (1.f / 128.f) + 1e-6f);
        bf16* MIX = (bf16*)(F.ws + WS_XM);
        const float og0 = __builtin_bit_cast(float, (unsigned)PR[(size_t)(m0 + t) * PR_LD + PR_OG + h * 128 + lane] << 16), og1 = __builtin_bit_cast(float, (unsigned)PR[(size_t)(m0 + t) * PR_LD + PR_OG + h * 128 + 64 + lane] << 16);
        MIX[(size_t)(m0 + t) * D + h * 128 + lane] = (bf16)f2bf(a * rn * F.a->in[21][lane] * silu_f(og0));
        MIX[(size_t)(m0 + t) * D + h * 128 + 64 + lane] = (bf16)f2bf(bq * rn * F.a->in[21][64 + lane] * silu_f(og1)); }
    LDS_WAIT(); __syncthreads();
}
__device__ __forceinline__ int opaque_i(int v) { asm volatile("" : "+v"(v)); return __builtin_amdgcn_readfirstlane(v); }
constexpr int N_PHASES = 14;
__global__ void __launch_bounds__(NWAVES * 64, 2) mk_fwd(Args args) {
    extern __shared__ __attribute__((aligned(16))) unsigned char lds[];
    Frame F;
    F.lds = (LAS unsigned char*)lds;
    F.MISC = (volatile LAS unsigned*)(F.lds + MISC_OFF);
    F.tid = threadIdx.x; F.lane = F.tid & 63; F.wave = __builtin_amdgcn_readfirstlane(F.tid >> 6);
    F.G = gridDim.x; { const int bx = blockIdx.x; F.vcu = (F.G % 8 == 0) ? (bx % 8) * (F.G / 8) + bx / 8 : bx; }
    F.a = &args;
    F.out = args.out; F.ws = args.ws;
    F.ctl = (gu32*)(F.ws + WS_CTL);
    for (int u = F.tid; u < (LDS_BYTES - LDSCTL_OFF) / 4; u += NWAVES * 64) ((LAS unsigned*)(F.lds + LDSCTL_OFF))[u] = 0u;
    __syncthreads();
    XcdBarrier bar = xcd_barrier_post((unsigned*)(F.ctl + CW_BAR), F.MISC + 8);
    xcd_barrier_census(bar);
    const int lo = args.ph_lo, hi = args.ph_hi;
#ifndef PHASE_MASK
#define PHASE_MASK 0xFFFFF
#endif
#define IN(k) (((PHASE_MASK >> (k)) & 1) && lo <= (k) && (k) < hi)
#ifndef REP_MASK
#define REP_MASK 0
#endif
#ifndef PROBE
#define PROBE 0
#endif
#ifndef SCAN_ABL
#define SCAN_ABL 0
#endif
#ifndef D3_ABL
#define D3_ABL 0
#endif
#ifndef REP_SUB
#define REP_SUB 0
#endif
#define FRESH() do { int t_ = threadIdx.x; asm volatile("" : "+v"(t_)); F.tid = t_; F.lane = t_ & 63; } while (0)
#if REP_MASK
#define PHASE_BEGIN(k) _Pragma("unroll 1") for (int rep_ = 0; rep_ < 1 + ((REP_MASK >> (k)) & 1); ++rep_) { if (rep_) xcd_barrier(bar); FRESH();
#else
#define PHASE_BEGIN(k) if (IN(k)) { const int rep_ = 0; (void)rep_; FRESH();
#endif
#define PHASE_END(k) } if (IN(k) && IN((k) + 1)) xcd_barrier(bar);
    bf16* const XM = (bf16*)(F.ws + WS_XM); bf16* const Yb = (bf16*)(F.ws + WS_Y); bf16* const HB = (bf16*)(F.ws + WS_HP);

    PHASE_BEGIN(0) p0_ada(F); p_convert<0>(F); p_convert<1>(F); PHASE_END(0)
    PHASE_BEGIN(1) p1_mod(F); PHASE_END(1)
    PHASE_BEGIN(2)
        pg8::Gemm g{XM, (const bf16*)(F.ws + WS_W1U), M, NUP, D}; pg8::StaticOrder S; S.init(M, NUP, F.G, (int)blockIdx.x);
        pg8::EpiSwiglu E{HB, FF};
        pg8::gemm_phase<pg8::EpiSwiglu, pg8::StaticOrder, true, true>(F.lds + RING_OFF, g, S, E); PHASE_END(2)
    PHASE_BEGIN(3)
        pg8::Gemm g{HB, (const bf16*)(F.ws + WS_W1D), MP, D, FF}; pg8::StaticOrder S; S.init(MP, D, F.G, (int)blockIdx.x);
        pg8::EpiBf16P E{Yb, D, 0, nullptr, 0};
        pg8::gemm_phase<pg8::EpiBf16P, pg8::StaticOrder, true, true>(F.lds + RING_OFF, g, S, E);
        sample_gemm<FF>(F, HB + (size_t)MP * FF, (const bf16*)(F.ws + WS_W1D), Yb + (size_t)MP * D); PHASE_END(3)
    PHASE_BEGIN(4) if (rep_ == 0) ln_pass<0>(F, 0.5f); else ln_pass<0, false>(F, 0.5f); PHASE_END(4)
    PHASE_BEGIN(5)
        pg8::Gemm g{XM, (const bf16*)(F.ws + WS_WIN), M, NIN, D}; pg8::StaticOrder S; S.init(M, NIN, F.G, (int)blockIdx.x);
        pg8::EpiBf16P E{(bf16*)(F.ws + WS_PQ), PQ_LD, 6, (bf16*)(F.ws + WS_PR), PR_LD};
        pg8::gemm_phase<pg8::EpiBf16P, pg8::StaticOrder, true, true>(F.lds + RING_OFF, g, S, E); PHASE_END(5)
    PHASE_BEGIN(6) for (int ci = (int)blockIdx.x; ci < 1024; ci += F.G) d1_unit(F, ci); PHASE_END(6)
    PHASE_BEGIN(7) if (!(rep_ && (REP_SUB & 1))) { if (rep_) scan_phase<SCAN_ABL>(F); else scan_phase<0>(F); } if (!(rep_ && (REP_SUB & 2))) sc_rows(F, 64); PHASE_END(7)
    PHASE_BEGIN(8) if (!(rep_ && (REP_SUB & 1))) { if (rep_) d3_phase<D3_ABL>(F); else d3_phase<0>(F); } if (!(rep_ && (REP_SUB & 2))) for (int u = (int)blockIdx.x; u < 4 * NS; u += F.G) p8_sample_unit(F, u); PHASE_END(8)
    PHASE_BEGIN(9)
        pg8::Gemm g{XM, (const bf16*)(F.ws + WS_WOUT), MP, D, D}; pg8::StaticOrder S; S.init(MP, D, F.G, (int)blockIdx.x);
        pg8::EpiBf16P E{Yb, D, 0, nullptr, 0};
        pg8::gemm_phase<pg8::EpiBf16P, pg8::StaticOrder, true, true>(F.lds + RING_OFF, g, S, E);
        sample_gemm<D>(F, XM + (size_t)MP * D, (const bf16*)(F.ws + WS_WOUT), Yb + (size_t)MP * D); PHASE_END(9)
    PHASE_BEGIN(10) ln_pass<1>(F, 1.0f); PHASE_END(10)
    PHASE_BEGIN(11)
        pg8::Gemm g{XM, (const bf16*)(F.ws + WS_W2U), M, NUP, D}; pg8::StaticOrder S; S.init(M, NUP, F.G, (int)blockIdx.x);
        pg8::EpiSwiglu E{HB, FF};
        pg8::gemm_phase<pg8::EpiSwiglu, pg8::StaticOrder, true, true>(F.lds + RING_OFF, g, S, E); PHASE_END(11)
    PHASE_BEGIN(12)
        pg8::Gemm g{HB, (const bf16*)(F.ws + WS_W2D), MP, D, FF}; pg8::StaticOrder S; S.init(MP, D, F.G, (int)blockIdx.x);
        pg8::EpiBf16P E{Yb, D, 0, nullptr, 0};
        pg8::gemm_phase<pg8::EpiBf16P, pg8::StaticOrder, true, true>(F.lds + RING_OFF, g, S, E);
        sample_gemm<FF>(F, HB + (size_t)MP * FF, (const bf16*)(F.ws + WS_W2D), Yb + (size_t)MP * D); PHASE_END(12)
    PHASE_BEGIN(13) ln_pass<2>(F, 0.5f); PHASE_END(13)
#if PROBE == 1
    for (int i_ = 0; i_ < 16; ++i_) xcd_barrier(bar);
#elif PROBE == 2
    xcd_barrier(bar);
    if (F.tid == 0) { const float* GLp = (const float*)(F.ws + FRB_GL); int i_ = (int)blockIdx.x; float acc_ = 0.f;
        for (int j_ = 0; j_ < 256; ++j_) { const float x_ = __hip_atomic_load(GLp + i_, __ATOMIC_RELAXED, __HIP_MEMORY_SCOPE_AGENT); acc_ += x_; i_ = (i_ + 37 + (x_ > 1e30f ? 1 : 0)) & 1023; }
        if (acc_ == 123.456f) F.ws[WS_END - 1] = 1; }
#elif PROBE == 4 || PROBE == 5
    xcd_barrier(bar);
    if (F.wave == 0 && (PROBE == 4 || blockIdx.x < 64)) { float a_ = (float)F.lane, b_ = 1.0001f;
#pragma unroll 1
        for (int j_ = 0; j_ < 1024; ++j_) { _Pragma("unroll") for (int q_ = 0; q_ < 16; ++q_) asm volatile("v_fma_f32 %0, %0, %1, %1" : "+v"(a_) : "v"(b_)); }
        if (a_ == 123.456f) F.ws[WS_END - 1] = 1; }
#elif PROBE == 3
    xcd_barrier(bar);
    if (F.tid == 0) { const float* GLp = (const float*)(F.ws + WS_PR); size_t i_ = (size_t)blockIdx.x * 65536; float acc_ = 0.f;
        for (int j_ = 0; j_ < 256; ++j_) { const float x_ = GLp[i_]; acc_ += x_; i_ = (i_ + 1048583 + (x_ > 1e30f ? 1 : 0)) % (size_t)(16 * 1024 * 1024); }
        if (acc_ == 123.456f) F.ws[WS_END - 1] = 1; }
#endif
#undef IN
#undef SEAM
}
extern "C" void kernel_launch(void* const* d_in, const int* in_sizes, int n_in, void* d_out, int out_size, void* d_ws, size_t ws_size, hipStream_t stream) {
    static int ok = 0;
    if (ok == 0) {
        int dev = 0, cus = 0;
        if (n_in != 24 || out_size != (int)O_END || ws_size < WS_END || hipGetDevice(&dev) != hipSuccess || hipDeviceGetAttribute(&cus, hipDeviceAttributeMultiprocessorCount, dev) != hipSuccess || cus < 256 ||
            hipFuncSetAttribute((const void*)mk_fwd, hipFuncAttributeMaxDynamicSharedMemorySize, LDS_BYTES) != hipSuccess) {
            fprintf(stderr, "kernel_launch: unexpected problem/device (n_in %d out %d ws %zu cus %d); nothing launched\n", n_in, out_size, ws_size, cus); ok = -1; return; }
        ok = 1;
    }
    if (ok < 0) return;
    (void)hipMemsetAsync((char*)d_ws + WS_CTL, 0, CTL_ZERO_BYTES, stream);
    Args a{};
    for (int i = 0; i < 24; ++i) a.in[i] = (const float*)d_in[i];
    a.out = (float*)d_out; a.ws = (unsigned char*)d_ws; a.ph_lo = 0; a.ph_hi = N_PHASES;
    hipLaunchKernelGGL(mk_fwd, dim3(256), dim3(NWAVES * 64), LDS_BYTES, stream, a);
}
```

```cpp
#include <hip/hip_runtime.h>
#include <cstdio>
#include <cstdint>
namespace pg8 {
#define PG8_LAS __attribute__((address_space(3)))
typedef unsigned short bf16_t;
typedef short bf16x8 __attribute__((ext_vector_type(8)));
typedef float f32x4 __attribute__((ext_vector_type(4)));
typedef unsigned u32x4 __attribute__((ext_vector_type(4)));
constexpr int BM = 256, BK = 64, HALF = 128, HTB = HALF * BK * 2  , STAGE_BYTES = 8 * HTB, NXCD = 8, WGM = 4;

__host__ __device__ __forceinline__ int lds_byte(int r, int c) { const int st = (r >> 4) * 2 + (c >> 5), rr = r & 15, cc = c & 31, ob = rr * 64 + cc * 2; return st * 1024 + (ob ^ (((ob >> 9) & 1) << 5)); }
__host__ __device__ __forceinline__ void stage_rc(int b, int& R, int& C) { const int st = b / 1024, sb = b % 1024, swz = sb ^ (((sb >> 9) & 1) << 5); R = (st >> 1) * 16 + swz / 64; C = (st & 1) * 32 + (swz % 64) / 2; }
__host__ __device__ __forceinline__ int perm32(int rho) { const int n = rho >> 4, i = rho & 15; return 8 * (i >> 2) + 4 * n + (i & 3); }

struct Unit { int pm, pn; };
struct Gemm { const bf16_t* A; const bf16_t* Bt; int M, N, K; };

struct StaticOrder {
    int nM, nN, nwg, G, c;
    __host__ __device__ void init(int M, int N, int G_, int c_) { nM = M / BM; nN = N / BM; nwg = nM * nN; G = G_; c = c_; }
    __host__ __device__ bool next(int i, Unit& u) const {
        const long L = (long)i * G + c; if (L >= nwg) return false;
        int wgid = (int)L; { const int q = nwg / NXCD, r = nwg % NXCD, xcd = wgid % NXCD, off = wgid / NXCD; wgid = (xcd < r ? xcd * (q + 1) : r * (q + 1) + (xcd - r) * q) + off; }
        const int nig = WGM * nN, gid = wgid / nig, fm = gid * WGM, gsz = (nM - fm) < WGM ? (nM - fm) : WGM;
        u.pm = fm + ((wgid % nig) % gsz); u.pn = (wgid % nig) / gsz; return true;
    }
    __device__ __forceinline__ void a_ready(const Unit&) const {}
    __device__ __forceinline__ void done(const Unit&) const {}
};

__device__ __forceinline__ unsigned cvt_pk_bf16(float lo, float hi) { unsigned r; asm volatile("v_cvt_pk_bf16_f32 %0, %1, %2" : "=v"(r) : "v"(lo), "v"(hi)); return r; }
typedef float f32x2 __attribute__((ext_vector_type(2)));
#ifndef EPI_X
#define EPI_X 0
#endif
struct EpiBf16P {
    static constexpr bool PERM = true, AFTER_DRAIN = false;
    bf16_t* O; int ldc; int split_pn; bf16_t* O2; int ldc2;
    __device__ __forceinline__ void operator()(const f32x4 (&acc)[2][2][4][2], const Unit& u, int wr, int wc, int fr, int fq) const {
        const bool second = split_pn > 0 && u.pn >= split_pn;
        bf16_t* const base = second ? O2 : O; const int ld = second ? ldc2 : ldc;
        const int row0 = u.pm * BM + wr * 64 + fr, col0 = (second ? u.pn - split_pn : u.pn) * BM + wc * 32 + 8 * fq;
#pragma unroll
        for (int ai = 0; ai < 2; ++ai)
#pragma unroll
            for (int m = 0; m < 4; ++m) { bf16_t* rowp = base + (size_t)(row0 + ai * HALF + m * 16) * ld + col0;
#pragma unroll
                for (int bj = 0; bj < 2; ++bj) { const f32x4 v0 = acc[ai][bj][m][0], v1 = acc[ai][bj][m][1];
                    u32x4 w; w.x = cvt_pk_bf16(v0[0], v0[1]); w.y = cvt_pk_bf16(v0[2], v0[3]); w.z = cvt_pk_bf16(v1[0], v1[1]); w.w = cvt_pk_bf16(v1[2], v1[3]);
                    *(u32x4*)(rowp + bj * HALF) = w; } }
    }
};
__device__ __forceinline__ float swiglu1(float g, float u) { return g * u * __builtin_amdgcn_rcpf(1.0f + __builtin_amdgcn_exp2f(-1.4426950408889634f * g)); }
struct EpiSwiglu {
    static constexpr bool PERM = true, AFTER_DRAIN = false;
    bf16_t* O; int ldc;
    __device__ __forceinline__ void operator()(const f32x4 (&acc)[2][2][4][2], const Unit& u, int wr, int wc, int fr, int fq) const {
        const int row0 = u.pm * BM + wr * 64 + fr, col0 = u.pn * HALF + wc * 32 + 8 * fq;
#pragma unroll
        for (int ai = 0; ai < 2; ++ai)
#pragma unroll
            for (int m = 0; m < 4; ++m) { bf16_t* rowp = O + (size_t)(row0 + ai * HALF + m * 16) * ldc + col0;
                const f32x4 g0 = acc[ai][0][m][0], g1 = acc[ai][0][m][1], u0 = acc[ai][1][m][0], u1 = acc[ai][1][m][1];
                u32x4 w; w.x = cvt_pk_bf16(swiglu1(g0[0], u0[0]), swiglu1(g0[1], u0[1])); w.y = cvt_pk_bf16(swiglu1(g0[2], u0[2]), swiglu1(g0[3], u0[3]));
                w.z = cvt_pk_bf16(swiglu1(g1[0], u1[0]), swiglu1(g1[1], u1[1])); w.w = cvt_pk_bf16(swiglu1(g1[2], u1[2]), swiglu1(g1[3], u1[3]));
                *(u32x4*)rowp = w; }
    }
};

struct PanelStats {
    unsigned* xbuf;
    unsigned* cnt;
    unsigned* tmo;
    int ntn; float eps;
    unsigned code;
    __device__ __forceinline__ bool run(const f32x4 (&v)[2][2][4][2], const Unit& u, int wr, int wc, int fr, int fq, PG8_LAS unsigned char* lds, int wid, int lane) const {
        typedef float f32x2v __attribute__((ext_vector_type(2)));
        PG8_LAS f32x2v* P = (PG8_LAS f32x2v*)lds;
        PG8_LAS f32x2v* S = (PG8_LAS f32x2v*)(lds + 8192);
        PG8_LAS unsigned* flag = (PG8_LAS unsigned*)(lds + 8192 + 2048);
#pragma unroll
        for (int ai = 0; ai < 2; ++ai)
#pragma unroll
            for (int m = 0; m < 4; ++m) {
                float s = 0.f;
#pragma unroll
                for (int bj = 0; bj < 2; ++bj)
#pragma unroll
                    for (int n = 0; n < 2; ++n) { const f32x4 x = v[ai][bj][m][n]; s += (x[0] + x[1]) + (x[2] + x[3]); }
                s += __shfl_xor(s, 16); s += __shfl_xor(s, 32);
                const float mw = s * (1.0f / 64.0f); float q = 0.f;
#pragma unroll
                for (int bj = 0; bj < 2; ++bj)
#pragma unroll
                    for (int n = 0; n < 2; ++n) { const f32x4 d = v[ai][bj][m][n] - mw; q += (d[0] * d[0] + d[1] * d[1]) + (d[2] * d[2] + d[3] * d[3]); }
                q += __shfl_xor(q, 16); q += __shfl_xor(q, 32);
                if (fq == 0) P[(ai * HALF + wr * 64 + m * 16 + fr) * 4 + wc] = (f32x2v){mw, q};
            }
        asm volatile("s_waitcnt lgkmcnt(0)" ::: "memory"); __builtin_amdgcn_s_barrier(); asm volatile("" ::: "memory");
#if defined(BROKEN_EXCHANGE_NO_WAIT)
#warning BROKEN CONTROL BUILD: the row-statistics exchange does not wait; results are wrong by design
        if (blockIdx.x >= 64) { const long long t0_ = clock64(); while (clock64() - t0_ < 60000) __builtin_amdgcn_s_sleep(8); }
#endif
        const int row = wid * 32 + (lane & 31);
        if (lane < 32) {
            const f32x2v a = P[row * 4 + 0], b = P[row * 4 + 1], c = P[row * 4 + 2], d = P[row * 4 + 3];
            const float mt = (a.x + b.x + c.x + d.x) * 0.25f;
            const float da = a.x - mt, db = b.x - mt, dc = c.x - mt, dd = d.x - mt;
            const float m2 = (a.y + b.y) + (c.y + d.y) + 64.0f * ((da * da + db * db) + (dc * dc + dd * dd));
            unsigned long long* slot = (unsigned long long*)xbuf + ((size_t)(u.pm * BM + row) * 4 + u.pn);
            __hip_atomic_store(slot, ((unsigned long long)__float_as_uint(m2) << 32) | __float_as_uint(mt), __ATOMIC_RELAXED, __HIP_MEMORY_SCOPE_AGENT);
        }
        asm volatile("s_waitcnt vmcnt(0)" ::: "memory");
        if (lane == 0) __hip_atomic_fetch_add(cnt + 64 * u.pm, 1u, __ATOMIC_RELAXED, __HIP_MEMORY_SCOPE_AGENT);
        if (wid == 0) {
            bool dead = false; const unsigned long long t0 = __builtin_amdgcn_s_memrealtime(); const unsigned want = 8u * (unsigned)ntn;
            for (;;) {
#if defined(BROKEN_EXCHANGE_NO_WAIT)
                break;
#endif
                if ((unsigned)__builtin_amdgcn_readfirstlane(__hip_atomic_load(cnt + 64 * u.pm, __ATOMIC_RELAXED, __HIP_MEMORY_SCOPE_AGENT)) >= want) break;
                if (__builtin_amdgcn_s_memrealtime() - t0 > 2000000ull) {
                    if (lane == 0) { unsigned expect = 0u; __hip_atomic_compare_exchange_strong(tmo + 1, &expect, code | (unsigned)(u.pm & 0xff), __ATOMIC_RELAXED, __ATOMIC_RELAXED, __HIP_MEMORY_SCOPE_AGENT);
                                     __hip_atomic_store(tmo, 1u, __ATOMIC_RELAXED, __HIP_MEMORY_SCOPE_AGENT); }
                    dead = true; break; }
                __builtin_amdgcn_s_sleep(2);
            }
            __builtin_amdgcn_fence(__ATOMIC_ACQUIRE, "agent");
            if (lane == 0) flag[0] = dead ? 1u : 0u;
        }
        asm volatile("s_waitcnt vmcnt(0) lgkmcnt(0)" ::: "memory"); __builtin_amdgcn_s_barrier(); asm volatile("" ::: "memory");
        const bool bad = flag[0] != 0u;
        if (lane < 32) {
            const unsigned long long* slot = (const unsigned long long*)xbuf + (size_t)(u.pm * BM + row) * 4; float mt[4], m2[4]; float ms = 0.f;
#pragma unroll
            for (int t = 0; t < 4; ++t) { if (t < ntn) { const unsigned long long w = __hip_atomic_load(slot + t, __ATOMIC_RELAXED, __HIP_MEMORY_SCOPE_AGENT); mt[t] = __uint_as_float((unsigned)w); m2[t] = __uint_as_float((unsigned)(w >> 32)); } else { mt[t] = 0.f; m2[t] = 0.f; } ms += mt[t]; }
            const float mean = ms / (float)ntn; float q = 0.f;
#pragma unroll
            for (int t = 0; t < 4; ++t) if (t < ntn) { const float dm = mt[t] - mean; q += m2[t] + 256.0f * dm * dm; }
            S[row] = (f32x2v){mean, 1.0f / sqrtf(q / (256.0f * (float)ntn) + eps)};
        }
        asm volatile("s_waitcnt lgkmcnt(0)" ::: "memory"); __builtin_amdgcn_s_barrier(); asm volatile("" ::: "memory");
        return bad;
    }
};

template <int I> struct EpiLnMod {
    static constexpr bool PERM = true, AFTER_DRAIN = true;
    const float* xin; float* out; bf16_t* xm; const float* mod; const float* lg; const float* lb; PanelStats st;
    static constexpr float yscale = (I == 1) ? 1.0f : 0.5f;
    __device__ __forceinline__ void fused(f32x4 (&acc)[2][2][4][2], const Unit& u, int wr, int wc, int fr, int fq, PG8_LAS unsigned char* lds, int wid, int lane) const {
        typedef float f32x2v __attribute__((ext_vector_type(2)));
        const PG8_LAS f32x2v* S = (const PG8_LAS f32x2v*)(lds + 8192);
        const int col0 = u.pn * BM + wc * 32 + 8 * fq;
        const float* ms = mod + (size_t)(u.pm >> 3) * 9216 + I * 3072;
        const float alpha = 1.189207115002721f;
        const unsigned loff = (unsigned)fr * 4096u + (unsigned)(u.pn * BM + wc * 32 + 8 * fq) * 4u;
#pragma unroll
        for (int bj = 0; bj < 2; ++bj)
#pragma unroll
            for (int n = 0; n < 2; ++n) { const f32x4 gt = *(const f32x4*)(ms + 2048 + col0 + bj * HALF + 4 * n) * yscale;
                f32x4 xv[2][4];
#pragma unroll
                for (int ai = 0; ai < 2; ++ai)
#pragma unroll
                    for (int m = 0; m < 4; ++m) {
                        const char* rb = (const char*)xin + (size_t)(u.pm * BM + ai * HALF + wr * 64 + m * 16) * 4096 + (bj * HALF + 4 * n) * 4;
                        xv[ai][m] = *(const f32x4*)(rb + loff); }
#pragma unroll
                for (int ai = 0; ai < 2; ++ai)
#pragma unroll
                    for (int m = 0; m < 4; ++m) { acc[ai][bj][m][n] = xv[ai][m] * alpha + gt * acc[ai][bj][m][n]; asm volatile("" : "+v"(acc[ai][bj][m][n])); }
                asm volatile("" ::: "memory");
            }
        const bool bad = st.run(acc, u, wr, wc, fr, fq, lds, wid, lane);
        const float qnan = __builtin_nanf("");
#pragma unroll
        for (int bj = 0; bj < 2; ++bj) {
            f32x4 g4[2], b4[2], sc4[2], sh4[2];
#pragma unroll
            for (int n = 0; n < 2; ++n) {
#if EPI_X & 2
                g4[n] = (f32x4){1.f, 1.f, 1.f, 1.f}; b4[n] = g4[n];
#else
                g4[n] = *(const f32x4*)(lg + col0 + bj * HALF + 4 * n); b4[n] = *(const f32x4*)(lb + col0 + bj * HALF + 4 * n);
#endif
                if (I < 2) { sh4[n] = *(const f32x4*)(ms + 3072 + col0 + bj * HALF + 4 * n); sc4[n] = *(const f32x4*)(ms + 4096 + col0 + bj * HALF + 4 * n) + 1.0f; } }
#pragma unroll
            for (int ai = 0; ai < 2; ++ai)
#pragma unroll
                for (int m = 0; m < 4; ++m) { const int r = ai * HALF + wr * 64 + m * 16 + fr; const f32x2v sr = S[r];
                    float* const outp = (float*)((char*)out + (size_t)(u.pm * BM + ai * HALF + wr * 64 + m * 16) * 4096 + bj * HALF * 4 + loff);
                    bf16_t* const xmp = (bf16_t*)((char*)xm + (size_t)(u.pm * BM + ai * HALF + wr * 64 + m * 16) * 2048 + bj * HALF * 2 + (loff >> 1));
                    f32x4 o0 = (acc[ai][bj][m][0] - sr.x) * sr.y * g4[0] + b4[0], o1 = (acc[ai][bj][m][1] - sr.x) * sr.y * g4[1] + b4[1];
                    if (bad) { o0 = (f32x4){qnan, qnan, qnan, qnan}; o1 = o0; }
                    *(f32x4*)outp = o0; *(f32x4*)(outp + 4) = o1;
                    if (I < 2) { const f32x4 u0 = o0 * sc4[0] + sh4[0], u1 = o1 * sc4[1] + sh4[1];
                        u32x4 w; w.x = cvt_pk_bf16(u0[0], u0[1]); w.y = cvt_pk_bf16(u0[2], u0[3]); w.z = cvt_pk_bf16(u1[0], u1[1]); w.w = cvt_pk_bf16(u1[2], u1[3]);
                        *(u32x4*)xmp = w; }
                    asm volatile("" ::: "memory"); }
            asm volatile("" ::: "memory");
        }
    }
};
struct EpiWin {
    static constexpr bool PERM = true, AFTER_DRAIN = false;
    bf16_t* PQ; bf16_t* PR; float* GB; const float* a_log; const float* dt_bias; int Mrows;
    __device__ __forceinline__ void operator()(const f32x4 (&acc)[2][2][4][2], const Unit& u, int wr, int wc, int fr, int fq) const {
        const int row0 = u.pm * BM + wr * 64 + fr;
        if (u.pn < 14) {
            const bool second = u.pn >= 6; bf16_t* const base = second ? PR : PQ; const int ld = second ? 2048 : 1536;
            const int col0 = (second ? u.pn - 6 : u.pn) * BM + wc * 32 + 8 * fq;
#pragma unroll
            for (int ai = 0; ai < 2; ++ai)
#pragma unroll
                for (int m = 0; m < 4; ++m) { bf16_t* rowp = base + (size_t)(row0 + ai * HALF + m * 16) * ld + col0;
#pragma unroll
                    for (int bj = 0; bj < 2; ++bj) { const f32x4 v0 = acc[ai][bj][m][0], v1 = acc[ai][bj][m][1];
                        u32x4 w; w.x = cvt_pk_bf16(v0[0], v0[1]); w.y = cvt_pk_bf16(v0[2], v0[3]); w.z = cvt_pk_bf16(v1[0], v1[1]); w.w = cvt_pk_bf16(v1[2], v1[3]);
                        *(u32x4*)(rowp + bj * HALF) = w; } }
        } else if (wc == 0 && fq == 0) {
            const f32x4 al = *(const f32x4*)a_log, dt = *(const f32x4*)dt_bias;
#pragma unroll
            for (int ai = 0; ai < 2; ++ai)
#pragma unroll
                for (int m = 0; m < 4; ++m) { const int row = row0 + ai * HALF + m * 16; const f32x4 a = acc[ai][0][m][0], b = acc[ai][0][m][1]; f32x4 gv, bv;
#pragma unroll
                    for (int h = 0; h < 4; ++h) { const float z = a[h] + dt[h]; const float sp = z > 20.f ? z : log1pf(__expf(z)); gv[h] = -__expf(al[h]) * sp; bv[h] = 1.f / (1.f + __expf(-b[h])); }
                    *(f32x4*)(GB + (size_t)row * 4) = gv; *(f32x4*)(GB + (size_t)Mrows * 4 + (size_t)row * 4) = bv; }
        }
    }
};
template <class Epi, class Sched, bool ALIGN_EPI = false, bool SP2 = false>
__device__ __forceinline__ void gemm_phase(PG8_LAS unsigned char* lds, const Gemm g, const Sched& S, const Epi& E) {
    int tid_l = threadIdx.x; asm volatile("" : "+v"(tid_l));
    const int tid = tid_l, wid = __builtin_amdgcn_readfirstlane(tid >> 6), lane = tid & 63, wr = wid >> 2, wc = wid & 3, fr = lane & 15, fq = lane >> 4;
    const int K = g.K, nt = K / BK;
    unsigned voffA[2], voffB[2];
#pragma unroll
    for (int i = 0; i < 2; ++i) { int R, C; stage_rc(tid * 16 + i * 8192, R, C); const int Rb = Epi::PERM ? ((R & ~31) + perm32(R & 31)) : R;
        voffA[i] = (unsigned)(R * K + C) * 2u; voffB[i] = (unsigned)(Rb * K + C) * 2u; }
    const size_t kstep = (size_t)(BK * 2);
    const size_t hstep = (size_t)HALF * K * 2;
    const size_t tstep = 2 * hstep;
    const unsigned ldsw = (unsigned)wid * 1024u;
    const int aoff = lds_byte(wr * 64 + fr, fq * 8), boff = lds_byte(wc * 32 + fr, fq * 8);
#define PG8_SA(b, h) (((b) * 2 + (h)) * HTB)
#define PG8_SB(b, h) ((4 + (b) * 2 + (h)) * HTB)
#define PG8_STAGE(bufoff, gbase, voff) do { _Pragma("unroll") for (int _i = 0; _i < 2; ++_i) \
        __builtin_amdgcn_global_load_lds((const unsigned*)((const char*)(gbase) + (voff)[_i]), (PG8_LAS unsigned*)(lds + (bufoff) + ldsw + _i * 8192), 16, 0, 0); } while (0)
#define PG8_LDA(dst, b, h) do { _Pragma("unroll") for (int m = 0; m < 4; ++m) _Pragma("unroll") for (int k = 0; k < 2; ++k) dst[m][k] = *(const PG8_LAS bf16x8*)(lds + PG8_SA(b, h) + aoff + m * 2048 + k * 1024); } while (0)
#define PG8_LDB(dst, b, h) do { _Pragma("unroll") for (int n = 0; n < 2; ++n) _Pragma("unroll") for (int k = 0; k < 2; ++k) dst[n][k] = *(const PG8_LAS bf16x8*)(lds + PG8_SB(b, h) + boff + n * 2048 + k * 1024); } while (0)
#define PG8_MMA(ai, bj, At, Bt) do { __builtin_amdgcn_s_setprio(1); _Pragma("unroll") for (int m = 0; m < 4; ++m) _Pragma("unroll") for (int n = 0; n < 2; ++n) _Pragma("unroll") for (int k = 0; k < 2; ++k) \
        acc[ai][bj][m][n] = __builtin_amdgcn_mfma_f32_16x16x32_bf16(Bt[n][k], At[m][k], acc[ai][bj][m][n], 0, 0, 0); __builtin_amdgcn_s_setprio(0); } while (0)
#define PG8_WAIT_V(n) asm volatile("s_waitcnt vmcnt(" #n ")" ::: "memory")
#define PG8_WAIT_L(n) asm volatile("s_waitcnt lgkmcnt(" #n ")" ::: "memory")
#define PG8_BAR __builtin_amdgcn_s_barrier()
#define PG8_SCHED __builtin_amdgcn_sched_barrier(0)
    Unit cur, nxt; int ui = 0;
    if (!S.next(0, cur)) return;
    f32x4 acc[2][2][4][2];
#pragma unroll
    for (int a = 0; a < 2; ++a)
#pragma unroll
        for (int b = 0; b < 2; ++b)
#pragma unroll
            for (int m = 0; m < 4; ++m)
#pragma unroll
                for (int n = 0; n < 2; ++n) acc[a][b][m][n] = (f32x4){0.f, 0.f, 0.f, 0.f};
    bf16x8 At[4][2], B0[2][2], B1[2][2];
    const char* cA = (const char*)g.A + (size_t)cur.pm * tstep; const char* cB = (const char*)g.Bt + (size_t)cur.pn * tstep;
    S.a_ready(cur);
    if constexpr (SP2) {
        PG8_STAGE(PG8_SB(0, 0), cB, voffB); PG8_STAGE(PG8_SB(0, 1), cB + hstep, voffB); PG8_STAGE(PG8_SA(0, 0), cA, voffA); PG8_STAGE(PG8_SA(0, 1), cA + hstep, voffA);
        if (wr == 1) PG8_BAR;
        PG8_WAIT_V(2); PG8_BAR;
        PG8_STAGE(PG8_SB(1, 0), cB + kstep, voffB); PG8_STAGE(PG8_SA(1, 0), cA + kstep, voffA); PG8_STAGE(PG8_SB(1, 1), cB + hstep + kstep, voffB);
        PG8_WAIT_V(6); PG8_BAR;
    } else {
        PG8_STAGE(PG8_SB(0, 0), cB, voffB); PG8_STAGE(PG8_SA(0, 0), cA, voffA); PG8_STAGE(PG8_SB(0, 1), cB + hstep, voffB); PG8_STAGE(PG8_SA(0, 1), cA + hstep, voffA);
        if (wr == 1) PG8_BAR;
        PG8_WAIT_V(4); PG8_BAR;
        PG8_STAGE(PG8_SB(1, 0), cB + kstep, voffB); PG8_STAGE(PG8_SA(1, 0), cA + kstep, voffA); PG8_STAGE(PG8_SB(1, 1), cB + hstep + kstep, voffB);
        PG8_WAIT_V(6); PG8_BAR;
    }
    for (;;) {
        const bool has_next = S.next(ui + 1, nxt);
        const char* nA = has_next ? (const char*)g.A + (size_t)nxt.pm * tstep : cA; const char* nB = has_next ? (const char*)g.Bt + (size_t)nxt.pn * tstep : cB;
        for (int t = 0; t < nt; t += 2) {
            const bool last = (t == nt - 2);
            const char* a1 = cA + (size_t)(t + 1) * kstep;
            const char* a2 = last ? nA : cA + (size_t)(t + 2) * kstep; const char* b2 = last ? nB : cB + (size_t)(t + 2) * kstep;
            const char* a3 = a2 + kstep; const char* b3 = b2 + kstep;
            if (last && has_next) S.a_ready(nxt);
            if constexpr (SP2) {
            PG8_LDB(B0, 0, 0); PG8_LDB(B1, 0, 1); PG8_SCHED; PG8_LDA(At, 0, 0); PG8_STAGE(PG8_SA(1, 1), a1 + hstep, voffA);
            PG8_WAIT_V(8); PG8_WAIT_L(0); PG8_BAR; PG8_MMA(0, 0, At, B0); PG8_MMA(0, 1, At, B1); PG8_BAR; PG8_SCHED;
            PG8_LDA(At, 0, 1); PG8_STAGE(PG8_SB(0, 0), b2, voffB); PG8_STAGE(PG8_SB(0, 1), b2 + hstep, voffB); PG8_STAGE(PG8_SA(0, 0), a2, voffA);
            PG8_WAIT_V(8); PG8_WAIT_L(0); PG8_BAR; PG8_MMA(1, 0, At, B0); PG8_MMA(1, 1, At, B1); PG8_BAR; PG8_SCHED;
            PG8_LDB(B0, 1, 0); PG8_LDB(B1, 1, 1); PG8_SCHED; PG8_LDA(At, 1, 0); PG8_STAGE(PG8_SA(0, 1), a2 + hstep, voffA);
            PG8_WAIT_V(8); PG8_WAIT_L(0); PG8_BAR; PG8_MMA(0, 0, At, B0); PG8_MMA(0, 1, At, B1); PG8_BAR; PG8_SCHED;
            PG8_LDA(At, 1, 1); PG8_STAGE(PG8_SB(1, 0), b3, voffB); PG8_STAGE(PG8_SB(1, 1), b3 + hstep, voffB); PG8_STAGE(PG8_SA(1, 0), a3, voffA);
            PG8_WAIT_V(8); PG8_WAIT_L(0); PG8_BAR; PG8_MMA(1, 0, At, B0); PG8_MMA(1, 1, At, B1); PG8_BAR; PG8_SCHED;
            } else {
            PG8_LDB(B0, 0, 0); PG8_SCHED; PG8_LDA(At, 0, 0); PG8_STAGE(PG8_SA(1, 1), a1 + hstep, voffA);
            PG8_WAIT_L(8); PG8_BAR; PG8_WAIT_L(0); PG8_MMA(0, 0, At, B0); PG8_BAR; PG8_SCHED;
            PG8_LDB(B1, 0, 1); PG8_STAGE(PG8_SB(0, 0), b2, voffB);
            PG8_BAR; PG8_WAIT_L(0); PG8_MMA(0, 1, At, B1); PG8_BAR;
            PG8_LDA(At, 0, 1); PG8_STAGE(PG8_SA(0, 0), a2, voffA);
            PG8_BAR; PG8_WAIT_L(0); PG8_MMA(1, 0, At, B0); PG8_BAR; PG8_SCHED;
            PG8_STAGE(PG8_SB(0, 1), b2 + hstep, voffB);
            PG8_WAIT_V(6); PG8_BAR; PG8_MMA(1, 1, At, B1); PG8_BAR;
            PG8_LDB(B0, 1, 0); PG8_SCHED; PG8_LDA(At, 1, 0); PG8_STAGE(PG8_SA(0, 1), a2 + hstep, voffA);
            PG8_WAIT_L(8); PG8_BAR; PG8_WAIT_L(0); PG8_MMA(0, 0, At, B0); PG8_BAR; PG8_SCHED;
            PG8_LDB(B1, 1, 1); PG8_STAGE(PG8_SB(1, 0), b3, voffB);
            PG8_BAR; PG8_WAIT_L(0); PG8_MMA(0, 1, At, B1); PG8_BAR;
            PG8_LDA(At, 1, 1); PG8_STAGE(PG8_SA(1, 0), a3, voffA);
            PG8_BAR; PG8_WAIT_L(0); PG8_MMA(1, 0, At, B0); PG8_BAR; PG8_SCHED;
            PG8_STAGE(PG8_SB(1, 1), b3 + hstep, voffB);
            PG8_WAIT_V(6); PG8_BAR; PG8_MMA(1, 1, At, B1); PG8_BAR;
            }
        }
        if constexpr (ALIGN_EPI) { if (wr == 0) PG8_BAR; }
        if constexpr (!Epi::AFTER_DRAIN) { E(acc, cur, wr, wc, fr, fq); S.done(cur); }
        if (!has_next) break;
#pragma unroll
        for (int a = 0; a < 2; ++a)
#pragma unroll
            for (int b = 0; b < 2; ++b)
#pragma unroll
                for (int m = 0; m < 4; ++m)
#pragma unroll
                    for (int n = 0; n < 2; ++n) acc[a][b][m][n] = (f32x4){0.f, 0.f, 0.f, 0.f};
        cur = nxt; cA = nA; cB = nB; ++ui;
        if constexpr (ALIGN_EPI) { if (wr == 1) PG8_BAR; }
    }
    PG8_WAIT_V(0);
    if constexpr (!ALIGN_EPI) { if (wr == 0) PG8_BAR; }
    PG8_BAR;
    if constexpr (Epi::AFTER_DRAIN) { E.fused(acc, cur, wr, wc, fr, fq, lds, wid, lane); S.done(cur); }
#undef PG8_SA
#undef PG8_SB
#undef PG8_STAGE
#undef PG8_LDA
#undef PG8_LDB
#undef PG8_MMA
#undef PG8_WAIT_V
#undef PG8_WAIT_L
#undef PG8_BAR
#undef PG8_SCHED
}
}
constexpr int NWAVES = 8;
constexpr int D = 1024, NB = 8, T = 2048, NS = 128, TS = 4, FF = 2816, PROJ = 3592, QKV = 1536, NH = 4;
constexpr int MP = NB * T, MS = NS * TS, M = MP + MS, NSEQ = NB + NS;
constexpr int NUP = 2 * FF, NIN = 3584, MODW = 9 * D;
constexpr float ALPHA = 1.189207115002721f, LN_EPS = 1e-5f;
constexpr size_t O_Y = 0, O_SSM_P = (size_t)M * D, O_CQ_P = O_SSM_P + (size_t)NB * NH * 128 * 128, O_CM_P = O_CQ_P + (size_t)NB * 3 * QKV,
                 O_SSM_S = O_CM_P + (size_t)NB * 2 * 512, O_CQ_S = O_SSM_S + (size_t)NS * NH * 128 * 128, O_CM_S = O_CQ_S + (size_t)NS * 3 * QKV,
                 O_END = O_CM_S + (size_t)NS * 2 * 512;
constexpr size_t MiB = 1u << 20, KiB = 1u << 10;
constexpr size_t WS_CTL = 0, CTL_ZERO_BYTES = 128 * KiB;
constexpr size_t WS_MOD = 1 * MiB;
constexpr size_t WS_W1U = 6 * MiB, WS_W1D = 17 * MiB, WS_W2U = 22 * MiB + 512 * KiB, WS_W2D = 33 * MiB + 512 * KiB, WS_WIN = 39 * MiB, WS_WOUT = 46 * MiB + 512 * KiB;
constexpr size_t WS_GB = 128 * KiB, WS_GL = 704 * KiB;
constexpr int NING = 3840;
constexpr size_t WS_XM = 49 * MiB, WS_Y = 82 * MiB, WS_HP = 115 * MiB, WS_END = 256 * MiB;
static_assert(WS_MOD + (size_t)NSEQ * MODW * 4 <= WS_W1U && WS_W1U + (size_t)NUP * D * 2 <= WS_W1D && WS_W1D + (size_t)D * FF * 2 <= WS_W2U && WS_W2U + (size_t)NUP * D * 2 <= WS_W2D &&
              WS_W2D + (size_t)D * FF * 2 <= WS_WIN && WS_WIN + (size_t)NING * D * 2 <= WS_WOUT && WS_WOUT + (size_t)D * D * 2 <= WS_XM && WS_GB + (size_t)M * 8 * 4 <= WS_GL && WS_GL + 4096 <= WS_MOD &&
              WS_XM + (size_t)M * D * 2 <= WS_Y && WS_Y + (size_t)M * D * 2 <= WS_HP && WS_HP + (size_t)M * NIN * 2 <= WS_END, "d_ws map");
constexpr size_t WS_X2B = WS_HP + 100 * MiB;
static_assert(WS_X2B >= WS_HP + (size_t)M * FF * 2 && WS_X2B + (size_t)M * D * 2 <= WS_END - 2 * MiB, "x2 above H");
constexpr int CW_TMO = 0, CW_CODE = 1, CW_BAR = 4096, CW_SEAM = 8192, SEAM_BANK = 64 * 64;
static_assert((CW_SEAM + 3 * SEAM_BANK) * 4 <= (int)CTL_ZERO_BYTES && CW_BAR + 3456 <= CW_SEAM, "control words");
constexpr size_t WS_XCH = 254 * MiB + 512 * KiB;
constexpr int RING_OFF = 0, RING_BYTES = 131072, LDSCTL_OFF = RING_BYTES, MISC_OFF = LDSCTL_OFF + 320, LDS_BYTES = 147456;

#define GAS __attribute__((address_space(1)))
#define LAS __attribute__((address_space(3)))
typedef unsigned short bf16;
typedef unsigned v4u __attribute__((ext_vector_type(4)));
typedef unsigned v2u __attribute__((ext_vector_type(2)));
typedef float f32x4 __attribute__((ext_vector_type(4)));
typedef short bf16x8 __attribute__((ext_vector_type(8)));
typedef GAS unsigned gu32;
#define RLX_AGENT __ATOMIC_RELAXED, __HIP_MEMORY_SCOPE_AGENT
#define LDS_WAIT() asm volatile("s_waitcnt lgkmcnt(0)" ::: "memory")
#define VM_WAIT() asm volatile("s_waitcnt vmcnt(0)" ::: "memory")
__device__ __forceinline__ unsigned f2bf(float f) { unsigned u = __builtin_bit_cast(unsigned, f); return (u + 0x7fffu + ((u >> 16) & 1u)) >> 16; }
typedef float f32x2_t __attribute__((ext_vector_type(2))); typedef __bf16 bf16x2_t __attribute__((ext_vector_type(2)));
__device__ __forceinline__ unsigned pk2(float lo, float hi) { const f32x2_t v = {lo, hi}; const bf16x2_t b = __builtin_convertvector(v, bf16x2_t); return __builtin_bit_cast(unsigned, b); }
__device__ __forceinline__ float bf_lo(unsigned w) { return __builtin_bit_cast(float, w << 16); }
__device__ __forceinline__ float bf_hi(unsigned w) { return __builtin_bit_cast(float, w & 0xffff0000u); }
__device__ __forceinline__ float silu_f(float x) { return x * __builtin_amdgcn_rcpf(1.0f + __builtin_amdgcn_exp2f(-1.4426950408889634f * x)); }

#define XB_TMO      128
#define XB_XCNT(j)  (256  + 64 * (j))
#define XB_XSUB(j)  (1280 + 64 * (j))
#define XB_XGEN(j)  (2304 + 64 * (j))
#define XB_TOP      3328
#define XB_TOPGEN   3392
#define XCD_BAR_WORDS 3456
#define XB_SPIN_CAP (1u << 18)
__device__ __forceinline__ unsigned xb_ld(unsigned* p)              { return __hip_atomic_load(p, __ATOMIC_RELAXED, __HIP_MEMORY_SCOPE_AGENT); }
__device__ __forceinline__ unsigned xb_add(unsigned* p, unsigned v) { return __hip_atomic_fetch_add(p, v, __ATOMIC_RELAXED, __HIP_MEMORY_SCOPE_AGENT); }
__device__ __forceinline__ unsigned xb_xcc_id() { return (unsigned)__builtin_amdgcn_s_getreg((3 << 11) | 20) & 0xFu; }
#define XB_SPIN(cond, bar) do { unsigned _sp = 0; while (cond) { __builtin_amdgcn_s_sleep(1); \
    if ((++_sp & 255u) == 0u) { if (xb_ld(&(bar)[XB_TMO])) break; if (_sp > XB_SPIN_CAP) { atomicAdd(&(bar)[XB_TMO], 1u); break; } } } } while (0)
struct XcdBarrier { unsigned* bar; unsigned x; volatile LAS unsigned* st; };
__device__ __forceinline__ XcdBarrier xcd_barrier_post(unsigned* bar, volatile LAS unsigned* st) {
    XcdBarrier b; b.bar = bar; b.x = xb_xcc_id(); b.st = st;
    if (threadIdx.x == 0) (void)xb_add(&bar[XB_XCNT(b.x)], 1u);
    return b;
}
__device__ __forceinline__ void xcd_barrier_complete(unsigned* bar, unsigned x, unsigned& nloc, unsigned& nx) {
    const unsigned G = gridDim.x * gridDim.y * gridDim.z;
    unsigned sum, cnt, mine, sp = 0u;
    for (;;) {
        sum = 0u; cnt = 0u; mine = 0u;
#pragma unroll
        for (unsigned j = 0; j < 16; ++j) { const unsigned c = xb_ld(&bar[XB_XCNT(j)]); sum += c; cnt += (c > 0u) ? 1u : 0u; mine = (j == x) ? c : mine; }
        if (sum == G) break;
        __builtin_amdgcn_s_sleep(1);
        if ((++sp & 255u) == 0u) { if (xb_ld(&bar[XB_TMO])) break; if (sp > XB_SPIN_CAP) { atomicAdd(&bar[XB_TMO], 1u); break; } }
    }
    nloc = mine > 0u ? mine : 1u; nx = cnt > 0u ? cnt : 1u;
}
__device__ __forceinline__ void xcd_barrier_census(const XcdBarrier& b) {
    if (threadIdx.x == 0) { unsigned nloc, nx; xcd_barrier_complete(b.bar, b.x, nloc, nx); b.st[0] = nloc; b.st[1] = nx; }
    __syncthreads();
}
__device__ __forceinline__ void xcd_barrier(const XcdBarrier& b) {
    asm volatile("s_waitcnt vmcnt(0)" ::: "memory");
    __syncthreads();
    if (threadIdx.x == 0) {
        unsigned* bar = b.bar;
        __builtin_amdgcn_s_waitcnt(0);
        unsigned nloc = b.st[0], nx = b.st[1];
        const unsigned old = xb_add(&bar[XB_XSUB(b.x)], 1u);
        const unsigned gen = old / nloc;
        if (old + 1u == (gen + 1u) * nloc) {
            __builtin_amdgcn_fence(__ATOMIC_RELEASE, "agent");
            asm volatile("s_waitcnt vmcnt(0)" ::: "memory");
            const unsigned og = xb_add(&bar[XB_TOP], 1u);
            const unsigned tg = og / nx;
            if (og + 1u == (tg + 1u) * nx) xb_add(&bar[XB_TOPGEN], 1u);
            else XB_SPIN(xb_ld(&bar[XB_TOPGEN]) == tg, bar);
            __builtin_amdgcn_fence(__ATOMIC_ACQUIRE, "agent");
            xb_add(&bar[XB_XGEN(b.x)], 1u);
            asm volatile("s_waitcnt vmcnt(0)" ::: "memory");
        } else {
            XB_SPIN(xb_ld(&bar[XB_XGEN(b.x)]) == gen, bar);
            __builtin_amdgcn_fence(__ATOMIC_ACQUIRE, "agent");
            asm volatile("s_waitcnt vmcnt(0)" ::: "memory");
        }
    }
    __syncthreads();
}

struct Args { const float* in[24]; float* out; unsigned char* ws; int ph_lo, ph_hi; };
struct Frame {
    LAS unsigned char* lds;
    volatile LAS unsigned* MISC;
    gu32* ctl;
    int tid, lane, wave, vcu, G;
    const struct Args* a; float* out; unsigned char* ws;
};
__device__ __forceinline__ float wave_sum(float v) {
#define WS_DPP(ctrl_, rm_) __builtin_bit_cast(float, __builtin_amdgcn_update_dpp(0, __builtin_bit_cast(int, v), ctrl_, rm_, 0xF, false))
    v += WS_DPP(0xB1, 0xF); v += WS_DPP(0x4E, 0xF); v += WS_DPP(0x141, 0xF); v += WS_DPP(0x140, 0xF);
    v += WS_DPP(0x142, 0xA); v += WS_DPP(0x143, 0xC);
#undef WS_DPP
    return __builtin_bit_cast(float, __builtin_amdgcn_readlane(__builtin_bit_cast(int, v), 63));
}
__device__ __forceinline__ int seq_of(int m) { return m < MP ? (m >> 11) : NB + ((m - MP) >> 2); }

__device__ __forceinline__ void p0_ada(Frame& F) {
    constexpr int RS = 528;
    const int unit = F.wave * F.G + (int)blockIdx.x;
    const bool has = unit < 576;
    const int n0 = unit * 16, m = F.lane & 15, g = F.lane >> 4;
    const float* wada = F.a->in[7];
    f32x4 acc[9];
#pragma unroll
    for (int i = 0; i < 9; ++i) acc[i] = (f32x4){0.f, 0.f, 0.f, 0.f};
    float afn[8][8];
#define ADA_LOAD(kc_) do { if (has) { _Pragma("unroll") for (int ks = 0; ks < 8; ++ks) _Pragma("unroll") for (int j = 0; j < 8; ++j) \
        afn[ks][j] = wada[(size_t)((kc_) * 256 + ks * 32 + 8 * g + j) * MODW + n0 + m]; } } while (0)
    ADA_LOAD(0);
#pragma unroll 1
    for (int kc = 0; kc < 4; ++kc) {
#pragma unroll
        for (int i = 0; i < 9; ++i) {
            const int gi = F.tid + 512 * i, row = gi >> 5, kg = gi & 31;
            v4u o = (v4u){0u, 0u, 0u, 0u};
            if (row < NSEQ) {
                const float* c = (row < NB ? F.a->in[5] + (size_t)row * D : F.a->in[6] + (size_t)(row - NB) * D) + kc * 256 + kg * 8;
                const f32x4 a = *(const f32x4*)c, b = *(const f32x4*)(c + 4);
                o.x = pk2(silu_f(a.x), silu_f(a.y)); o.y = pk2(silu_f(a.z), silu_f(a.w)); o.z = pk2(silu_f(b.x), silu_f(b.y)); o.w = pk2(silu_f(b.z), silu_f(b.w));
            }
            *(LAS v4u*)(F.lds + row * RS + kg * 16) = o;
        }
        v4u aw[8];
#pragma unroll
        for (int ks = 0; ks < 8; ++ks) { aw[ks].x = pk2(afn[ks][0], afn[ks][1]); aw[ks].y = pk2(afn[ks][2], afn[ks][3]); aw[ks].z = pk2(afn[ks][4], afn[ks][5]); aw[ks].w = pk2(afn[ks][6], afn[ks][7]); }
        if (kc + 1 < 4) ADA_LOAD(kc + 1);
        LDS_WAIT(); __syncthreads();
        if (has) {
#pragma unroll
            for (int ks = 0; ks < 8; ++ks) {
                const bf16x8 A = __builtin_bit_cast(bf16x8, aw[ks]);
#pragma unroll
                for (int nt = 0; nt < 9; ++nt) {
                    const bf16x8 B = *(const LAS bf16x8*)(F.lds + (16 * nt + m) * RS + (ks * 32 + 8 * g) * 2);
                    acc[nt] = __builtin_amdgcn_mfma_f32_16x16x32_bf16(A, B, acc[nt], 0, 0, 0);
                }
            }
        }
        LDS_WAIT(); __syncthreads();
    }
#undef ADA_LOAD
    if (has) {
        const f32x4 bv = *(const f32x4*)(F.a->in[8] + n0 + 4 * g);
        float* mod = (float*)(F.ws + WS_MOD);
#pragma unroll
        for (int nt = 0; nt < 9; ++nt) { const int s = 16 * nt + m; if (s < NSEQ) *(f32x4*)(mod + (size_t)s * MODW + n0 + 4 * g) = acc[nt] + bv; }
    }
}
__device__ __forceinline__ void transpose_item(const float* W, int ldw, int src_col0, bf16* WT, int K, int dst_row0, int kb, LAS float* scr, int lane) {
    const int k0 = 64 * kb;
    f32x4 tv[8];
#pragma unroll
    for (int i = 0; i < 8; ++i) tv[i] = *(const f32x4*)(W + (size_t)(k0 + 8 * i + (lane >> 3)) * ldw + src_col0 + 4 * (lane & 7));
#pragma unroll
    for (int i = 0; i < 8; ++i) { LAS float* d = scr + (8 * i + (lane >> 3)) * 33 + 4 * (lane & 7); d[0] = tv[i].x; d[1] = tv[i].y; d[2] = tv[i].z; d[3] = tv[i].w; }
    LDS_WAIT(); asm volatile("" ::: "memory");
    const int c = lane & 7;
#pragma unroll
    for (int j = 0; j < 4; ++j) { const int n = (lane >> 3) + 8 * j; const LAS float* s = scr + (8 * c) * 33 + n;
        v4u o; o.x = pk2(s[0 * 33], s[1 * 33]); o.y = pk2(s[2 * 33], s[3 * 33]); o.z = pk2(s[4 * 33], s[5 * 33]); o.w = pk2(s[6 * 33], s[7 * 33]);
        *(GAS v4u*)(WT + (size_t)(dst_row0 + n) * K + k0 + 8 * c) = o; }
    LDS_WAIT(); asm volatile("" ::: "memory");
}
constexpr int CV_W1U = 0, CV_W1D = 2816, CV_WIN = 4224, CV_WOUT = 6032, CV_W2U = 6544, CV_W2D = 9360, CV_END = 10768;
__device__ __forceinline__ void convert_items(Frame& F, int it0, int it1, int gw, int ngw) {
    LAS float* scr = (LAS float*)(F.lds + RING_OFF + F.wave * 16384);
    for (int it = it0 + gw; it < it1; it += ngw) {
        if (it < CV_W1D || (it >= CV_W2U && it < CV_W2D)) { const bool second = it >= CV_W2U; int r = it - (second ? CV_W2U : CV_W1U); const int w = r / 1408; r -= w * 1408; const int kb = r / 88, nb = r % 88;
            transpose_item(second ? (w == 0 ? F.a->in[14] : F.a->in[15]) : (w == 0 ? F.a->in[11] : F.a->in[12]), FF, 32 * nb, (bf16*)(F.ws + (second ? WS_W2U : WS_W1U)), D, 256 * (nb >> 2) + 32 * (nb & 3) + 128 * w, kb, scr, F.lane); }
        else if (it < CV_WIN || it >= CV_W2D) { const bool second = it >= CV_W2D; const int r = it - (second ? CV_W2D : CV_W1D), kb = r / 32, nb = r % 32;
            transpose_item(second ? F.a->in[16] : F.a->in[13], D, 32 * nb, (bf16*)(F.ws + (second ? WS_W2D : WS_W1D)), FF, 32 * nb, kb, scr, F.lane); }
        else if (it < CV_WOUT) { const int r = it - CV_WIN, kb = r / 113, nb = r % 113;
            transpose_item(F.a->in[17], PROJ, nb < 48 ? 32 * nb : nb < 112 ? 1544 + 32 * (nb - 48) : 1536, (bf16*)(F.ws + WS_WIN), D, nb < 48 ? 32 * nb : nb < 112 ? 1536 + 32 * (nb - 48) : 3584, kb, scr, F.lane); }
        else { const int r = it - CV_WOUT, kb = r / 32, nb = r % 32; transpose_item(F.a->in[23], D, 32 * nb, (bf16*)(F.ws + WS_WOUT), D, 32 * nb, kb, scr, F.lane); }
    }
}
template <int K>
__device__ __forceinline__ void sample_gemm(Frame& F, const bf16* A, const bf16* Bt, bf16* C) {
    static_assert(K % 256 == 0, "K split over 8 waves in 32-deep steps");
    int tid_l = F.tid; asm volatile("" : "+v"(tid_l));
    const int tid = tid_l, lane = tid & 63, wave = F.wave, m = lane & 15, g = lane >> 4;
    for (int tile = (int)blockIdx.x; tile < 256; tile += F.G) {
        const int rm = tile >> 4, cn = tile & 15;
        const bf16* a0 = A + (size_t)(32 * rm + m) * K + wave * (K / 8) + 8 * g;
        const bf16* b0 = Bt + (size_t)(64 * cn + m) * K + wave * (K / 8) + 8 * g;
        f32x4 acc[2][4];
#pragma unroll
        for (int i = 0; i < 2; ++i)
#pragma unroll
            for (int j = 0; j < 4; ++j) acc[i][j] = (f32x4){0.f, 0.f, 0.f, 0.f};
#pragma unroll 4
        for (int ks = 0; ks < K / 256; ++ks) {
            bf16x8 a[2], b[4];
#pragma unroll
            for (int i = 0; i < 2; ++i) a[i] = *(const GAS bf16x8*)(a0 + (size_t)(16 * i) * K + 32 * ks);
#pragma unroll
            for (int j = 0; j < 4; ++j) b[j] = *(const GAS bf16x8*)(b0 + (size_t)(16 * j) * K + 32 * ks);
#pragma unroll
            for (int i = 0; i < 2; ++i)
#pragma unroll
                for (int j = 0; j < 4; ++j) acc[i][j] = __builtin_amdgcn_mfma_f32_16x16x32_bf16(a[i], b[j], acc[i][j], 0, 0, 0);
        }
        LAS float* red = (LAS float*)(F.lds + RING_OFF);
#pragma unroll
        for (int i = 0; i < 2; ++i)
#pragma unroll
            for (int j = 0; j < 4; ++j)
#pragma unroll
                for (int r = 0; r < 4; ++r) red[(wave * 32 + 16 * i + 4 * g + r) * 64 + 16 * j + m] = acc[i][j][r];
        LDS_WAIT(); __syncthreads();
        const int row = tid >> 4, c4 = (tid & 15) * 4;
        f32x4 s = (f32x4){0.f, 0.f, 0.f, 0.f};
#pragma unroll
        for (int w = 0; w < 8; ++w) s = s + *(const LAS f32x4*)(red + (w * 32 + row) * 64 + c4);
        v2u o; o.x = pk2(s.x, s.y); o.y = pk2(s.z, s.w);
        *(GAS v2u*)(C + (size_t)(32 * rm + row) * D + 64 * cn + c4) = o;
        LDS_WAIT(); __syncthreads();
    }
}
__device__ __forceinline__ void p1_mod(Frame& F) {
    const int gw = F.vcu * NWAVES + F.wave, NGW = F.G * NWAVES;
    const float* mod = (const float*)(F.ws + WS_MOD); bf16* XM = (bf16*)(F.ws + WS_XM);
    for (int m = gw; m < M; m += NGW) {
        const float* xr = m < MP ? F.a->in[0] + (size_t)m * D : F.a->in[1] + (size_t)(m - MP) * D;
        const float* ms = mod + (size_t)seq_of(m) * MODW;
#pragma unroll
        for (int j = 0; j < 4; ++j) { const int d = 4 * F.lane + 256 * j;
            const f32x4 v = *(const f32x4*)(xr + d), sh = *(const f32x4*)(ms + d), sc = *(const f32x4*)(ms + D + d);
            const f32x4 o = v * (sc + 1.0f) + sh; v2u w; w.x = pk2(o.x, o.y); w.y = pk2(o.z, o.w);
            *(GAS v2u*)(XM + (size_t)m * D + d) = w; }
    }
}
template <int I, bool AB, int NR>
__device__ __forceinline__ void ln_rows(Frame& F, int m0, float yscale, LAS float* W8, const bf16* Y, bf16* XM) {
    const float* mod = (const float*)(F.ws + WS_MOD);
    const float* ms = mod + (size_t)seq_of(m0) * MODW + I * 3 * D;
    const int lane = F.lane;
    f32x4 gt[4], lg[4], lb[4], sh[4], sc[4];
#pragma unroll
    for (int j = 0; j < 4; ++j) { const int d = 4 * lane + 256 * j;
        gt[j] = *(const f32x4*)(ms + 2 * D + d) * yscale; lg[j] = *(const f32x4*)(F.a->in[9] + I * D + d); lb[j] = *(const f32x4*)(F.a->in[10] + I * D + d);
        if (I < 2) { sh[j] = *(const f32x4*)(ms + 3 * D + d); sc[j] = *(const f32x4*)(ms + 4 * D + d) + 1.0f; } }
    f32x4 xn[4]; v2u yn[4];
#define LN_LOAD(m_) do { \
        if (I == 0) { const float* xr_ = (m_) < MP ? F.a->in[0] + (size_t)(m_) * D : F.a->in[1] + (size_t)((m_) - MP) * D; \
            _Pragma("unroll") for (int j = 0; j < 4; ++j) xn[j] = *(const f32x4*)(xr_ + 4 * lane + 256 * j); } \
        else { const bf16* xb_ = (I == 1 ? (const bf16*)F.out : (const bf16*)(F.ws + WS_X2B)) + (size_t)(m_) * D; \
            _Pragma("unroll") for (int j = 0; j < 4; ++j) { const v2u w_ = *(const GAS v2u*)(xb_ + 4 * lane + 256 * j); xn[j] = (f32x4){bf_lo(w_.x), bf_hi(w_.x), bf_lo(w_.y), bf_hi(w_.y)}; } } \
        _Pragma("unroll") for (int j = 0; j < 4; ++j) yn[j] = *(const GAS v2u*)(Y + (size_t)(m_) * D + 4 * lane + 256 * j); } while (0)
    LN_LOAD(m0);
#pragma unroll 1
    for (int i = 0; i < NR; ++i) {
        const int m = m0 + i;
        f32x4 v[4]; float s = 0.f;
#pragma unroll
        for (int j = 0; j < 4; ++j) { const f32x4 y = (f32x4){bf_lo(yn[j].x), bf_hi(yn[j].x), bf_lo(yn[j].y), bf_hi(yn[j].y)};
            v[j] = xn[j] * ALPHA + gt[j] * y; s += (v[j].x + v[j].y) + (v[j].z + v[j].w); }
        if (i + 1 < NR) LN_LOAD(m + 1);
        const float mean = wave_sum(s) * (1.f / D); float s2 = 0.f;
#pragma unroll
        for (int j = 0; j < 4; ++j) { v[j] = v[j] - mean; s2 += (v[j].x * v[j].x + v[j].y * v[j].y) + (v[j].z * v[j].z + v[j].w * v[j].w); }
        const float rstd = 1.f / sqrtf(wave_sum(s2) * (1.f / D) + LN_EPS);
        f32x4 uu[4];
#pragma unroll
        for (int j = 0; j < 4; ++j) { const int d = 4 * lane + 256 * j;
            const f32x4 o = v[j] * rstd * lg[j] + lb[j];
            if (I == 2) *(f32x4*)(F.out + (size_t)m * D + d) = o;
            else { v2u ow; ow.x = pk2(o.x, o.y); ow.y = pk2(o.z, o.w); *(GAS v2u*)((I == 0 ? (bf16*)F.out : (bf16*)(F.ws + WS_X2B)) + (size_t)m * D + d) = ow; }
            if (I < 2) { const f32x4 u = o * sc[j] + sh[j]; v2u w; w.x = pk2(u.x, u.y); w.y = pk2(u.z, u.w);
                *(GAS v2u*)(XM + (size_t)m * D + d) = w; uu[j] = u; }
        }
        if (AB) {
            float pa[8];
#pragma unroll
            for (int q = 0; q < 8; ++q) { typedef float f32x2s __attribute__((ext_vector_type(2))); f32x2s a2 = {0.f, 0.f};
#pragma unroll
                for (int j = 0; j < 4; ++j) { const f32x4 wv = *(const LAS f32x4*)(W8 + q * D + 4 * lane + 256 * j);
                    a2 = a2 + (f32x2s){uu[j].x, uu[j].y} * (f32x2s){wv.x, wv.y}; a2 = a2 + (f32x2s){uu[j].z, uu[j].w} * (f32x2s){wv.z, wv.w}; }
                float a_ = a2.x + a2.y;
                asm volatile("" : "+v"(a_));
                pa[q] = a_; }
            float p4[4], p2[2];
#pragma unroll
            for (int q = 0; q < 4; ++q) { const float keep = (lane & 1) ? pa[q + 4] : pa[q], give = (lane & 1) ? pa[q] : pa[q + 4]; p4[q] = keep + __shfl_xor(give, 1); }
#pragma unroll
            for (int q = 0; q < 2; ++q) { const float keep = (lane & 2) ? p4[q + 2] : p4[q], give = (lane & 2) ? p4[q] : p4[q + 2]; p2[q] = keep + __shfl_xor(give, 2); }
            float p1; { const float keep = (lane & 4) ? p2[1] : p2[0], give = (lane & 4) ? p2[0] : p2[1]; p1 = keep + __shfl_xor(give, 4); }
            p1 += __shfl_xor(p1, 8); p1 += __shfl_xor(p1, 16); p1 += __shfl_xor(p1, 32);
            if (lane < 8) { const int q = 4 * (lane & 1) + 2 * ((lane >> 1) & 1) + ((lane >> 2) & 1), h = q & 3;
                float* GB = (float*)(F.ws + WS_GB);
                if (q < 4) { const float z = p1 + F.a->in[20][h]; const float sp = z > 20.f ? z : log1pf(__expf(z)); GB[(size_t)m * 4 + h] = -__expf(F.a->in[19][h]) * sp; }
                else GB[(size_t)M * 4 + (size_t)m * 4 + h] = 1.f / (1.f + __expf(-p1)); }
        }
    }
#undef LN_LOAD
}
template <int I, bool AB = (I == 0)>
__device__ __forceinline__ void ln_pass(Frame& F, float yscale) {
    const int gw = F.vcu * NWAVES + F.wave, NGW = F.G * NWAVES;
    LAS float* W8 = (LAS float*)(F.lds + RING_OFF);
    if (AB) {
        for (int e = F.tid; e < 8 * D; e += NWAVES * 64) { const int d = e >> 3, j = e & 7; W8[j * D + d] = F.a->in[17][(size_t)d * PROJ + QKV + j]; }
        LDS_WAIT(); __syncthreads();
    }
    for (int m0 = 8 * gw; m0 < MP; m0 += 8 * NGW) ln_rows<I, AB, 8>(F, m0, yscale, W8, (const bf16*)(F.ws + WS_Y), (bf16*)(F.ws + WS_XM));
    for (int m = MP + gw; m < M; m += NGW) ln_rows<I, AB, 1>(F, m, yscale, W8, (const bf16*)(F.ws + WS_Y), (bf16*)(F.ws + WS_XM));
    if (AB) { LDS_WAIT(); __syncthreads(); }
}

constexpr size_t WS_YS = WS_HP + (size_t)M * NIN * 2;
template <int I>
__device__ __forceinline__ void ln_sample(Frame& F, float yscale, bf16* XMbase) {
    const int gw = F.vcu * NWAVES + F.wave, NGW = F.G * NWAVES;
    for (int m = MP + gw; m < M; m += NGW) ln_rows<I, false, 1>(F, m, yscale, nullptr, (const bf16*)(F.ws + WS_YS) - (size_t)MP * D, XMbase);
}

__device__ __forceinline__ void ab_rows(Frame& F, int first_wg) {
    LAS float* W8 = (LAS float*)(F.lds + RING_OFF);
    for (int e = F.tid; e < 8 * D; e += NWAVES * 64) { const int d = e >> 3, j = e & 7; W8[j * D + d] = F.a->in[17][(size_t)d * PROJ + QKV + j]; }
    LDS_WAIT(); __syncthreads();
    const int gw = ((int)blockIdx.x - first_wg) * NWAVES + F.wave, ngw = (F.G - first_wg) * NWAVES, lane = F.lane;
    const bf16* XM = (const bf16*)(F.ws + WS_XM); float* GB = (float*)(F.ws + WS_GB);
    for (int m = gw; m < M; m += ngw) {
        const v4u x0 = *(const GAS v4u*)(XM + (size_t)m * D + 8 * lane), x1 = *(const GAS v4u*)(XM + (size_t)m * D + 512 + 8 * lane);
        float u[16];
        u[0] = bf_lo(x0.x); u[1] = bf_hi(x0.x); u[2] = bf_lo(x0.y); u[3] = bf_hi(x0.y); u[4] = bf_lo(x0.z); u[5] = bf_hi(x0.z); u[6] = bf_lo(x0.w); u[7] = bf_hi(x0.w);
        u[8] = bf_lo(x1.x); u[9] = bf_hi(x1.x); u[10] = bf_lo(x1.y); u[11] = bf_hi(x1.y); u[12] = bf_lo(x1.z); u[13] = bf_hi(x1.z); u[14] = bf_lo(x1.w); u[15] = bf_hi(x1.w);
        float pa[8];
#pragma unroll
        for (int q = 0; q < 8; ++q) { const LAS float* w = W8 + q * D + 8 * lane;
            const f32x4 w0 = *(const LAS f32x4*)w, w1 = *(const LAS f32x4*)(w + 4), w2 = *(const LAS f32x4*)(w + 512), w3 = *(const LAS f32x4*)(w + 516);
            float a_ = (u[0] * w0.x + u[1] * w0.y) + (u[2] * w0.z + u[3] * w0.w) + (u[4] * w1.x + u[5] * w1.y) + (u[6] * w1.z + u[7] * w1.w)
                     + (u[8] * w2.x + u[9] * w2.y) + (u[10] * w2.z + u[11] * w2.w) + (u[12] * w3.x + u[13] * w3.y) + (u[14] * w3.z + u[15] * w3.w);
            asm volatile("" : "+v"(a_));
            pa[q] = a_; }
        float p4[4], p2[2];
#pragma unroll
        for (int q = 0; q < 4; ++q) { const float keep = (lane & 1) ? pa[q + 4] : pa[q], give = (lane & 1) ? pa[q] : pa[q + 4]; p4[q] = keep + __shfl_xor(give, 1); }
#pragma unroll
        for (int q = 0; q < 2; ++q) { const float keep = (lane & 2) ? p4[q + 2] : p4[q], give = (lane & 2) ? p4[q] : p4[q + 2]; p2[q] = keep + __shfl_xor(give, 2); }
        float p1; { const float keep = (lane & 4) ? p2[1] : p2[0], give = (lane & 4) ? p2[0] : p2[1]; p1 = keep + __shfl_xor(give, 4); }
        p1 += __shfl_xor(p1, 8); p1 += __shfl_xor(p1, 16); p1 += __shfl_xor(p1, 32);
        if (lane < 8) { const int q = 4 * (lane & 1) + 2 * ((lane >> 1) & 1) + ((lane >> 2) & 1), h = q & 3;
            if (q < 4) { const float z = p1 + F.a->in[20][h]; const float sp = z > 20.f ? z : log1pf(__expf(z)); GB[(size_t)m * 4 + h] = -__expf(F.a->in[19][h]) * sp; }
            else GB[(size_t)M * 4 + (size_t)m * 4 + h] = 1.f / (1.f + __expf(-p1)); }
    }
    LDS_WAIT(); __syncthreads();
}
constexpr int PQ_LD = 1536, PR_LD = 2048, PR_OG = 0, PR_SB = 512, PR_SC = 1024, PR_SH = 1536;
constexpr size_t WS_PQ = WS_HP, WS_PR = WS_HP + (size_t)M * PQ_LD * 2, WS_TAIL = WS_HP + (size_t)M * NIN * 2;
constexpr size_t FRB_AW = WS_Y, FRB_AQD = WS_Y + 16 * MiB;
constexpr size_t FRB_AQK = WS_TAIL, FRB_U = WS_TAIL + 8 * MiB, FRB_GL = WS_GL;
constexpr size_t FRB_SH = WS_PQ;
static_assert(FRB_AQD + 16 * MiB <= WS_HP && FRB_U + 16 * MiB <= WS_XCH && WS_XCH + 3 * 512 * KiB <= WS_END && (size_t)32 * MiB <= (size_t)MP * PQ_LD * 2, "fragment map");
constexpr size_t FRB_AKD = WS_W2U;
static_assert(FRB_AKD + 16 * MiB <= WS_WIN, "AKD inside the FFN2 weight region");
__device__ __forceinline__ unsigned char* fr_akd(const Frame& F) { return F.ws + FRB_AKD; }

__device__ __forceinline__ void unpack8(const v4u w, float (&f)[8]) {
    f[0] = bf_lo(w.x); f[1] = bf_hi(w.x); f[2] = bf_lo(w.y); f[3] = bf_hi(w.y); f[4] = bf_lo(w.z); f[5] = bf_hi(w.z); f[6] = bf_lo(w.w); f[7] = bf_hi(w.w);
}
__device__ __forceinline__ void d1_unit(Frame& F, int ci) {
    constexpr int RAW = 0, RAWS = 768, KBI = 0, KHI = 17408, QHI = 34816, IMS = 272, VB = 52224, KG = 84992, SC = 117760, CW = 118784;
    constexpr int LM = 0, QKI = 17408, QKS = 136, WIM = 34816;
    const int bh = ci >> 5, n = ci & 31, b = bh >> 2, h = bh & 3, row0 = b * T + 64 * n;
    int tid_l = F.tid; asm volatile("" : "+v"(tid_l));
    const int tid = tid_l, lane = tid & 63, wave = F.wave;
    LAS unsigned char* L = F.lds;
    LAS float* SCf = (LAS float*)(L + SC);
    LAS float* CWf = (LAS float*)(L + CW);
    const bf16* P = (const bf16*)(F.ws + WS_PQ);
    const float* GB = (const float*)(F.ws + WS_GB);
    {
        v4u rv[7]; float cwv[3];
#pragma unroll
        for (int it = 0; it < 7; ++it) { const int p = tid + 512 * it, r = p / 48, q = p % 48, part = q >> 4, c8 = q & 15, tok = r - 3;
            rv[it] = (v4u){0u, 0u, 0u, 0u};
            if (p < 67 * 48 && (n > 0 || tok >= 0)) rv[it] = *(const GAS v4u*)(P + (size_t)(row0 + tok) * PQ_LD + part * 512 + h * 128 + c8 * 8); }
#pragma unroll
        for (int it = 0; it < 3; ++it) { const int e = tid + 512 * it, i = e / 384, q = e % 384; cwv[it] = F.a->in[18][i * QKV + (q >> 7) * 512 + h * 128 + (q & 127)]; }
#pragma unroll
        for (int it = 0; it < 7; ++it) { const int p = tid + 512 * it, r = p / 48, q = p % 48; if (p < 67 * 48) *(LAS v4u*)(L + RAW + r * RAWS + q * 16) = rv[it]; }
        if (n == 31) {
#pragma unroll
            for (int it = 6; it < 7; ++it) { const int p = tid + 512 * it, r = p / 48, q = p % 48, part = q >> 4, c8 = q & 15;
                if (p < 67 * 48 && r >= 64) { float x[8]; unpack8(rv[it], x); float* cq = F.out + O_CQ_P + ((size_t)b * 3 + (r - 64)) * QKV + part * 512 + h * 128 + c8 * 8;
                    *(f32x4*)cq = (f32x4){x[0], x[1], x[2], x[3]}; *(f32x4*)(cq + 4) = (f32x4){x[4], x[5], x[6], x[7]}; } }
        }
#pragma unroll
        for (int it = 0; it < 3; ++it) CWf[tid + 512 * it] = cwv[it];
    }
    if (wave == 0) {
        const float gv = GB[(size_t)(row0 + lane) * 4 + h], bt = GB[(size_t)M * 4 + (size_t)(row0 + lane) * 4 + h];
        float gc = gv;
#pragma unroll
        for (int o = 1; o < 64; o <<= 1) { const float t = __shfl_up(gc, o); if (lane >= o) gc += t; }
        const float glast = __shfl(gc, 63);
        SCf[lane] = gc; SCf[64 + lane] = bt; SCf[128 + lane] = __expf(gc); SCf[192 + lane] = __expf(glast - gc);
        if (lane == 0) ((float*)(F.ws + FRB_GL))[ci] = __expf(glast);
    }
    LDS_WAIT(); __syncthreads();
    const int tok = tid >> 3, sub = tid & 7;
    float val[6][8];
#pragma unroll
    for (int i = 0; i < 6; ++i) { const int cg = (i >> 1) * 16 + (i & 1) * 8 + sub;
        float a[8];
#pragma unroll
        for (int e = 0; e < 8; ++e) a[e] = 0.f;
#pragma unroll
        for (int tap = 0; tap < 4; ++tap) { float x[8]; unpack8(*(const LAS v4u*)(L + RAW + (tok + tap) * RAWS + cg * 16), x);
            const f32x4 w0 = *(const LAS f32x4*)(CWf + tap * 384 + cg * 8), w1 = *(const LAS f32x4*)(CWf + tap * 384 + cg * 8 + 4);
            a[0] += x[0] * w0.x; a[1] += x[1] * w0.y; a[2] += x[2] * w0.z; a[3] += x[3] * w0.w; a[4] += x[4] * w1.x; a[5] += x[5] * w1.y; a[6] += x[6] * w1.z; a[7] += x[7] * w1.w; }
#pragma unroll
        for (int e = 0; e < 8; ++e) val[i][e] = silu_f(a[e]); }
    float sq = 0.f, sk = 0.f;
#pragma unroll
    for (int e = 0; e < 8; ++e) { sq += val[0][e] * val[0][e] + val[1][e] * val[1][e]; sk += val[2][e] * val[2][e] + val[3][e] * val[3][e]; }
#define D1_DPP(v_, ctrl_) __builtin_bit_cast(float, __builtin_amdgcn_update_dpp(0, __builtin_bit_cast(int, v_), ctrl_, 0xF, 0xF, false))
    sq += D1_DPP(sq, 0xB1); sk += D1_DPP(sk, 0xB1); sq += D1_DPP(sq, 0x4E); sk += D1_DPP(sk, 0x4E); sq += D1_DPP(sq, 0x141); sk += D1_DPP(sk, 0x141);
#undef D1_DPP
    const float rq = rsqrtf(sq + 1e-6f) * 0.08838834764831845f, rk = rsqrtf(sk + 1e-6f);
    const float bt = SCf[64 + tok], egt = SCf[128 + tok];
    LDS_WAIT(); __syncthreads();
    unsigned char* AQD = F.ws + FRB_AQD + (size_t)ci * 16384;
#pragma unroll
    for (int i = 0; i < 2; ++i) { const int dk0 = (i * 8 + sub) * 8;
        float q[8];
#pragma unroll
        for (int e = 0; e < 8; ++e) q[e] = val[i][e] * rq;
        v4u w; w.x = pk2(q[0], q[1]); w.y = pk2(q[2], q[3]); w.z = pk2(q[4], q[5]); w.w = pk2(q[6], q[7]);
        *(LAS v4u*)(L + QHI + tok * IMS + dk0 * 2) = w;
        const int s = dk0 >> 5, jh = (dk0 >> 4) & 1, g2 = (dk0 >> 3) & 1, mt = tok >> 4, m = tok & 15;
#pragma unroll
        for (int half = 0; half < 2; ++half) { const int g = 2 * g2 + half;
            v2u o; o.x = pk2(q[4 * half] * egt, q[4 * half + 1] * egt); o.y = pk2(q[4 * half + 2] * egt, q[4 * half + 3] * egt);
            *(GAS v2u*)(AQD + ((size_t)((mt * 4 + s) * 64 + m + 16 * g) * 8 + 4 * jh) * 2) = o; } }
#pragma unroll
    for (int i = 0; i < 2; ++i) { const int dk0 = (i * 8 + sub) * 8;
        float k[8];
#pragma unroll
        for (int e = 0; e < 8; ++e) k[e] = val[2 + i][e] * rk;
        v4u w; w.x = pk2(k[0], k[1]); w.y = pk2(k[2], k[3]); w.z = pk2(k[4], k[5]); w.w = pk2(k[6], k[7]);
        *(LAS v4u*)(L + KHI + tok * IMS + dk0 * 2) = w;
        v4u wb; wb.x = pk2(k[0] * bt, k[1] * bt); wb.y = pk2(k[2] * bt, k[3] * bt); wb.z = pk2(k[4] * bt, k[5] * bt); wb.w = pk2(k[6] * bt, k[7] * bt);
        *(LAS v4u*)(L + KBI + tok * IMS + dk0 * 2) = wb;
        const float f = bt * egt;
        *(LAS f32x4*)(L + KG + tok * 512 + dk0 * 4) = (f32x4){k[0] * f, k[1] * f, k[2] * f, k[3] * f};
        *(LAS f32x4*)(L + KG + tok * 512 + dk0 * 4 + 16) = (f32x4){k[4] * f, k[5] * f, k[6] * f, k[7] * f}; }
#pragma unroll
    for (int i = 0; i < 2; ++i) { const int dv0 = (i * 8 + sub) * 8;
        *(LAS f32x4*)(L + VB + tok * 512 + dv0 * 4) = (f32x4){val[4 + i][0] * bt, val[4 + i][1] * bt, val[4 + i][2] * bt, val[4 + i][3] * bt};
        *(LAS f32x4*)(L + VB + tok * 512 + dv0 * 4 + 16) = (f32x4){val[4 + i][4] * bt, val[4 + i][5] * bt, val[4 + i][6] * bt, val[4 + i][7] * bt}; }
    LDS_WAIT(); __syncthreads();
    const int kind = wave >> 2, ti = wave & 3, m16 = lane & 15, g4 = lane >> 4;
    f32x4 acc[4];
#pragma unroll
    for (int tj = 0; tj < 4; ++tj) acc[tj] = (f32x4){0.f, 0.f, 0.f, 0.f};
#pragma unroll
    for (int s = 0; s < 4; ++s) {
        const bf16x8 A = *(const LAS bf16x8*)(L + (kind == 0 ? KBI : QHI) + (16 * ti + m16) * IMS + (32 * s + 8 * g4) * 2);
#pragma unroll
        for (int tj = 0; tj < 4; ++tj) if (tj <= ti) {
            const bf16x8 B = *(const LAS bf16x8*)(L + KHI + (16 * tj + m16) * IMS + (32 * s + 8 * g4) * 2);
            acc[tj] = __builtin_amdgcn_mfma_f32_16x16x32_bf16(A, B, acc[tj], 0, 0, 0); }
    }
    {
        unsigned char* AKD = fr_akd(F) + (size_t)ci * 16384;
#pragma unroll
        for (int rep = 0; rep < 2; ++rep) { const int lf = tid + 512 * rep, frag = lf >> 6, ln = lf & 63, Tt = frag >> 1, s2 = frag & 1, m = ln & 15, g = ln >> 4;
            float kd[8];
#pragma unroll
            for (int j = 0; j < 8; ++j) { const int tk = 32 * s2 + 16 * (j >> 2) + 4 * g + (j & 3);
                const unsigned short hv = *(const LAS unsigned short*)(L + KHI + tk * IMS + (16 * Tt + m) * 2);
                kd[j] = __builtin_bit_cast(float, (unsigned)hv << 16) * SCf[192 + tk]; }
            v4u o; o.x = pk2(kd[0], kd[1]); o.y = pk2(kd[2], kd[3]); o.z = pk2(kd[4], kd[5]); o.w = pk2(kd[6], kd[7]);
            *(GAS v4u*)(AKD + (size_t)lf * 16) = o; }
    }
    LDS_WAIT(); __syncthreads();
#pragma unroll
    for (int tj = 0; tj < 4; ++tj)
#pragma unroll
        for (int r = 0; r < 4; ++r) { const int i = 16 * ti + 4 * g4 + r, j = 16 * tj + m16;
            const float dec = (tj <= ti && i >= j) ? __expf(SCf[i] - SCf[j]) : 0.f;
            const float v = (tj <= ti) ? acc[tj][r] * dec : 0.f;
            if (kind == 0) { if (tj <= ti) *(LAS float*)(L + LM + ((i >> 2) * 64 + j) * 16 + (i & 3) * 4) = (i > j) ? v : 0.f; }
            else *(LAS unsigned short*)(L + QKI + i * QKS + j * 2) = (unsigned short)f2bf(v); }
    LDS_WAIT(); __syncthreads();
    if (wave < 4) {
        const int c = tid;
        const LAS unsigned char* rhsp = L + (c < 128 ? VB : KG) + (c & 127) * 4;
        typedef float f32x2s __attribute__((ext_vector_type(2)));
        float x[64];
#pragma unroll
        for (int blk = 0; blk < 16; ++blk) { const int i0 = 4 * blk;
            f32x2s sa, sb;
            sa.x = *(const LAS float*)(rhsp + (i0 + 0) * 512); sa.y = *(const LAS float*)(rhsp + (i0 + 1) * 512);
            sb.x = *(const LAS float*)(rhsp + (i0 + 2) * 512); sb.y = *(const LAS float*)(rhsp + (i0 + 3) * 512);
            f32x2s ta = {0.f, 0.f}, tb = {0.f, 0.f};
#pragma unroll
            for (int jb = 0; jb < i0; jb += 16) {
                f32x4 l[16];
#pragma unroll
                for (int q = 0; q < 16; ++q) if (jb + q < i0) l[q] = *(const LAS f32x4*)(L + LM + (blk * 64 + jb + q) * 16);
                __builtin_amdgcn_sched_barrier(0);
#pragma unroll
                for (int q = 0; q < 16; q += 2) if (jb + q < i0) {
                    sa = sa - (f32x2s){l[q].x, l[q].y} * x[jb + q]; sb = sb - (f32x2s){l[q].z, l[q].w} * x[jb + q];
                    ta = ta - (f32x2s){l[q + 1].x, l[q + 1].y} * x[jb + q + 1]; tb = tb - (f32x2s){l[q + 1].z, l[q + 1].w} * x[jb + q + 1]; }
            }
            sa = sa + ta; sb = sb + tb;
            const f32x4 d0 = *(const LAS f32x4*)(L + LM + (blk * 64 + i0) * 16), d1 = *(const LAS f32x4*)(L + LM + (blk * 64 + i0 + 1) * 16), d2 = *(const LAS f32x4*)(L + LM + (blk * 64 + i0 + 2) * 16);
            x[i0] = sa.x;
            x[i0 + 1] = sa.y - d0.y * x[i0];
            sb = sb - (f32x2s){d0.z, d0.w} * x[i0];
            sb = sb - (f32x2s){d1.z, d1.w} * x[i0 + 1];
            x[i0 + 2] = sb.x;
            x[i0 + 3] = sb.y - d2.w * x[i0 + 2];
        }
        if (c < 128) {
            unsigned char* U = F.ws + FRB_U + (size_t)ci * 16384 + (size_t)(c >> 4) * 2048;
#pragma unroll
            for (int mt = 0; mt < 4; ++mt)
#pragma unroll
                for (int g = 0; g < 4; ++g) { const int t0 = 16 * mt + 4 * g; v2u o; o.x = pk2(x[t0], x[t0 + 1]); o.y = pk2(x[t0 + 2], x[t0 + 3]);
                    *(GAS v2u*)(U + (size_t)(mt * 64 + (c & 15) + 16 * g) * 8) = o; }
        } else {
            const int dk = c - 128;
#pragma unroll
            for (int i = 0; i < 64; ++i) *(LAS unsigned short*)(L + WIM + i * IMS + dk * 2) = (unsigned short)f2bf(x[i]);
        }
    } else {
        unsigned char* AQK = F.ws + FRB_AQK + (size_t)ci * 8192;
#pragma unroll
        for (int rep = 0; rep < 2; ++rep) { const int lf = (tid - 256) + 256 * rep, frag = lf >> 6, ln = lf & 63, mt = frag >> 1, s2 = frag & 1, m = ln & 15, g = ln >> 4;
            const v2u a = *(const LAS v2u*)(L + QKI + (16 * mt + m) * QKS + (32 * s2 + 4 * g) * 2);
            const v2u bq = *(const LAS v2u*)(L + QKI + (16 * mt + m) * QKS + (32 * s2 + 16 + 4 * g) * 2);
            *(GAS v4u*)(AQK + (size_t)lf * 16) = (v4u){a.x, a.y, bq.x, bq.y}; }
    }
    LDS_WAIT(); __syncthreads();
    {
        unsigned char* AW = F.ws + FRB_AW + (size_t)ci * 16384;
#pragma unroll
        for (int rep = 0; rep < 2; ++rep) { const int lf = tid + 512 * rep, frag = lf >> 6, ln = lf & 63, mt = frag >> 2, s = frag & 3, m = ln & 15, g = ln >> 4;
            const v2u a = *(const LAS v2u*)(L + WIM + (16 * mt + m) * IMS + (32 * s + 4 * g) * 2);
            const v2u bq = *(const LAS v2u*)(L + WIM + (16 * mt + m) * IMS + (32 * s + 16 + 4 * g) * 2);
            *(GAS v4u*)(AW + (size_t)lf * 16) = (v4u){a.x, a.y, bq.x, bq.y}; }
    }
    LDS_WAIT(); __syncthreads();
}
template <int ABL = 0>
__device__ __forceinline__ void scan_phase(Frame& F) {
    if ((int)blockIdx.x >= 64) return;
    constexpr int BUFB = 40960;
    const int unit = (int)blockIdx.x, bh = unit & 31, half = unit >> 5, lane = F.lane, wave = F.wave;
    LAS unsigned char* L = F.lds;
    if (wave >= 4) {
        __builtin_amdgcn_s_setprio(3);
        const int lw = wave - 4;
        const unsigned char* src[10];
#pragma unroll
        for (int i = 0; i < 10; ++i) { const int p = 10 * lw + i;
            src[i] = (p < 16 ? F.ws + FRB_AW + (size_t)p * 1024 : p < 32 ? fr_akd(F) + (size_t)(p - 16) * 1024 : F.ws + FRB_U + (size_t)half * 8192 + (size_t)(p - 32) * 1024) + (size_t)bh * 32 * 16384 + lane * 16; }
#define SCAN_ISSUE(c_, buf_) do { _Pragma("unroll") for (int i_ = 0; i_ < 10; ++i_) \
            __builtin_amdgcn_global_load_lds((const unsigned*)(src[i_] + (size_t)(c_) * 16384), (LAS unsigned*)(L + (buf_) * BUFB + (10 * lw + i_) * 1024), 16, 0, 0); } while (0)
        if (!(ABL & 8)) { SCAN_ISSUE(0, 0); SCAN_ISSUE(1, 1); }
        int nb = 2;
        for (int n = 0; n < 32; ++n) {
            if (!(ABL & 8)) asm volatile("s_waitcnt vmcnt(10)" ::: "memory");
            __builtin_amdgcn_s_barrier();
            asm volatile("" ::: "memory");
            const int c = n + 2 < 32 ? n + 2 : 31;
            if (!(ABL & 8)) SCAN_ISSUE(c, nb); nb = nb == 2 ? 0 : nb + 1;
        }
        asm volatile("s_waitcnt vmcnt(0)" ::: "memory");
#undef SCAN_ISSUE
    } else {
        const int dvl = lane & 15, g = lane >> 4, sl = 4 * half + wave;
        const float* GL = (const float*)(F.ws + FRB_GL) + bh * 32;
        unsigned char* SH = F.ws + FRB_SH + ((size_t)bh * 32 * 8 + sl) * 4096 + lane * 16;
        f32x4 St[8];
#pragma unroll
        for (int t = 0; t < 8; ++t) St[t] = (f32x4){0.f, 0.f, 0.f, 0.f};
        const float glv = __hip_atomic_load(GL + (lane & 31), __ATOMIC_RELAXED, __HIP_MEMORY_SCOPE_AGENT);
        int cb = 0;
        for (int n = 0; n < 32; ++n) {
            const float gl = __builtin_bit_cast(float, __builtin_amdgcn_readlane(__builtin_bit_cast(int, glv), n));
            v4u Bw[4];
#pragma unroll
            for (int s = 0; s < 4; ++s) { Bw[s].x = pk2(St[2 * s][0], St[2 * s][1]); Bw[s].y = pk2(St[2 * s][2], St[2 * s][3]); Bw[s].z = pk2(St[2 * s + 1][0], St[2 * s + 1][1]); Bw[s].w = pk2(St[2 * s + 1][2], St[2 * s + 1][3]);
                if (ABL & 1) asm volatile("" :: "v"(Bw[s])); else *(GAS v4u*)(SH + (size_t)n * 32768 + s * 1024) = Bw[s]; }
            __builtin_amdgcn_s_barrier();
            asm volatile("" ::: "memory");
            const LAS unsigned char* B = L + cb * BUFB + lane * 16;
            f32x4 accA[4];
#pragma unroll
            for (int mt = 0; mt < 4; ++mt) accA[mt] = (f32x4){0.f, 0.f, 0.f, 0.f};
#pragma unroll
            for (int s = 0; s < 4; ++s)
#pragma unroll
                for (int mt = 0; mt < 4; ++mt) accA[mt] = __builtin_amdgcn_mfma_f32_16x16x32_bf16(*(const LAS bf16x8*)(B + (mt * 4 + s) * 1024), __builtin_bit_cast(bf16x8, Bw[s]), accA[mt], 0, 0, 0);
            f32x4 vn[4];
#pragma unroll
            for (int mt = 0; mt < 4; ++mt) { const v2u uw = *(const LAS v2u*)(L + cb * BUFB + 32768 + wave * 2048 + (mt * 64 + lane) * 8);
                vn[mt] = (f32x4){bf_lo(uw.x), bf_hi(uw.x), bf_lo(uw.y), bf_hi(uw.y)} - accA[mt]; }
            bf16x8 Bv[2];
#pragma unroll
            for (int s2 = 0; s2 < 2; ++s2) { v4u w; w.x = pk2(vn[2 * s2][0], vn[2 * s2][1]); w.y = pk2(vn[2 * s2][2], vn[2 * s2][3]); w.z = pk2(vn[2 * s2 + 1][0], vn[2 * s2 + 1][1]); w.w = pk2(vn[2 * s2 + 1][2], vn[2 * s2 + 1][3]);
                Bv[s2] = __builtin_bit_cast(bf16x8, w); }
#pragma unroll
            for (int t = 0; t < 8; ++t) St[t] = St[t] * gl;
#pragma unroll
            for (int s2 = 0; s2 < 2; ++s2)
#pragma unroll
                for (int t = 0; t < 8; ++t) St[t] = __builtin_amdgcn_mfma_f32_16x16x32_bf16(*(const LAS bf16x8*)(B + 16384 + (t * 2 + s2) * 1024), Bv[s2], St[t], 0, 0, 0);
            cb = cb == 2 ? 0 : cb + 1;
        }
        float* So = F.out + O_SSM_P + (size_t)bh * 128 * 128;
#pragma unroll
        for (int t = 0; t < 8; ++t)
#pragma unroll
            for (int r = 0; r < 4; ++r) So[(size_t)(16 * t + 4 * g + r) * 128 + 16 * sl + dvl] = St[t][r];
    }
}
__device__ __forceinline__ float dpp_add(float v, const int ctrl_sel) {
    const int iv = __builtin_bit_cast(int, v); int o;
    if (ctrl_sel == 0) o = __builtin_amdgcn_update_dpp(0, iv, 0xB1, 0xF, 0xF, true);
    else if (ctrl_sel == 1) o = __builtin_amdgcn_update_dpp(0, iv, 0x4E, 0xF, 0xF, true);
    else if (ctrl_sel == 2) o = __builtin_amdgcn_update_dpp(0, iv, 0x141, 0xF, 0xF, true);
    else o = __builtin_amdgcn_update_dpp(0, iv, 0x140, 0xF, 0xF, true);
    return v + __builtin_bit_cast(float, o);
}
__device__ __forceinline__ f32x4 row16_sum4(f32x4 v) {
#pragma unroll
    for (int st = 0; st < 4; ++st) { v.x = dpp_add(v.x, st); v.y = dpp_add(v.y, st); v.z = dpp_add(v.z, st); v.w = dpp_add(v.w, st); }
    return v;
}
template <int ABL = 0>
__device__ __forceinline__ void d3_phase(Frame& F) {
    constexpr int BUFB = 57344, RED = 114688;
    int tid_l = F.tid; asm volatile("" : "+v"(tid_l));
    const int lane = tid_l & 63, wave = F.wave, dvl = lane & 15, g = lane >> 4;
    LAS unsigned char* L = F.lds;
    LAS float* red = (LAS float*)(L + RED);
    bf16* MIX = (bf16*)(F.ws + WS_XM); const bf16* PR = (const bf16*)(F.ws + WS_PR);
    const float gdn = F.a->in[21][16 * wave + dvl];
    const int nk = (1024 - (int)blockIdx.x + F.G - 1) / F.G;
#define D3_ISSUE(ci_, buf_) do { _Pragma("unroll") for (int i_ = 0; i_ < 7; ++i_) { const int p_ = 7 * wave + i_; \
            const unsigned char* s_ = (p_ < 16 ? F.ws + FRB_AW + (size_t)(ci_) * 16384 + (size_t)p_ * 1024 : p_ < 32 ? F.ws + FRB_AQD + (size_t)(ci_) * 16384 + (size_t)(p_ - 16) * 1024 : \
                                       p_ < 40 ? F.ws + FRB_AQK + (size_t)(ci_) * 8192 + (size_t)(p_ - 32) * 1024 : F.ws + FRB_U + (size_t)(ci_) * 16384 + (size_t)(p_ - 40) * 1024) + lane * 16; \
            __builtin_amdgcn_global_load_lds((const unsigned*)s_, (LAS unsigned*)(L + (buf_) * BUFB + p_ * 1024), 16, 0, 0); } } while (0)
#define D3_LOADS(ci_, dst_) do { const unsigned char* sh_ = F.ws + FRB_SH + ((size_t)(ci_) * 8 + wave) * 4096 + lane * 16; \
            _Pragma("unroll") for (int s_ = 0; s_ < 4; ++s_) dst_[s_] = *(const GAS v4u*)(sh_ + s_ * 1024); } while (0)
#define D3_OG(ci_) do { const int bh_ = (ci_) >> 5, n_ = (ci_) & 31, r0_ = (bh_ >> 2) * T + 64 * n_, h_ = bh_ & 3; \
            _Pragma("unroll") for (int mt_ = 0; mt_ < 4; ++mt_) _Pragma("unroll") for (int r_ = 0; r_ < 4; ++r_) ogn[mt_][r_] = PR[(size_t)(r0_ + 16 * mt_ + 4 * g + r_) * PR_LD + PR_OG + h_ * 128 + 16 * wave + dvl]; } while (0)
    v4u Bn[4]; unsigned short ogn[4][4];
    if (nk > 0) { if (!(ABL & 8)) D3_ISSUE((int)blockIdx.x, 0); D3_LOADS((int)blockIdx.x, Bn); D3_OG((int)blockIdx.x); }
    for (int k = 0; k < nk; ++k) {
        const int ci = (int)blockIdx.x + k * F.G, bh = ci >> 5, n = ci & 31, b = bh >> 2, h = bh & 3, row0 = b * T + 64 * n;
        asm volatile("s_waitcnt vmcnt(0)" ::: "memory");
        __builtin_amdgcn_s_barrier();
        asm volatile("" ::: "memory");
        v4u Bw[4];
#pragma unroll
        for (int s = 0; s < 4; ++s) Bw[s] = Bn[s];
        if (k + 1 < nk) { if (!(ABL & 8)) D3_ISSUE(ci + F.G, (k + 1) & 1); if (!(ABL & 16)) D3_LOADS(ci + F.G, Bn); }
        unsigned short ogv[4][4];
#pragma unroll
        for (int mt = 0; mt < 4; ++mt)
#pragma unroll
            for (int r = 0; r < 4; ++r) ogv[mt][r] = ogn[mt][r];
        if (k + 1 < nk) D3_OG(ci + F.G);
        const LAS unsigned char* B = L + (k & 1) * BUFB + lane * 16;
        f32x4 accA[4], accO[4];
#pragma unroll
        for (int mt = 0; mt < 4; ++mt) { accA[mt] = (f32x4){0.f, 0.f, 0.f, 0.f}; accO[mt] = (f32x4){0.f, 0.f, 0.f, 0.f};
#pragma unroll
            for (int s = 0; s < 4; ++s) { accA[mt] = __builtin_amdgcn_mfma_f32_16x16x32_bf16(*(const LAS bf16x8*)(B + (mt * 4 + s) * 1024), __builtin_bit_cast(bf16x8, Bw[s]), accA[mt], 0, 0, 0);
                accO[mt] = __builtin_amdgcn_mfma_f32_16x16x32_bf16(*(const LAS bf16x8*)(B + 16384 + (mt * 4 + s) * 1024), __builtin_bit_cast(bf16x8, Bw[s]), accO[mt], 0, 0, 0); } }
        f32x4 vn[4];
#pragma unroll
        for (int mt = 0; mt < 4; ++mt) { const v2u uw = *(const LAS v2u*)(L + (k & 1) * BUFB + 40960 + wave * 2048 + (mt * 64 + lane) * 8);
            vn[mt] = (f32x4){bf_lo(uw.x), bf_hi(uw.x), bf_lo(uw.y), bf_hi(uw.y)} - accA[mt]; }
        bf16x8 Bv[2];
#pragma unroll
        for (int s2 = 0; s2 < 2; ++s2) { v4u w; w.x = pk2(vn[2 * s2][0], vn[2 * s2][1]); w.y = pk2(vn[2 * s2][2], vn[2 * s2][3]); w.z = pk2(vn[2 * s2 + 1][0], vn[2 * s2 + 1][1]); w.w = pk2(vn[2 * s2 + 1][2], vn[2 * s2 + 1][3]);
            Bv[s2] = __builtin_bit_cast(bf16x8, w); }
#pragma unroll
        for (int mt = 0; mt < 4; ++mt)
#pragma unroll
            for (int s2 = 0; s2 < 2; ++s2) accO[mt] = __builtin_amdgcn_mfma_f32_16x16x32_bf16(*(const LAS bf16x8*)(B + 32768 + (mt * 2 + s2) * 1024), Bv[s2], accO[mt], 0, 0, 0);
#pragma unroll
        for (int mt = 0; mt < 4; ++mt) { f32x4 ss = accO[mt] * accO[mt];
            ss = row16_sum4(ss);
            if (dvl == 0) *(LAS f32x4*)(red + wave * 64 + 16 * mt + 4 * g) = ss; }
        asm volatile("s_waitcnt lgkmcnt(0)" ::: "memory"); __builtin_amdgcn_s_barrier(); asm volatile("" ::: "memory");
        f32x4 tot[4];
#pragma unroll
        for (int mt = 0; mt < 4; ++mt) { f32x4 pr[8];
#pragma unroll
            for (int w = 0; w < 8; ++w) pr[w] = *(const LAS f32x4*)(red + w * 64 + 16 * mt + 4 * g);
            tot[mt] = ((pr[0] + pr[1]) + (pr[2] + pr[3])) + ((pr[4] + pr[5]) + (pr[6] + pr[7])); }
#pragma unroll
        for (int mt = 0; mt < 4; ++mt)
#pragma unroll
            for (int r = 0; r < 4; ++r) { const int tk = 16 * mt + 4 * g + r;
                const float rn = rsqrtf(tot[mt][r] * (1.f / 128.f) + 1e-6f);
                const float ogf = __builtin_bit_cast(float, (unsigned)ogv[mt][r] << 16);
                const unsigned ov = pk2(accO[mt][r] * rn * gdn * silu_f(ogf), 0.f) & 0xffffu;
                if (ABL & 1) asm volatile("" :: "v"(ov)); else MIX[(size_t)(row0 + tk) * D + h * 128 + 16 * wave + dvl] = (bf16)ov; }
    }
    asm volatile("s_waitcnt vmcnt(0) lgkmcnt(0)" ::: "memory"); __builtin_amdgcn_s_barrier();
#undef D3_ISSUE
#undef D3_LOADS
#undef D3_OG
}
__device__ __forceinline__ void sc_rows(Frame& F, int first_wg) {
    const int gw = ((int)blockIdx.x - first_wg) * NWAVES + F.wave, NGW = (F.G - first_wg) * NWAVES, lane = F.lane;
    if (gw < 0) return;
    bf16* MIX = (bf16*)(F.ws + WS_XM); const bf16* PR = (const bf16*)(F.ws + WS_PR);
    f32x4 w0[3], w1[3];
#pragma unroll
    for (int i = 0; i < 3; ++i) { w0[i] = *(const f32x4*)(F.a->in[22] + i * 512 + lane * 8); w1[i] = *(const f32x4*)(F.a->in[22] + i * 512 + lane * 8 + 4); }
    for (int m = gw; m < M; m += NGW) {
        const bool prm = m < MP; const int t = prm ? (m & (T - 1)) : ((m - MP) & 3), sq = prm ? (m >> 11) : ((m - MP) >> 2);
        v4u cw[3], hw[3]; f32x4 sa[2], sbq[2];
#pragma unroll
        for (int i = 0; i < 3; ++i) { const int tt = t - 2 + i; cw[i] = (v4u){0u, 0u, 0u, 0u}; hw[i] = cw[i];
            if (tt >= 0) { cw[i] = *(const GAS v4u*)(PR + (size_t)(m - 2 + i) * PR_LD + PR_SC + lane * 8); hw[i] = *(const GAS v4u*)(PR + (size_t)(m - 2 + i) * PR_LD + PR_SH + lane * 8); } }
        const v4u sbw = *(const GAS v4u*)(PR + (size_t)m * PR_LD + PR_SB + lane * 8);
        if (!prm && t < 2) {
#pragma unroll
            for (int i = 0; i < 2; ++i) { sa[i] = (f32x4){0.f, 0.f, 0.f, 0.f}; sbq[i] = sa[i];
                if (t - 2 + i < 0) { const float* sb = F.a->in[4] + ((size_t)sq * 2 + (t + i)) * 512 + lane * 8; sa[i] = *(const f32x4*)sb; sbq[i] = *(const f32x4*)(sb + 4); } } }
        float zc[8], z2[8];
#pragma unroll
        for (int e = 0; e < 8; ++e) zc[e] = 0.f;
#pragma unroll
        for (int i = 0; i < 3; ++i) { const int tt = t - 2 + i; float z[8];
            if (tt >= 0) { float c[8], hh[8]; unpack8(cw[i], c); unpack8(hw[i], hh);
#pragma unroll
                for (int e = 0; e < 8; ++e) z[e] = c[e] * hh[e]; }
            else if (!prm && i < 2) { z[0] = sa[i].x; z[1] = sa[i].y; z[2] = sa[i].z; z[3] = sa[i].w; z[4] = sbq[i].x; z[5] = sbq[i].y; z[6] = sbq[i].z; z[7] = sbq[i].w; }
            else {
#pragma unroll
                for (int e = 0; e < 8; ++e) z[e] = 0.f; }
            zc[0] += z[0] * w0[i].x; zc[1] += z[1] * w0[i].y; zc[2] += z[2] * w0[i].z; zc[3] += z[3] * w0[i].w; zc[4] += z[4] * w1[i].x; zc[5] += z[5] * w1[i].y; zc[6] += z[6] * w1[i].z; zc[7] += z[7] * w1[i].w;
            if (i == 2) {
#pragma unroll
                for (int e = 0; e < 8; ++e) z2[e] = z[e]; }
        }
        float sb[8]; unpack8(sbw, sb);
        *(GAS v4u*)(MIX + (size_t)m * D + 512 + lane * 8) = (v4u){pk2(sb[0] * zc[0], sb[1] * zc[1]), pk2(sb[2] * zc[2], sb[3] * zc[3]), pk2(sb[4] * zc[4], sb[5] * zc[5]), pk2(sb[6] * zc[6], sb[7] * zc[7])};
        const int Tg = prm ? T : TS;
        if (t >= Tg - 2) { float* cm = F.out + (prm ? O_CM_P : O_CM_S) + ((size_t)sq * 2 + (t - (Tg - 2))) * 512 + lane * 8;
            *(f32x4*)cm = (f32x4){z2[0], z2[1], z2[2], z2[3]}; *(f32x4*)(cm + 4) = (f32x4){z2[4], z2[5], z2[6], z2[7]}; }
    }
}
__device__ __forceinline__ void p8_sample_unit(Frame& F, int unit) {
    int tid_l = F.tid; asm volatile("" : "+v"(tid_l));
    const int sq = unit >> 2, h = unit & 3, tid = tid_l, lane = tid & 63, wave = F.wave;
    LAS float* Lf = (LAS float*)F.lds;
    LAS float* QKV_ = Lf;
    LAS float* RED = Lf + 1536;
    LAS float* SCAL = Lf + 2048;
    LAS float* OB = Lf + 2080;
    const bf16* P = (const bf16*)(F.ws + WS_PQ); const bf16* PR = (const bf16*)(F.ws + WS_PR); const float* GB = (const float*)(F.ws + WS_GB);
    const int m0 = MP + 4 * sq;
    const int kq = tid >> 7, dv = tid & 127;
    float S[32];
    const float* S0 = F.a->in[2] + ((size_t)(sq * 4 + h) * 128 + 32 * kq) * 128 + dv;
#pragma unroll
    for (int i = 0; i < 32; ++i) S[i] = S0[(size_t)i * 128];
    float decv[4], btv[4];
#pragma unroll
    for (int t = 0; t < 4; ++t) { decv[t] = GB[(size_t)(m0 + t) * 4 + h]; btv[t] = GB[(size_t)M * 4 + (size_t)(m0 + t) * 4 + h]; }
    if (tid < 384) { const int part = tid >> 7, ch = tid & 127, c = part * 512 + h * 128 + ch;
        float xp[7];
#pragma unroll
        for (int i = 0; i < 3; ++i) xp[i] = F.a->in[3][((size_t)sq * 3 + i) * QKV + c];
#pragma unroll
        for (int t = 0; t < 4; ++t) xp[3 + t] = __builtin_bit_cast(float, (unsigned)P[(size_t)(m0 + t) * PQ_LD + c] << 16);
#pragma unroll
        for (int t = 1; t < 4; ++t) F.out[O_CQ_S + ((size_t)sq * 3 + (t - 1)) * QKV + c] = xp[3 + t];
        const float w0 = F.a->in[18][c], w1 = F.a->in[18][QKV + c], w2 = F.a->in[18][2 * QKV + c], w3 = F.a->in[18][3 * QKV + c];
#pragma unroll
        for (int t = 0; t < 4; ++t) QKV_[(part * 4 + t) * 128 + ch] = silu_f(xp[t] * w0 + xp[t + 1] * w1 + xp[t + 2] * w2 + xp[t + 3] * w3); }
    LDS_WAIT(); __syncthreads();
    {
        const int part = wave >> 2, t = wave & 3; const float a = QKV_[(part * 4 + t) * 128 + lane], bq = QKV_[(part * 4 + t) * 128 + 64 + lane];
        const float ss = wave_sum(a * a + bq * bq); const float rn = rsqrtf(ss + 1e-6f) * (part == 0 ? 0.08838834764831845f : 1.0f);
        QKV_[(part * 4 + t) * 128 + lane] = a * rn; QKV_[(part * 4 + t) * 128 + 64 + lane] = bq * rn; }
    LDS_WAIT(); __syncthreads();
#pragma unroll
    for (int t = 0; t < 4; ++t) {
        const float dec = __expf(decv[t]), bt = btv[t];
        const LAS float* qv = QKV_ + (0 * 4 + t) * 128 + 32 * kq; const LAS float* kv = QKV_ + (1 * 4 + t) * 128 + 32 * kq;
        float ks = 0.f;
#pragma unroll
        for (int i = 0; i < 32; ++i) { S[i] *= dec; ks += kv[i] * S[i]; }
        RED[kq * 128 + dv] = ks;
        LDS_WAIT(); __syncthreads();
        const float kS = (RED[dv] + RED[128 + dv]) + (RED[256 + dv] + RED[384 + dv]);
        const float vn = bt * (QKV_[(2 * 4 + t) * 128 + dv] - kS);
        float o = 0.f;
#pragma unroll
        for (int i = 0; i < 32; ++i) { S[i] += kv[i] * vn; o += qv[i] * S[i]; }
        LDS_WAIT(); __syncthreads();
        RED[kq * 128 + dv] = o;
        LDS_WAIT(); __syncthreads();
        if (kq == 0) OB[t * 128 + dv] = (RED[dv] + RED[128 + dv]) + (RED[256 + dv] + RED[384 + dv]);
        LDS_WAIT(); __syncthreads();
    }
    float* So = F.out + O_SSM_S + ((size_t)(sq * 4 + h) * 128 + 32 * kq) * 128 + dv;
#pragma unroll
    for (int i = 0; i < 32; ++i) So[(size_t)i * 128] = S[i];
    if (wave < 4) { const int t = wave; const float a = OB[t * 128 + lane], bq = OB[t * 128 + 64 + lane];
        const float rn = rsqrtf(wave_sum(a * a + bq * bq) * (1.f / 128.f) + 1e-6f);
        bf16* MIX = (bf16*)(F.ws + WS_XM);
        const float og0 = __builtin_bit_cast(float, (unsigned)PR[(size_t)(m0 + t) * PR_LD + PR_OG + h * 128 + lane] << 16), og1 = __builtin_bit_cast(float, (unsigned)PR[(size_t)(m0 + t) * PR_LD + PR_OG + h * 128 + 64 + lane] << 16);
        MIX[(size_t)(m0 + t) * D + h * 128 + lane] = (bf16)f2bf(a * rn * F.a->in[21][lane] * silu_f(og0));
        MIX[(size_t)(m0 + t) * D + h * 128 + 64 + lane] = (bf16)f2bf(bq * rn * F.a->in[21][64 + lane] * silu_f(og1)); }
    LDS_WAIT(); __syncthreads();
}
__device__ __forceinline__ int opaque_i(int v) { asm volatile("" : "+v"(v)); return __builtin_amdgcn_readfirstlane(v); }
constexpr int N_PHASES = 14;
__global__ void __launch_bounds__(NWAVES * 64, 2) mk_fwd(Args args) {
    extern __shared__ __attribute__((aligned(16))) unsigned char lds[];
    Frame F;
    F.lds = (LAS unsigned char*)lds;
    F.MISC = (volatile LAS unsigned*)(F.lds + MISC_OFF);
    F.tid = threadIdx.x; F.lane = F.tid & 63; F.wave = __builtin_amdgcn_readfirstlane(F.tid >> 6);
    F.G = gridDim.x; { const int bx = blockIdx.x; F.vcu = (F.G % 8 == 0) ? (bx % 8) * (F.G / 8) + bx / 8 : bx; }
    F.a = &args;
    F.out = args.out; F.ws = args.ws;
    F.ctl = (gu32*)(F.ws + WS_CTL);
    for (int u = F.tid; u < (LDS_BYTES - LDSCTL_OFF) / 4; u += NWAVES * 64) ((LAS unsigned*)(F.lds + LDSCTL_OFF))[u] = 0u;
    __syncthreads();
    XcdBarrier bar = xcd_barrier_post((unsigned*)(F.ctl + CW_BAR), F.MISC + 8);
    xcd_barrier_census(bar);
    constexpr int lo = 0, hi = N_PHASES;
#ifndef PHASE_MASK
#define PHASE_MASK 0xFFFFF
#endif
#define IN(k) (((PHASE_MASK >> (k)) & 1) && lo <= (k) && (k) < hi)
#ifndef REP_MASK
#define REP_MASK 0
#endif
#ifndef GEMM_ALIGN
#define GEMM_ALIGN true
#endif
#ifndef GEMM_SP2
#define GEMM_SP2 true
#endif
#ifndef SCAN_ABL
#define SCAN_ABL 0
#endif
#ifndef D3_ABL
#define D3_ABL 0
#endif
#ifndef REP_SUB
#define REP_SUB 0
#endif
#define FRESH() do { int t_ = threadIdx.x; asm volatile("" : "+v"(t_)); F.tid = t_; F.lane = t_ & 63; } while (0)
#if REP_MASK
#define PHASE_BEGIN(k) _Pragma("unroll 1") for (int rep_ = 0; rep_ < 1 + ((REP_MASK >> (k)) & 1); ++rep_) { if (rep_) xcd_barrier(bar); FRESH();
#else
#define PHASE_BEGIN(k) if (IN(k)) { const int rep_ = 0; (void)rep_; FRESH();
#endif
#define PHASE_END(k) } if (IN(k) && IN((k) + 1)) xcd_barrier(bar);
    bf16* const XM = (bf16*)(F.ws + WS_XM); bf16* const Yb = (bf16*)(F.ws + WS_Y); bf16* const HB = (bf16*)(F.ws + WS_HP);

    PHASE_BEGIN(0) p0_ada(F); convert_items(F, CV_W1U, CV_W1D, F.vcu * NWAVES + F.wave, F.G * NWAVES); PHASE_END(0)
    PHASE_BEGIN(1) p1_mod(F); PHASE_END(1)
    PHASE_BEGIN(2)
        pg8::Gemm g{XM, (const bf16*)(F.ws + WS_W1U), M, NUP, D}; pg8::StaticOrder S; S.init(M, NUP, F.G, (int)blockIdx.x);
        pg8::EpiSwiglu E{HB, FF};
        pg8::gemm_phase<pg8::EpiSwiglu, pg8::StaticOrder, GEMM_ALIGN, GEMM_SP2>(F.lds + RING_OFF, g, S, E);
        { const int nfull = (M / 256) * (NUP / 256) - ((M / 256) * (NUP / 256) / F.G) * F.G;
          if ((int)blockIdx.x >= nfull) { LDS_WAIT(); __syncthreads(); convert_items(F, CV_W1D, CV_W2U, ((int)blockIdx.x - nfull) * NWAVES + F.wave, (F.G - nfull) * NWAVES); } } PHASE_END(2)
    PHASE_BEGIN(3)
        pg8::Gemm g{HB, (const bf16*)(F.ws + WS_W1D), MP, D, FF}; pg8::StaticOrder S; S.init(MP, D, F.G, (int)blockIdx.x);
        pg8::EpiBf16P E{Yb, D, 0, nullptr, 0};
        pg8::gemm_phase<pg8::EpiBf16P, pg8::StaticOrder, true, true>(F.lds + RING_OFF, g, S, E);
        sample_gemm<FF>(F, HB + (size_t)MP * FF, (const bf16*)(F.ws + WS_W1D), Yb + (size_t)MP * D); PHASE_END(3)
    PHASE_BEGIN(4) ln_pass<0>(F, 0.5f); PHASE_END(4)
    PHASE_BEGIN(5)
        pg8::Gemm g{XM, (const bf16*)(F.ws + WS_WIN), M, NIN, D}; pg8::StaticOrder S; S.init(M, NIN, F.G, (int)blockIdx.x);
        pg8::EpiWin E{(bf16*)(F.ws + WS_PQ), (bf16*)(F.ws + WS_PR), (float*)(F.ws + WS_GB), F.a->in[19], F.a->in[20], M};
        pg8::gemm_phase<pg8::EpiWin, pg8::StaticOrder, true, true>(F.lds + RING_OFF, g, S, E); PHASE_END(5)
    PHASE_BEGIN(6) _Pragma("unroll 1") for (int ci = (int)blockIdx.x; ci < 1024; ci += F.G) d1_unit(F, ci); PHASE_END(6)
    PHASE_BEGIN(7) if (!(rep_ && (REP_SUB & 1))) { if (rep_) scan_phase<SCAN_ABL>(F); else scan_phase<0>(F); } if (!(rep_ && (REP_SUB & 2))) { sc_rows(F, 64); for (int u = (int)blockIdx.x - 64; u >= 0 && u < 4 * NS; u += F.G - 64) p8_sample_unit(F, u); } PHASE_END(7)
    PHASE_BEGIN(8) if (!(rep_ && (REP_SUB & 1))) { if (rep_) d3_phase<D3_ABL>(F); else d3_phase<0>(F); } if (!(rep_ && (REP_SUB & 2))) { LDS_WAIT(); __syncthreads(); convert_items(F, CV_W2U, CV_END, F.vcu * NWAVES + F.wave, F.G * NWAVES); } PHASE_END(8)
    PHASE_BEGIN(9)
        pg8::Gemm g{XM, (const bf16*)(F.ws + WS_WOUT), MP, D, D}; pg8::StaticOrder S; S.init(MP, D, F.G, (int)blockIdx.x);
        pg8::EpiBf16P E{Yb, D, 0, nullptr, 0};
        pg8::gemm_phase<pg8::EpiBf16P, pg8::StaticOrder, true, true>(F.lds + RING_OFF, g, S, E);
        sample_gemm<D>(F, XM + (size_t)MP * D, (const bf16*)(F.ws + WS_WOUT), Yb + (size_t)MP * D); PHASE_END(9)
    PHASE_BEGIN(10) ln_pass<1>(F, 1.0f); PHASE_END(10)
    PHASE_BEGIN(11)
        pg8::Gemm g{XM, (const bf16*)(F.ws + WS_W2U), M, NUP, D}; pg8::StaticOrder S; S.init(M, NUP, F.G, (int)blockIdx.x);
        pg8::EpiSwiglu E{HB, FF};
        pg8::gemm_phase<pg8::EpiSwiglu, pg8::StaticOrder, GEMM_ALIGN, GEMM_SP2>(F.lds + RING_OFF, g, S, E); PHASE_END(11)
    PHASE_BEGIN(12)
        pg8::Gemm g{HB, (const bf16*)(F.ws + WS_W2D), MP, D, FF}; pg8::StaticOrder S; S.init(MP, D, F.G, (int)blockIdx.x);
        pg8::EpiBf16P E{Yb, D, 0, nullptr, 0};
        pg8::gemm_phase<pg8::EpiBf16P, pg8::StaticOrder, true, true>(F.lds + RING_OFF, g, S, E);
        sample_gemm<FF>(F, HB + (size_t)MP * FF, (const bf16*)(F.ws + WS_W2D), Yb + (size_t)MP * D); PHASE_END(12)
    PHASE_BEGIN(13) ln_pass<2>(F, 0.5f); PHASE_END(13)
#undef IN
#undef SEAM
}
extern "C" void kernel_launch(void* const* d_in, const int* in_sizes, int n_in, void* d_out, int out_size, void* d_ws, size_t ws_size, hipStream_t stream) {
    static int ok = 0;
    if (ok == 0) {
        int dev = 0, cus = 0;
        if (n_in != 24 || out_size != (int)O_END || ws_size < WS_END || hipGetDevice(&dev) != hipSuccess || hipDeviceGetAttribute(&cus, hipDeviceAttributeMultiprocessorCount, dev) != hipSuccess || cus < 256 ||
            hipFuncSetAttribute((const void*)mk_fwd, hipFuncAttributeMaxDynamicSharedMemorySize, LDS_BYTES) != hipSuccess) {
            fprintf(stderr, "kernel_launch: unexpected problem/device (n_in %d out %d ws %zu cus %d); nothing launched\n", n_in, out_size, ws_size, cus); ok = -1; return; }
        ok = 1;
    }
    if (ok < 0) return;
    (void)hipMemsetAsync((char*)d_ws + WS_CTL, 0, CTL_ZERO_BYTES, stream);
    Args a{};
    for (int i = 0; i < 24; ++i) a.in[i] = (const float*)d_in[i];
    a.out = (float*)d_out; a.ws = (unsigned char*)d_ws; a.ph_lo = 0; a.ph_hi = N_PHASES;
    hipLaunchKernelGGL(mk_fwd, dim3(256), dim3(NWAVES * 64), LDS_BYTES, stream, a);
}
```

```cpp
#include <hip/hip_runtime.h>
#include <cstdio>
#include <cstdint>
namespace pg8 {
#define PG8_LAS __attribute__((address_space(3)))
typedef unsigned short bf16_t;
typedef short bf16x8 __attribute__((ext_vector_type(8)));
typedef float f32x4 __attribute__((ext_vector_type(4)));
typedef unsigned u32x4 __attribute__((ext_vector_type(4)));
constexpr int BM = 256, BK = 64, HALF = 128, HTB = HALF * BK * 2  , STAGE_BYTES = 8 * HTB, NXCD = 8, WGM = 4;

__host__ __device__ __forceinline__ int lds_byte(int r, int c) { const int st = (r >> 4) * 2 + (c >> 5), rr = r & 15, cc = c & 31, ob = rr * 64 + cc * 2; return st * 1024 + (ob ^ (((ob >> 9) & 1) << 5)); }
__host__ __device__ __forceinline__ void stage_rc(int b, int& R, int& C) { const int st = b / 1024, sb = b % 1024, swz = sb ^ (((sb >> 9) & 1) << 5); R = (st >> 1) * 16 + swz / 64; C = (st & 1) * 32 + (swz % 64) / 2; }
__host__ __device__ __forceinline__ int perm32(int rho) { const int n = rho >> 4, i = rho & 15; return 8 * (i >> 2) + 4 * n + (i & 3); }

struct Unit { int pm, pn; };
struct Gemm { const bf16_t* A; const bf16_t* Bt; int M, N, K; };

struct StaticOrder {
    int nM, nN, nwg, G, c;
    __host__ __device__ void init(int M, int N, int G_, int c_) { nM = M / BM; nN = N / BM; nwg = nM * nN; G = G_; c = c_; }
    __host__ __device__ bool next(int i, Unit& u) const {
        const long L = (long)i * G + c; if (L >= nwg) return false;
        int wgid = (int)L; { const int q = nwg / NXCD, r = nwg % NXCD, xcd = wgid % NXCD, off = wgid / NXCD; wgid = (xcd < r ? xcd * (q + 1) : r * (q + 1) + (xcd - r) * q) + off; }
        const int nig = WGM * nN, gid = wgid / nig, fm = gid * WGM, gsz = (nM - fm) < WGM ? (nM - fm) : WGM;
        u.pm = fm + ((wgid % nig) % gsz); u.pn = (wgid % nig) / gsz; return true;
    }
    __device__ __forceinline__ void a_ready(const Unit&) const {}
    __device__ __forceinline__ void done(const Unit&) const {}
};

__device__ __forceinline__ unsigned cvt_pk_bf16(float lo, float hi) { unsigned r; asm volatile("v_cvt_pk_bf16_f32 %0, %1, %2" : "=v"(r) : "v"(lo), "v"(hi)); return r; }
typedef float f32x2 __attribute__((ext_vector_type(2)));
#ifndef EPI_X
#define EPI_X 0
#endif
struct EpiBf16P {
    static constexpr bool PERM = true, AFTER_DRAIN = false;
    bf16_t* O; int ldc; int split_pn; bf16_t* O2; int ldc2;
    __device__ __forceinline__ void operator()(const f32x4 (&acc)[2][2][4][2], const Unit& u, int wr, int wc, int fr, int fq) const {
        const bool second = split_pn > 0 && u.pn >= split_pn;
        bf16_t* const base = second ? O2 : O; const int ld = second ? ldc2 : ldc;
        const int row0 = u.pm * BM + wr * 64 + fr, col0 = (second ? u.pn - split_pn : u.pn) * BM + wc * 32 + 8 * fq;
#pragma unroll
        for (int ai = 0; ai < 2; ++ai)
#pragma unroll
            for (int m = 0; m < 4; ++m) { bf16_t* rowp = base + (size_t)(row0 + ai * HALF + m * 16) * ld + col0;
#pragma unroll
                for (int bj = 0; bj < 2; ++bj) { const f32x4 v0 = acc[ai][bj][m][0], v1 = acc[ai][bj][m][1];
                    u32x4 w; w.x = cvt_pk_bf16(v0[0], v0[1]); w.y = cvt_pk_bf16(v0[2], v0[3]); w.z = cvt_pk_bf16(v1[0], v1[1]); w.w = cvt_pk_bf16(v1[2], v1[3]);
                    *(u32x4*)(rowp + bj * HALF) = w; } }
    }
};
__device__ __forceinline__ float swiglu1(float g, float u) { return g * u * __builtin_amdgcn_rcpf(1.0f + __builtin_amdgcn_exp2f(-1.4426950408889634f * g)); }
struct EpiSwiglu {
    static constexpr bool PERM = true, AFTER_DRAIN = false;
    bf16_t* O; int ldc;
    __device__ __forceinline__ void operator()(const f32x4 (&acc)[2][2][4][2], const Unit& u, int wr, int wc, int fr, int fq) const {
        const int row0 = u.pm * BM + wr * 64 + fr, col0 = u.pn * HALF + wc * 32 + 8 * fq;
#pragma unroll
        for (int ai = 0; ai < 2; ++ai)
#pragma unroll
            for (int m = 0; m < 4; ++m) { bf16_t* rowp = O + (size_t)(row0 + ai * HALF + m * 16) * ldc + col0;
                const f32x4 g0 = acc[ai][0][m][0], g1 = acc[ai][0][m][1], u0 = acc[ai][1][m][0], u1 = acc[ai][1][m][1];
                u32x4 w; w.x = cvt_pk_bf16(swiglu1(g0[0], u0[0]), swiglu1(g0[1], u0[1])); w.y = cvt_pk_bf16(swiglu1(g0[2], u0[2]), swiglu1(g0[3], u0[3]));
                w.z = cvt_pk_bf16(swiglu1(g1[0], u1[0]), swiglu1(g1[1], u1[1])); w.w = cvt_pk_bf16(swiglu1(g1[2], u1[2]), swiglu1(g1[3], u1[3]));
                *(u32x4*)rowp = w; }
    }
};


__device__ __forceinline__ unsigned pk4_fp8(float a, float b, float c, float d) { int r = __builtin_amdgcn_cvt_pk_fp8_f32(a, b, 0, false); r = __builtin_amdgcn_cvt_pk_fp8_f32(c, d, r, true); return (unsigned)r; }
struct EpiSwiglu8 {
    static constexpr bool PERM = true, AFTER_DRAIN = false;
    unsigned char* O; int ldc;
    __device__ __forceinline__ void operator()(const f32x4 (&acc)[2][2][4][2], const Unit& u, int wr, int wc, int fr, int fq) const {
        const int row0 = u.pm * BM + wr * 64 + fr, col0 = u.pn * HALF + wc * 32 + 8 * fq;
#pragma unroll
        for (int ai = 0; ai < 2; ++ai)
#pragma unroll
            for (int m = 0; m < 4; ++m) { unsigned char* rowp = O + (size_t)(row0 + ai * HALF + m * 16) * ldc + col0;
                const f32x4 g0 = acc[ai][0][m][0], g1 = acc[ai][0][m][1], u0 = acc[ai][1][m][0], u1 = acc[ai][1][m][1];
                typedef unsigned u32x2 __attribute__((ext_vector_type(2)));
                u32x2 w; w.x = pk4_fp8(swiglu1(g0[0], u0[0]), swiglu1(g0[1], u0[1]), swiglu1(g0[2], u0[2]), swiglu1(g0[3], u0[3]));
                w.y = pk4_fp8(swiglu1(g1[0], u1[0]), swiglu1(g1[1], u1[1]), swiglu1(g1[2], u1[2]), swiglu1(g1[3], u1[3]));
                *(u32x2*)rowp = w; }
    }
};
struct PanelStats {
    unsigned* xbuf;
    unsigned* cnt;
    unsigned* tmo;
    int ntn; float eps;
    unsigned code;
    __device__ __forceinline__ bool run(const f32x4 (&v)[2][2][4][2], const Unit& u, int wr, int wc, int fr, int fq, PG8_LAS unsigned char* lds, int wid, int lane) const {
        typedef float f32x2v __attribute__((ext_vector_type(2)));
        PG8_LAS f32x2v* P = (PG8_LAS f32x2v*)lds;
        PG8_LAS f32x2v* S = (PG8_LAS f32x2v*)(lds + 8192);
        PG8_LAS unsigned* flag = (PG8_LAS unsigned*)(lds + 8192 + 2048);
#pragma unroll
        for (int ai = 0; ai < 2; ++ai)
#pragma unroll
            for (int m = 0; m < 4; ++m) {
                float s = 0.f;
#pragma unroll
                for (int bj = 0; bj < 2; ++bj)
#pragma unroll
                    for (int n = 0; n < 2; ++n) { const f32x4 x = v[ai][bj][m][n]; s += (x[0] + x[1]) + (x[2] + x[3]); }
                s += __shfl_xor(s, 16); s += __shfl_xor(s, 32);
                const float mw = s * (1.0f / 64.0f); float q = 0.f;
#pragma unroll
                for (int bj = 0; bj < 2; ++bj)
#pragma unroll
                    for (int n = 0; n < 2; ++n) { const f32x4 d = v[ai][bj][m][n] - mw; q += (d[0] * d[0] + d[1] * d[1]) + (d[2] * d[2] + d[3] * d[3]); }
                q += __shfl_xor(q, 16); q += __shfl_xor(q, 32);
                if (fq == 0) P[(ai * HALF + wr * 64 + m * 16 + fr) * 4 + wc] = (f32x2v){mw, q};
            }
        asm volatile("s_waitcnt lgkmcnt(0)" ::: "memory"); __builtin_amdgcn_s_barrier(); asm volatile("" ::: "memory");
#if defined(BROKEN_EXCHANGE_NO_WAIT)
#warning BROKEN CONTROL BUILD: the row-statistics exchange does not wait; results are wrong by design
        if (blockIdx.x >= 64) { const long long t0_ = clock64(); while (clock64() - t0_ < 60000) __builtin_amdgcn_s_sleep(8); }
#endif
        const int row = wid * 32 + (lane & 31);
        if (lane < 32) {
            const f32x2v a = P[row * 4 + 0], b = P[row * 4 + 1], c = P[row * 4 + 2], d = P[row * 4 + 3];
            const float mt = (a.x + b.x + c.x + d.x) * 0.25f;
            const float da = a.x - mt, db = b.x - mt, dc = c.x - mt, dd = d.x - mt;
            const float m2 = (a.y + b.y) + (c.y + d.y) + 64.0f * ((da * da + db * db) + (dc * dc + dd * dd));
            unsigned long long* slot = (unsigned long long*)xbuf + ((size_t)(u.pm * BM + row) * 4 + u.pn);
            __hip_atomic_store(slot, ((unsigned long long)__float_as_uint(m2) << 32) | __float_as_uint(mt), __ATOMIC_RELAXED, __HIP_MEMORY_SCOPE_AGENT);
        }
        asm volatile("s_waitcnt vmcnt(0)" ::: "memory");
        if (lane == 0) __hip_atomic_fetch_add(cnt + 64 * u.pm, 1u, __ATOMIC_RELAXED, __HIP_MEMORY_SCOPE_AGENT);
        if (wid == 0) {
            bool dead = false; const unsigned long long t0 = __builtin_amdgcn_s_memrealtime(); const unsigned want = 8u * (unsigned)ntn;
            for (;;) {
#if defined(BROKEN_EXCHANGE_NO_WAIT)
                break;
#endif
                if ((unsigned)__builtin_amdgcn_readfirstlane(__hip_atomic_load(cnt + 64 * u.pm, __ATOMIC_RELAXED, __HIP_MEMORY_SCOPE_AGENT)) >= want) break;
                if (__builtin_amdgcn_s_memrealtime() - t0 > 2000000ull) {
                    if (lane == 0) { unsigned expect = 0u; __hip_atomic_compare_exchange_strong(tmo + 1, &expect, code | (unsigned)(u.pm & 0xff), __ATOMIC_RELAXED, __ATOMIC_RELAXED, __HIP_MEMORY_SCOPE_AGENT);
                                     __hip_atomic_store(tmo, 1u, __ATOMIC_RELAXED, __HIP_MEMORY_SCOPE_AGENT); }
                    dead = true; break; }
                __builtin_amdgcn_s_sleep(2);
            }
            __builtin_amdgcn_fence(__ATOMIC_ACQUIRE, "agent");
            if (lane == 0) flag[0] = dead ? 1u : 0u;
        }
        asm volatile("s_waitcnt vmcnt(0) lgkmcnt(0)" ::: "memory"); __builtin_amdgcn_s_barrier(); asm volatile("" ::: "memory");
        const bool bad = flag[0] != 0u;
        if (lane < 32) {
            const unsigned long long* slot = (const unsigned long long*)xbuf + (size_t)(u.pm * BM + row) * 4; float mt[4], m2[4]; float ms = 0.f;
#pragma unroll
            for (int t = 0; t < 4; ++t) { if (t < ntn) { const unsigned long long w = __hip_atomic_load(slot + t, __ATOMIC_RELAXED, __HIP_MEMORY_SCOPE_AGENT); mt[t] = __uint_as_float((unsigned)w); m2[t] = __uint_as_float((unsigned)(w >> 32)); } else { mt[t] = 0.f; m2[t] = 0.f; } ms += mt[t]; }
            const float mean = ms / (float)ntn; float q = 0.f;
#pragma unroll
            for (int t = 0; t < 4; ++t) if (t < ntn) { const float dm = mt[t] - mean; q += m2[t] + 256.0f * dm * dm; }
            S[row] = (f32x2v){mean, 1.0f / sqrtf(q / (256.0f * (float)ntn) + eps)};
        }
        asm volatile("s_waitcnt lgkmcnt(0)" ::: "memory"); __builtin_amdgcn_s_barrier(); asm volatile("" ::: "memory");
        return bad;
    }
};

template <int I> struct EpiLnMod {
    static constexpr bool PERM = true, AFTER_DRAIN = true;
    const float* xin; float* out; bf16_t* xm; const float* mod; const float* lg; const float* lb; PanelStats st;
    static constexpr float yscale = (I == 1) ? 1.0f : 0.5f;
    __device__ __forceinline__ void fused(f32x4 (&acc)[2][2][4][2], const Unit& u, int wr, int wc, int fr, int fq, PG8_LAS unsigned char* lds, int wid, int lane) const {
        typedef float f32x2v __attribute__((ext_vector_type(2)));
        const PG8_LAS f32x2v* S = (const PG8_LAS f32x2v*)(lds + 8192);
        const int col0 = u.pn * BM + wc * 32 + 8 * fq;
        const float* ms = mod + (size_t)(u.pm >> 3) * 9216 + I * 3072;
        const float alpha = 1.189207115002721f;
        const unsigned loff = (unsigned)fr * 4096u + (unsigned)(u.pn * BM + wc * 32 + 8 * fq) * 4u;
#pragma unroll
        for (int bj = 0; bj < 2; ++bj)
#pragma unroll
            for (int n = 0; n < 2; ++n) { const f32x4 gt = *(const f32x4*)(ms + 2048 + col0 + bj * HALF + 4 * n) * yscale;
                f32x4 xv[2][4];
#pragma unroll
                for (int ai = 0; ai < 2; ++ai)
#pragma unroll
                    for (int m = 0; m < 4; ++m) {
                        const char* rb = (const char*)xin + (size_t)(u.pm * BM + ai * HALF + wr * 64 + m * 16) * 4096 + (bj * HALF + 4 * n) * 4;
                        xv[ai][m] = *(const f32x4*)(rb + loff); }
#pragma unroll
                for (int ai = 0; ai < 2; ++ai)
#pragma unroll
                    for (int m = 0; m < 4; ++m) { acc[ai][bj][m][n] = xv[ai][m] * alpha + gt * acc[ai][bj][m][n]; asm volatile("" : "+v"(acc[ai][bj][m][n])); }
                asm volatile("" ::: "memory");
            }
        const bool bad = st.run(acc, u, wr, wc, fr, fq, lds, wid, lane);
        const float qnan = __builtin_nanf("");
#pragma unroll
        for (int bj = 0; bj < 2; ++bj) {
            f32x4 g4[2], b4[2], sc4[2], sh4[2];
#pragma unroll
            for (int n = 0; n < 2; ++n) {
#if EPI_X & 2
                g4[n] = (f32x4){1.f, 1.f, 1.f, 1.f}; b4[n] = g4[n];
#else
                g4[n] = *(const f32x4*)(lg + col0 + bj * HALF + 4 * n); b4[n] = *(const f32x4*)(lb + col0 + bj * HALF + 4 * n);
#endif
                if (I < 2) { sh4[n] = *(const f32x4*)(ms + 3072 + col0 + bj * HALF + 4 * n); sc4[n] = *(const f32x4*)(ms + 4096 + col0 + bj * HALF + 4 * n) + 1.0f; } }
#pragma unroll
            for (int ai = 0; ai < 2; ++ai)
#pragma unroll
                for (int m = 0; m < 4; ++m) { const int r = ai * HALF + wr * 64 + m * 16 + fr; const f32x2v sr = S[r];
                    float* const outp = (float*)((char*)out + (size_t)(u.pm * BM + ai * HALF + wr * 64 + m * 16) * 4096 + bj * HALF * 4 + loff);
                    bf16_t* const xmp = (bf16_t*)((char*)xm + (size_t)(u.pm * BM + ai * HALF + wr * 64 + m * 16) * 2048 + bj * HALF * 2 + (loff >> 1));
                    f32x4 o0 = (acc[ai][bj][m][0] - sr.x) * sr.y * g4[0] + b4[0], o1 = (acc[ai][bj][m][1] - sr.x) * sr.y * g4[1] + b4[1];
                    if (bad) { o0 = (f32x4){qnan, qnan, qnan, qnan}; o1 = o0; }
                    *(f32x4*)outp = o0; *(f32x4*)(outp + 4) = o1;
                    if (I < 2) { const f32x4 u0 = o0 * sc4[0] + sh4[0], u1 = o1 * sc4[1] + sh4[1];
                        u32x4 w; w.x = cvt_pk_bf16(u0[0], u0[1]); w.y = cvt_pk_bf16(u0[2], u0[3]); w.z = cvt_pk_bf16(u1[0], u1[1]); w.w = cvt_pk_bf16(u1[2], u1[3]);
                        *(u32x4*)xmp = w; }
                    asm volatile("" ::: "memory"); }
            asm volatile("" ::: "memory");
        }
    }
};
struct EpiWin {
    static constexpr bool PERM = true, AFTER_DRAIN = false;
    bf16_t* PQ; bf16_t* PR; float* GB; const float* a_log; const float* dt_bias; int Mrows;
    __device__ __forceinline__ void operator()(const f32x4 (&acc)[2][2][4][2], const Unit& u, int wr, int wc, int fr, int fq) const {
        const int row0 = u.pm * BM + wr * 64 + fr;
        if (u.pn < 14) {
            const bool second = u.pn >= 6; bf16_t* const base = second ? PR : PQ; const int ld = second ? 2048 : 1536;
            const int col0 = (second ? u.pn - 6 : u.pn) * BM + wc * 32 + 8 * fq;
#pragma unroll
            for (int ai = 0; ai < 2; ++ai)
#pragma unroll
                for (int m = 0; m < 4; ++m) { bf16_t* rowp = base + (size_t)(row0 + ai * HALF + m * 16) * ld + col0;
#pragma unroll
                    for (int bj = 0; bj < 2; ++bj) { const f32x4 v0 = acc[ai][bj][m][0], v1 = acc[ai][bj][m][1];
                        u32x4 w; w.x = cvt_pk_bf16(v0[0], v0[1]); w.y = cvt_pk_bf16(v0[2], v0[3]); w.z = cvt_pk_bf16(v1[0], v1[1]); w.w = cvt_pk_bf16(v1[2], v1[3]);
                        *(u32x4*)(rowp + bj * HALF) = w; } }
        } else if (wc == 0 && fq == 0) {
            const f32x4 al = *(const f32x4*)a_log, dt = *(const f32x4*)dt_bias;
#pragma unroll
            for (int ai = 0; ai < 2; ++ai)
#pragma unroll
                for (int m = 0; m < 4; ++m) { const int row = row0 + ai * HALF + m * 16; const f32x4 a = acc[ai][0][m][0], b = acc[ai][0][m][1]; f32x4 gv, bv;
#pragma unroll
                    for (int h = 0; h < 4; ++h) { const float z = a[h] + dt[h]; const float sp = z > 20.f ? z : log1pf(__expf(z)); gv[h] = -__expf(al[h]) * sp; bv[h] = 1.f / (1.f + __expf(-b[h])); }
                    *(f32x4*)(GB + (size_t)row * 4) = gv; *(f32x4*)(GB + (size_t)Mrows * 4 + (size_t)row * 4) = bv; }
        }
    }
};
template <class Epi, class Sched, bool ALIGN_EPI = false, bool SP2 = false, int F8 = 0>
__device__ __forceinline__ void gemm_phase(PG8_LAS unsigned char* lds, const Gemm g, const Sched& S, const Epi& E) {
    int tid_l = threadIdx.x; asm volatile("" : "+v"(tid_l));
    const int tid = tid_l, wid = __builtin_amdgcn_readfirstlane(tid >> 6), lane = tid & 63, wr = wid >> 2, wc = wid & 3, fr = lane & 15, fq = lane >> 4;
    const int K = g.K, nt = K / BK;
    typedef int i32x4 __attribute__((ext_vector_type(4))); typedef int i32x8 __attribute__((ext_vector_type(8)));
    const int f8sw = F8 * 0x01010101, f8sa = 0x7F7F7F7F; (void)f8sw; (void)f8sa;
    unsigned voffA[2], voffB[2];
#pragma unroll
    for (int i = 0; i < 2; ++i) { int R, C; stage_rc(tid * 16 + i * 8192, R, C); const int Rb = Epi::PERM ? ((R & ~31) + perm32(R & 31)) : R;
        voffA[i] = (unsigned)(R * K + C) * 2u; voffB[i] = (unsigned)(Rb * K + C) * 2u; }
    const size_t kstep = (size_t)(BK * 2);
    const size_t hstep = (size_t)HALF * K * 2;
    const size_t tstep = 2 * hstep;
    const unsigned ldsw = (unsigned)wid * 1024u;
    const int aoff = lds_byte(wr * 64 + fr, fq * 8), boff = lds_byte(wc * 32 + fr, fq * 8);
#define PG8_SA(b, h) (((b) * 2 + (h)) * HTB)
#define PG8_SB(b, h) ((4 + (b) * 2 + (h)) * HTB)
#define PG8_STAGE(bufoff, gbase, voff) do { _Pragma("unroll") for (int _i = 0; _i < 2; ++_i) \
        __builtin_amdgcn_global_load_lds((const unsigned*)((const char*)(gbase) + (voff)[_i]), (PG8_LAS unsigned*)(lds + (bufoff) + ldsw + _i * 8192), 16, 0, 0); } while (0)
#define PG8_LDA(dst, b, h) do { _Pragma("unroll") for (int m = 0; m < 4; ++m) _Pragma("unroll") for (int k = 0; k < 2; ++k) dst[m][k] = *(const PG8_LAS bf16x8*)(lds + PG8_SA(b, h) + aoff + m * 2048 + k * 1024); } while (0)
#define PG8_LDB(dst, b, h) do { _Pragma("unroll") for (int n = 0; n < 2; ++n) _Pragma("unroll") for (int k = 0; k < 2; ++k) dst[n][k] = *(const PG8_LAS bf16x8*)(lds + PG8_SB(b, h) + boff + n * 2048 + k * 1024); } while (0)
#define PG8_CAT(lo, hi) __builtin_shufflevector(__builtin_bit_cast(i32x4, lo), __builtin_bit_cast(i32x4, hi), 0, 1, 2, 3, 4, 5, 6, 7)
#define PG8_MMA(ai, bj, At, Bt) do { __builtin_amdgcn_s_setprio(1); _Pragma("unroll") for (int m = 0; m < 4; ++m) _Pragma("unroll") for (int n = 0; n < 2; ++n) { \
        if constexpr (F8 != 0) { const i32x8 a8_ = PG8_CAT(Bt[n][0], Bt[n][1]), b8_ = PG8_CAT(At[m][0], At[m][1]); \
            asm volatile("v_mfma_scale_f32_16x16x128_f8f6f4 %0, %1, %2, %0, %3, %4 op_sel_hi:[0,0,0]" : "+v"(acc[ai][bj][m][n]) : "v"(a8_), "v"(b8_), "v"(f8sw), "v"(f8sa)); } \
        else { _Pragma("unroll") for (int k = 0; k < 2; ++k) acc[ai][bj][m][n] = __builtin_amdgcn_mfma_f32_16x16x32_bf16(Bt[n][k], At[m][k], acc[ai][bj][m][n], 0, 0, 0); } } __builtin_amdgcn_s_setprio(0); } while (0)
#define PG8_WAIT_V(n) asm volatile("s_waitcnt vmcnt(" #n ")" ::: "memory")
#define PG8_WAIT_L(n) asm volatile("s_waitcnt lgkmcnt(" #n ")" ::: "memory")
#define PG8_BAR __builtin_amdgcn_s_barrier()
#define PG8_SCHED __builtin_amdgcn_sched_barrier(0)
    Unit cur, nxt; int ui = 0;
    if (!S.next(0, cur)) return;
    f32x4 acc[2][2][4][2];
#pragma unroll
    for (int a = 0; a < 2; ++a)
#pragma unroll
        for (int b = 0; b < 2; ++b)
#pragma unroll
            for (int m = 0; m < 4; ++m)
#pragma unroll
                for (int n = 0; n < 2; ++n) acc[a][b][m][n] = (f32x4){0.f, 0.f, 0.f, 0.f};
    bf16x8 At[4][2], B0[2][2], B1[2][2];
    const char* cA = (const char*)g.A + (size_t)cur.pm * tstep; const char* cB = (const char*)g.Bt + (size_t)cur.pn * tstep;
    S.a_ready(cur);
    if constexpr (SP2) {
        PG8_STAGE(PG8_SB(0, 0), cB, voffB); PG8_STAGE(PG8_SB(0, 1), cB + hstep, voffB); PG8_STAGE(PG8_SA(0, 0), cA, voffA); PG8_STAGE(PG8_SA(0, 1), cA + hstep, voffA);
        if (wr == 1) PG8_BAR;
        PG8_WAIT_V(2); PG8_BAR;
        PG8_STAGE(PG8_SB(1, 0), cB + kstep, voffB); PG8_STAGE(PG8_SA(1, 0), cA + kstep, voffA); PG8_STAGE(PG8_SB(1, 1), cB + hstep + kstep, voffB);
        PG8_WAIT_V(6); PG8_BAR;
    } else {
        PG8_STAGE(PG8_SB(0, 0), cB, voffB); PG8_STAGE(PG8_SA(0, 0), cA, voffA); PG8_STAGE(PG8_SB(0, 1), cB + hstep, voffB); PG8_STAGE(PG8_SA(0, 1), cA + hstep, voffA);
        if (wr == 1) PG8_BAR;
        PG8_WAIT_V(4); PG8_BAR;
        PG8_STAGE(PG8_SB(1, 0), cB + kstep, voffB); PG8_STAGE(PG8_SA(1, 0), cA + kstep, voffA); PG8_STAGE(PG8_SB(1, 1), cB + hstep + kstep, voffB);
        PG8_WAIT_V(6); PG8_BAR;
    }
    for (;;) {
        const bool has_next = S.next(ui + 1, nxt);
        const char* nA = has_next ? (const char*)g.A + (size_t)nxt.pm * tstep : cA; const char* nB = has_next ? (const char*)g.Bt + (size_t)nxt.pn * tstep : cB;
#pragma unroll 1
        for (int t = 0; t < nt; t += 2) {
            const bool last = (t == nt - 2);
            const char* a1 = cA + (size_t)(t + 1) * kstep;
            const char* a2 = last ? nA : cA + (size_t)(t + 2) * kstep; const char* b2 = last ? nB : cB + (size_t)(t + 2) * kstep;
            const char* a3 = a2 + kstep; const char* b3 = b2 + kstep;
            if (last && has_next) S.a_ready(nxt);
            if constexpr (SP2) {
            PG8_LDB(B0, 0, 0); PG8_LDB(B1, 0, 1); PG8_SCHED; PG8_LDA(At, 0, 0); PG8_STAGE(PG8_SA(1, 1), a1 + hstep, voffA);
            PG8_WAIT_V(8); PG8_WAIT_L(0); PG8_BAR; PG8_MMA(0, 0, At, B0); PG8_MMA(0, 1, At, B1); PG8_BAR; PG8_SCHED;
            PG8_LDA(At, 0, 1); PG8_STAGE(PG8_SB(0, 0), b2, voffB); PG8_STAGE(PG8_SB(0, 1), b2 + hstep, voffB); PG8_STAGE(PG8_SA(0, 0), a2, voffA);
            PG8_WAIT_V(8); PG8_WAIT_L(0); PG8_BAR; PG8_MMA(1, 0, At, B0); PG8_MMA(1, 1, At, B1); PG8_BAR; PG8_SCHED;
            PG8_LDB(B0, 1, 0); PG8_LDB(B1, 1, 1); PG8_SCHED; PG8_LDA(At, 1, 0); PG8_STAGE(PG8_SA(0, 1), a2 + hstep, voffA);
            PG8_WAIT_V(8); PG8_WAIT_L(0); PG8_BAR; PG8_MMA(0, 0, At, B0); PG8_MMA(0, 1, At, B1); PG8_BAR; PG8_SCHED;
            PG8_LDA(At, 1, 1); PG8_STAGE(PG8_SB(1, 0), b3, voffB); PG8_STAGE(PG8_SB(1, 1), b3 + hstep, voffB); PG8_STAGE(PG8_SA(1, 0), a3, voffA);
            PG8_WAIT_V(8); PG8_WAIT_L(0); PG8_BAR; PG8_MMA(1, 0, At, B0); PG8_MMA(1, 1, At, B1); PG8_BAR; PG8_SCHED;
            } else {
            PG8_LDB(B0, 0, 0); PG8_SCHED; PG8_LDA(At, 0, 0); PG8_STAGE(PG8_SA(1, 1), a1 + hstep, voffA);
            PG8_WAIT_L(8); PG8_BAR; PG8_WAIT_L(0); PG8_MMA(0, 0, At, B0); PG8_BAR; PG8_SCHED;
            PG8_LDB(B1, 0, 1); PG8_STAGE(PG8_SB(0, 0), b2, voffB);
            PG8_BAR; PG8_WAIT_L(0); PG8_MMA(0, 1, At, B1); PG8_BAR;
            PG8_LDA(At, 0, 1); PG8_STAGE(PG8_SA(0, 0), a2, voffA);
            PG8_BAR; PG8_WAIT_L(0); PG8_MMA(1, 0, At, B0); PG8_BAR; PG8_SCHED;
            PG8_STAGE(PG8_SB(0, 1), b2 + hstep, voffB);
            PG8_WAIT_V(6); PG8_BAR; PG8_MMA(1, 1, At, B1); PG8_BAR;
            PG8_LDB(B0, 1, 0); PG8_SCHED; PG8_LDA(At, 1, 0); PG8_STAGE(PG8_SA(0, 1), a2 + hstep, voffA);
            PG8_WAIT_L(8); PG8_BAR; PG8_WAIT_L(0); PG8_MMA(0, 0, At, B0); PG8_BAR; PG8_SCHED;
            PG8_LDB(B1, 1, 1); PG8_STAGE(PG8_SB(1, 0), b3, voffB);
            PG8_BAR; PG8_WAIT_L(0); PG8_MMA(0, 1, At, B1); PG8_BAR;
            PG8_LDA(At, 1, 1); PG8_STAGE(PG8_SA(1, 0), a3, voffA);
            PG8_BAR; PG8_WAIT_L(0); PG8_MMA(1, 0, At, B0); PG8_BAR; PG8_SCHED;
            PG8_STAGE(PG8_SB(1, 1), b3 + hstep, voffB);
            PG8_WAIT_V(6); PG8_BAR; PG8_MMA(1, 1, At, B1); PG8_BAR;
            }
        }
        if constexpr (F8 != 0) asm volatile("s_nop 15\n\ts_nop 15" ::: "memory");
        if constexpr (ALIGN_EPI) { if (wr == 0) PG8_BAR; }
        if constexpr (!Epi::AFTER_DRAIN) { E(acc, cur, wr, wc, fr, fq); S.done(cur); }
        if (!has_next) break;
#pragma unroll
        for (int a = 0; a < 2; ++a)
#pragma unroll
            for (int b = 0; b < 2; ++b)
#pragma unroll
                for (int m = 0; m < 4; ++m)
#pragma unroll
                    for (int n = 0; n < 2; ++n) acc[a][b][m][n] = (f32x4){0.f, 0.f, 0.f, 0.f};
        cur = nxt; cA = nA; cB = nB; ++ui;
        if constexpr (ALIGN_EPI) { if (wr == 1) PG8_BAR; }
    }
    PG8_WAIT_V(0);
    if constexpr (!ALIGN_EPI) { if (wr == 0) PG8_BAR; }
    PG8_BAR;
    if constexpr (Epi::AFTER_DRAIN) { E.fused(acc, cur, wr, wc, fr, fq, lds, wid, lane); S.done(cur); }
#undef PG8_SA
#undef PG8_SB
#undef PG8_STAGE
#undef PG8_LDA
#undef PG8_LDB
#undef PG8_MMA
#undef PG8_CAT
#undef PG8_WAIT_V
#undef PG8_WAIT_L
#undef PG8_BAR
#undef PG8_SCHED
}
}
constexpr int NWAVES = 8;
constexpr int D = 1024, NB = 8, T = 2048, NS = 128, TS = 4, FF = 2816, PROJ = 3592, QKV = 1536, NH = 4;
constexpr int MP = NB * T, MS = NS * TS, M = MP + MS, NSEQ = NB + NS;
constexpr int NUP = 2 * FF, NIN = 3584, MODW = 9 * D;
constexpr float ALPHA = 1.189207115002721f, LN_EPS = 1e-5f;
constexpr size_t O_Y = 0, O_SSM_P = (size_t)M * D, O_CQ_P = O_SSM_P + (size_t)NB * NH * 128 * 128, O_CM_P = O_CQ_P + (size_t)NB * 3 * QKV,
                 O_SSM_S = O_CM_P + (size_t)NB * 2 * 512, O_CQ_S = O_SSM_S + (size_t)NS * NH * 128 * 128, O_CM_S = O_CQ_S + (size_t)NS * 3 * QKV,
                 O_END = O_CM_S + (size_t)NS * 2 * 512;
constexpr size_t MiB = 1u << 20, KiB = 1u << 10;
constexpr size_t WS_CTL = 0, CTL_ZERO_BYTES = 128 * KiB;
constexpr size_t WS_MOD = 1 * MiB;
constexpr size_t WS_W1U = 6 * MiB, WS_W1D = 17 * MiB, WS_W2U = 22 * MiB + 512 * KiB, WS_W2D = 33 * MiB + 512 * KiB, WS_WIN = 39 * MiB, WS_WOUT = 46 * MiB + 512 * KiB;
constexpr size_t WS_GB = 128 * KiB, WS_GL = 704 * KiB;
constexpr int NING = 3840;
constexpr size_t WS_XM = 49 * MiB, WS_Y = 82 * MiB, WS_HP = 115 * MiB, WS_END = 256 * MiB;
static_assert(WS_MOD + (size_t)NSEQ * MODW * 4 <= WS_W1U && WS_W1U + (size_t)NUP * D * 2 <= WS_W1D && WS_W1D + (size_t)D * FF * 2 <= WS_W2U && WS_W2U + (size_t)NUP * D * 2 <= WS_W2D &&
              WS_W2D + (size_t)D * FF * 2 <= WS_WIN && WS_WIN + (size_t)NING * D * 2 <= WS_WOUT && WS_WOUT + (size_t)D * D * 2 <= WS_XM && WS_GB + (size_t)M * 8 * 4 <= WS_GL && WS_GL + 4096 <= WS_MOD &&
              WS_XM + (size_t)M * D * 2 <= WS_Y && WS_Y + (size_t)M * D * 2 <= WS_HP && WS_HP + (size_t)M * NIN * 2 <= WS_END, "d_ws map");
constexpr size_t WS_X2B = WS_HP + 100 * MiB;
static_assert(WS_X2B >= WS_HP + (size_t)M * FF * 2 && WS_X2B + (size_t)M * D * 2 <= WS_END - 2 * MiB, "x2 above H");
constexpr int CW_TMO = 0, CW_CODE = 1, CW_BAR = 4096, CW_SEAM = 8192, SEAM_BANK = 64 * 64;
static_assert((CW_SEAM + 3 * SEAM_BANK) * 4 <= (int)CTL_ZERO_BYTES && CW_BAR + 3456 <= CW_SEAM, "control words");
constexpr size_t WS_XCH = 254 * MiB + 512 * KiB;
constexpr int RING_OFF = 0, RING_BYTES = 131072, LDSCTL_OFF = RING_BYTES, MISC_OFF = LDSCTL_OFF + 320, LDS_BYTES = 147456;

#define GAS __attribute__((address_space(1)))
#define LAS __attribute__((address_space(3)))
typedef unsigned short bf16;
typedef unsigned v4u __attribute__((ext_vector_type(4)));
typedef unsigned v2u __attribute__((ext_vector_type(2)));
typedef float f32x4 __attribute__((ext_vector_type(4)));
typedef short bf16x8 __attribute__((ext_vector_type(8)));
typedef GAS unsigned gu32;
#define RLX_AGENT __ATOMIC_RELAXED, __HIP_MEMORY_SCOPE_AGENT
#define LDS_WAIT() asm volatile("s_waitcnt lgkmcnt(0)" ::: "memory")
#define VM_WAIT() asm volatile("s_waitcnt vmcnt(0)" ::: "memory")
__device__ __forceinline__ unsigned f2bf(float f) { unsigned u = __builtin_bit_cast(unsigned, f); return (u + 0x7fffu + ((u >> 16) & 1u)) >> 16; }
typedef float f32x2_t __attribute__((ext_vector_type(2))); typedef __bf16 bf16x2_t __attribute__((ext_vector_type(2)));
__device__ __forceinline__ unsigned pk2(float lo, float hi) { const f32x2_t v = {lo, hi}; const bf16x2_t b = __builtin_convertvector(v, bf16x2_t); return __builtin_bit_cast(unsigned, b); }
__device__ __forceinline__ float bf_lo(unsigned w) { return __builtin_bit_cast(float, w << 16); }
__device__ __forceinline__ float bf_hi(unsigned w) { return __builtin_bit_cast(float, w & 0xffff0000u); }
__device__ __forceinline__ float silu_f(float x) { return x * __builtin_amdgcn_rcpf(1.0f + __builtin_amdgcn_exp2f(-1.4426950408889634f * x)); }

#define XB_TMO      128
#define XB_XCNT(j)  (256  + 64 * (j))
#define XB_XSUB(j)  (1280 + 64 * (j))
#define XB_XGEN(j)  (2304 + 64 * (j))
#define XB_TOP      3328
#define XB_TOPGEN   3392
#define XCD_BAR_WORDS 3456
#define XB_SPIN_CAP (1u << 18)
__device__ __forceinline__ unsigned xb_ld(unsigned* p)              { return __hip_atomic_load(p, __ATOMIC_RELAXED, __HIP_MEMORY_SCOPE_AGENT); }
__device__ __forceinline__ unsigned xb_add(unsigned* p, unsigned v) { return __hip_atomic_fetch_add(p, v, __ATOMIC_RELAXED, __HIP_MEMORY_SCOPE_AGENT); }
__device__ __forceinline__ unsigned xb_xcc_id() { return (unsigned)__builtin_amdgcn_s_getreg((3 << 11) | 20) & 0xFu; }
#define XB_SPIN(cond, bar) do { unsigned _sp = 0; while (cond) { __builtin_amdgcn_s_sleep(1); \
    if ((++_sp & 255u) == 0u) { if (xb_ld(&(bar)[XB_TMO])) break; if (_sp > XB_SPIN_CAP) { atomicAdd(&(bar)[XB_TMO], 1u); break; } } } } while (0)
struct XcdBarrier { unsigned* bar; unsigned x; volatile LAS unsigned* st; };
__device__ __forceinline__ XcdBarrier xcd_barrier_post(unsigned* bar, volatile LAS unsigned* st) {
    XcdBarrier b; b.bar = bar; b.x = xb_xcc_id(); b.st = st;
    if (threadIdx.x == 0) (void)xb_add(&bar[XB_XCNT(b.x)], 1u);
    return b;
}
__device__ __forceinline__ void xcd_barrier_complete(unsigned* bar, unsigned x, unsigned& nloc, unsigned& nx) {
    const unsigned G = gridDim.x * gridDim.y * gridDim.z;
    unsigned sum, cnt, mine, sp = 0u;
    for (;;) {
        sum = 0u; cnt = 0u; mine = 0u;
#pragma unroll
        for (unsigned j = 0; j < 16; ++j) { const unsigned c = xb_ld(&bar[XB_XCNT(j)]); sum += c; cnt += (c > 0u) ? 1u : 0u; mine = (j == x) ? c : mine; }
        if (sum == G) break;
        __builtin_amdgcn_s_sleep(1);
        if ((++sp & 255u) == 0u) { if (xb_ld(&bar[XB_TMO])) break; if (sp > XB_SPIN_CAP) { atomicAdd(&bar[XB_TMO], 1u); break; } }
    }
    nloc = mine > 0u ? mine : 1u; nx = cnt > 0u ? cnt : 1u;
}
__device__ __forceinline__ void xcd_barrier_census(const XcdBarrier& b) {
    if (threadIdx.x == 0) { unsigned nloc, nx; xcd_barrier_complete(b.bar, b.x, nloc, nx); b.st[0] = nloc; b.st[1] = nx; }
    __syncthreads();
}
__device__ __forceinline__ void xcd_barrier(const XcdBarrier& b) {
    asm volatile("s_waitcnt vmcnt(0)" ::: "memory");
    __syncthreads();
    if (threadIdx.x == 0) {
        unsigned* bar = b.bar;
        __builtin_amdgcn_s_waitcnt(0);
        unsigned nloc = b.st[0], nx = b.st[1];
        const unsigned old = xb_add(&bar[XB_XSUB(b.x)], 1u);
        const unsigned gen = old / nloc;
        if (old + 1u == (gen + 1u) * nloc) {
            __builtin_amdgcn_fence(__ATOMIC_RELEASE, "agent");
            asm volatile("s_waitcnt vmcnt(0)" ::: "memory");
            const unsigned og = xb_add(&bar[XB_TOP], 1u);
            const unsigned tg = og / nx;
            if (og + 1u == (tg + 1u) * nx) xb_add(&bar[XB_TOPGEN], 1u);
            else XB_SPIN(xb_ld(&bar[XB_TOPGEN]) == tg, bar);
            __builtin_amdgcn_fence(__ATOMIC_ACQUIRE, "agent");
            xb_add(&bar[XB_XGEN(b.x)], 1u);
            asm volatile("s_waitcnt vmcnt(0)" ::: "memory");
        } else {
            XB_SPIN(xb_ld(&bar[XB_XGEN(b.x)]) == gen, bar);
            __builtin_amdgcn_fence(__ATOMIC_ACQUIRE, "agent");
            asm volatile("s_waitcnt vmcnt(0)" ::: "memory");
        }
    }
    __syncthreads();
}

struct Args { const float* in[24]; float* out; unsigned char* ws; int ph_lo, ph_hi; };
struct Frame {
    LAS unsigned char* lds;
    volatile LAS unsigned* MISC;
    gu32* ctl;
    int tid, lane, wave, vcu, G;
    const struct Args* a; float* out; unsigned char* ws;
};
__device__ __forceinline__ float wave_sum(float v) {
#define WS_DPP(ctrl_, rm_) __builtin_bit_cast(float, __builtin_amdgcn_update_dpp(0, __builtin_bit_cast(int, v), ctrl_, rm_, 0xF, false))
    v += WS_DPP(0xB1, 0xF); v += WS_DPP(0x4E, 0xF); v += WS_DPP(0x141, 0xF); v += WS_DPP(0x140, 0xF);
    v += WS_DPP(0x142, 0xA); v += WS_DPP(0x143, 0xC);
#undef WS_DPP
    return __builtin_bit_cast(float, __builtin_amdgcn_readlane(__builtin_bit_cast(int, v), 63));
}
__device__ __forceinline__ int seq_of(int m) { return m < MP ? (m >> 11) : NB + ((m - MP) >> 2); }

__device__ __forceinline__ void p0_ada(Frame& F) {
    constexpr int RS = 528;
    const int unit = F.wave * F.G + (int)blockIdx.x;
    const bool has = unit < 576;
    const int n0 = unit * 16, m = F.lane & 15, g = F.lane >> 4;
    const float* wada = F.a->in[7];
    f32x4 acc[9];
#pragma unroll
    for (int i = 0; i < 9; ++i) acc[i] = (f32x4){0.f, 0.f, 0.f, 0.f};
    float afn[8][8];
#define ADA_LOAD(kc_) do { if (has) { _Pragma("unroll") for (int ks = 0; ks < 8; ++ks) _Pragma("unroll") for (int j = 0; j < 8; ++j) \
        afn[ks][j] = wada[(size_t)((kc_) * 256 + ks * 32 + 8 * g + j) * MODW + n0 + m]; } } while (0)
    ADA_LOAD(0);
#pragma unroll 1
    for (int kc = 0; kc < 4; ++kc) {
#pragma unroll
        for (int i = 0; i < 9; ++i) {
            const int gi = F.tid + 512 * i, row = gi >> 5, kg = gi & 31;
            v4u o = (v4u){0u, 0u, 0u, 0u};
            if (row < NSEQ) {
                const float* c = (row < NB ? F.a->in[5] + (size_t)row * D : F.a->in[6] + (size_t)(row - NB) * D) + kc * 256 + kg * 8;
                const f32x4 a = *(const f32x4*)c, b = *(const f32x4*)(c + 4);
                o.x = pk2(silu_f(a.x), silu_f(a.y)); o.y = pk2(silu_f(a.z), silu_f(a.w)); o.z = pk2(silu_f(b.x), silu_f(b.y)); o.w = pk2(silu_f(b.z), silu_f(b.w));
            }
            *(LAS v4u*)(F.lds + row * RS + kg * 16) = o;
        }
        v4u aw[8];
#pragma unroll
        for (int ks = 0; ks < 8; ++ks) { aw[ks].x = pk2(afn[ks][0], afn[ks][1]); aw[ks].y = pk2(afn[ks][2], afn[ks][3]); aw[ks].z = pk2(afn[ks][4], afn[ks][5]); aw[ks].w = pk2(afn[ks][6], afn[ks][7]); }
        if (kc + 1 < 4) ADA_LOAD(kc + 1);
        LDS_WAIT(); __syncthreads();
        if (has) {
#pragma unroll
            for (int ks = 0; ks < 8; ++ks) {
                const bf16x8 A = __builtin_bit_cast(bf16x8, aw[ks]);
#pragma unroll
                for (int nt = 0; nt < 9; ++nt) {
                    const bf16x8 B = *(const LAS bf16x8*)(F.lds + (16 * nt + m) * RS + (ks * 32 + 8 * g) * 2);
                    acc[nt] = __builtin_amdgcn_mfma_f32_16x16x32_bf16(A, B, acc[nt], 0, 0, 0);
                }
            }
        }
        LDS_WAIT(); __syncthreads();
    }
#undef ADA_LOAD
    if (has) {
        const f32x4 bv = *(const f32x4*)(F.a->in[8] + n0 + 4 * g);
        float* mod = (float*)(F.ws + WS_MOD);
#pragma unroll
        for (int nt = 0; nt < 9; ++nt) { const int s = 16 * nt + m; if (s < NSEQ) *(f32x4*)(mod + (size_t)s * MODW + n0 + 4 * g) = acc[nt] + bv; }
    }
}
#ifndef F8_FFN1
#define F8_FFN1 0
#endif
#ifndef F8_FFN2
#define F8_FFN2 1
#endif
constexpr int F8_UP_SH = 5, F8_DN_SH = 6;
template <bool F8 = false>
__device__ __forceinline__ void transpose_item(const float* W, int ldw, int src_col0, void* WTv, int K, int dst_row0, int kb, LAS float* scr, int lane, float scale = 1.f) {
    bf16* const WT = (bf16*)WTv;
    const int k0 = 64 * kb;
    f32x4 tv[8];
#pragma unroll
    for (int i = 0; i < 8; ++i) tv[i] = *(const f32x4*)(W + (size_t)(k0 + 8 * i + (lane >> 3)) * ldw + src_col0 + 4 * (lane & 7));
#pragma unroll
    for (int i = 0; i < 8; ++i) { LAS float* d = scr + (8 * i + (lane >> 3)) * 33 + 4 * (lane & 7); d[0] = tv[i].x; d[1] = tv[i].y; d[2] = tv[i].z; d[3] = tv[i].w; }
    LDS_WAIT(); asm volatile("" ::: "memory");
    const int c = lane & 7;
#pragma unroll
    for (int j = 0; j < 4; ++j) { const int n = (lane >> 3) + 8 * j; const LAS float* s = scr + (8 * c) * 33 + n;
        if constexpr (F8) { v2u o; o.x = pg8::pk4_fp8(s[0 * 33] * scale, s[1 * 33] * scale, s[2 * 33] * scale, s[3 * 33] * scale); o.y = pg8::pk4_fp8(s[4 * 33] * scale, s[5 * 33] * scale, s[6 * 33] * scale, s[7 * 33] * scale);
            *(GAS v2u*)((unsigned char*)WTv + (size_t)(dst_row0 + n) * K + k0 + 8 * c) = o; }
        else { v4u o; o.x = pk2(s[0 * 33], s[1 * 33]); o.y = pk2(s[2 * 33], s[3 * 33]); o.z = pk2(s[4 * 33], s[5 * 33]); o.w = pk2(s[6 * 33], s[7 * 33]);
            *(GAS v4u*)(WT + (size_t)(dst_row0 + n) * K + k0 + 8 * c) = o; } }
    LDS_WAIT(); asm volatile("" ::: "memory");
}
constexpr int CV_W1U = 0, CV_W1D = 2816, CV_WIN = 4224, CV_WOUT = 6032, CV_W2U = 6544, CV_W2D = 9360, CV_END = 10768;
__device__ __forceinline__ void convert_items(Frame& F, int it0, int it1, int gw, int ngw) {
    LAS float* scr = (LAS float*)(F.lds + RING_OFF + F.wave * 16384);
    for (int it = it0 + gw; it < it1; it += ngw) {
        if (it < CV_W1D || (it >= CV_W2U && it < CV_W2D)) { const bool second = it >= CV_W2U; int r = it - (second ? CV_W2U : CV_W1U); const int w = r / 1408; r -= w * 1408; const int kb = r / 88, nb = r % 88;
            const float* src = second ? (w == 0 ? F.a->in[14] : F.a->in[15]) : (w == 0 ? F.a->in[11] : F.a->in[12]); void* dst = F.ws + (second ? WS_W2U : WS_W1U); const int dr = 256 * (nb >> 2) + 32 * (nb & 3) + 128 * w;
            if (second ? F8_FFN2 : F8_FFN1) transpose_item<true>(src, FF, 32 * nb, dst, D, dr, kb, scr, F.lane, (float)(1 << F8_UP_SH)); else transpose_item<false>(src, FF, 32 * nb, dst, D, dr, kb, scr, F.lane); }
        else if (it < CV_WIN || it >= CV_W2D) { const bool second = it >= CV_W2D; const int r = it - (second ? CV_W2D : CV_W1D), kb = r / 32, nb = r % 32;
            const float* src = second ? F.a->in[16] : F.a->in[13]; void* dst = F.ws + (second ? WS_W2D : WS_W1D);
            if (second ? F8_FFN2 : F8_FFN1) transpose_item<true>(src, D, 32 * nb, dst, FF, 32 * nb, kb, scr, F.lane, (float)(1 << F8_DN_SH)); else transpose_item<false>(src, D, 32 * nb, dst, FF, 32 * nb, kb, scr, F.lane); }
        else if (it < CV_WOUT) { const int r = it - CV_WIN, kb = r / 113, nb = r % 113;
            transpose_item(F.a->in[17], PROJ, nb < 48 ? 32 * nb : nb < 112 ? 1544 + 32 * (nb - 48) : 1536, (bf16*)(F.ws + WS_WIN), D, nb < 48 ? 32 * nb : nb < 112 ? 1536 + 32 * (nb - 48) : 3584, kb, scr, F.lane); }
        else { const int r = it - CV_WOUT, kb = r / 32, nb = r % 32; transpose_item(F.a->in[23], D, 32 * nb, (bf16*)(F.ws + WS_WOUT), D, 32 * nb, kb, scr, F.lane); }
    }
}
template <int K>
__device__ __forceinline__ void sample_gemm(Frame& F, const bf16* A, const bf16* Bt, bf16* C) {
    static_assert(K % 256 == 0, "K split over 8 waves in 32-deep steps");
    int tid_l = F.tid; asm volatile("" : "+v"(tid_l));
    const int tid = tid_l, lane = tid & 63, wave = F.wave, m = lane & 15, g = lane >> 4;
    for (int tile = (int)blockIdx.x; tile < 256; tile += F.G) {
        const int rm = tile >> 4, cn = tile & 15;
        const bf16* a0 = A + (size_t)(32 * rm + m) * K + wave * (K / 8) + 8 * g;
        const bf16* b0 = Bt + (size_t)(64 * cn + m) * K + wave * (K / 8) + 8 * g;
        f32x4 acc[2][4];
#pragma unroll
        for (int i = 0; i < 2; ++i)
#pragma unroll
            for (int j = 0; j < 4; ++j) acc[i][j] = (f32x4){0.f, 0.f, 0.f, 0.f};
#pragma unroll 4
        for (int ks = 0; ks < K / 256; ++ks) {
            bf16x8 a[2], b[4];
#pragma unroll
            for (int i = 0; i < 2; ++i) a[i] = *(const GAS bf16x8*)(a0 + (size_t)(16 * i) * K + 32 * ks);
#pragma unroll
            for (int j = 0; j < 4; ++j) b[j] = *(const GAS bf16x8*)(b0 + (size_t)(16 * j) * K + 32 * ks);
#pragma unroll
            for (int i = 0; i < 2; ++i)
#pragma unroll
                for (int j = 0; j < 4; ++j) acc[i][j] = __builtin_amdgcn_mfma_f32_16x16x32_bf16(a[i], b[j], acc[i][j], 0, 0, 0);
        }
        LAS float* red = (LAS float*)(F.lds + RING_OFF);
#pragma unroll
        for (int i = 0; i < 2; ++i)
#pragma unroll
            for (int j = 0; j < 4; ++j)
#pragma unroll
                for (int r = 0; r < 4; ++r) red[(wave * 32 + 16 * i + 4 * g + r) * 64 + 16 * j + m] = acc[i][j][r];
        LDS_WAIT(); __syncthreads();
        const int row = tid >> 4, c4 = (tid & 15) * 4;
        f32x4 s = (f32x4){0.f, 0.f, 0.f, 0.f};
#pragma unroll
        for (int w = 0; w < 8; ++w) s = s + *(const LAS f32x4*)(red + (w * 32 + row) * 64 + c4);
        v2u o; o.x = pk2(s.x, s.y); o.y = pk2(s.z, s.w);
        *(GAS v2u*)(C + (size_t)(32 * rm + row) * D + 64 * cn + c4) = o;
        LDS_WAIT(); __syncthreads();
    }
}
template <int K>
__device__ __forceinline__ void sample_gemm8(Frame& F, const unsigned char* A, const unsigned char* Bt, bf16* C, float oscale) {
    static_assert(K % 256 == 0, "K split over 8 waves in 32-deep steps");
    int tid_l = F.tid; asm volatile("" : "+v"(tid_l));
    const int tid = tid_l, lane = tid & 63, wave = F.wave, m = lane & 15, g = lane >> 4;
    for (int tile = (int)blockIdx.x; tile < 256; tile += F.G) {
        const int rm = tile >> 4, cn = tile & 15;
        const unsigned char* a0 = A + (size_t)(32 * rm + m) * K + wave * (K / 8) + 8 * g;
        const unsigned char* b0 = Bt + (size_t)(64 * cn + m) * K + wave * (K / 8) + 8 * g;
        f32x4 acc[2][4];
#pragma unroll
        for (int i = 0; i < 2; ++i)
#pragma unroll
            for (int j = 0; j < 4; ++j) acc[i][j] = (f32x4){0.f, 0.f, 0.f, 0.f};
#pragma unroll 4
        for (int ks = 0; ks < K / 256; ++ks) {
            long a[2], b[4];
#pragma unroll
            for (int i = 0; i < 2; ++i) a[i] = *(const GAS long*)(a0 + (size_t)(16 * i) * K + 32 * ks);
#pragma unroll
            for (int j = 0; j < 4; ++j) b[j] = *(const GAS long*)(b0 + (size_t)(16 * j) * K + 32 * ks);
#pragma unroll
            for (int i = 0; i < 2; ++i)
#pragma unroll
                for (int j = 0; j < 4; ++j) acc[i][j] = __builtin_amdgcn_mfma_f32_16x16x32_fp8_fp8(a[i], b[j], acc[i][j], 0, 0, 0);
        }
        LAS float* red = (LAS float*)(F.lds + RING_OFF);
#pragma unroll
        for (int i = 0; i < 2; ++i)
#pragma unroll
            for (int j = 0; j < 4; ++j)
#pragma unroll
                for (int r = 0; r < 4; ++r) red[(wave * 32 + 16 * i + 4 * g + r) * 64 + 16 * j + m] = acc[i][j][r];
        LDS_WAIT(); __syncthreads();
        const int row = tid >> 4, c4 = (tid & 15) * 4;
        f32x4 s = (f32x4){0.f, 0.f, 0.f, 0.f};
#pragma unroll
        for (int w = 0; w < 8; ++w) s = s + *(const LAS f32x4*)(red + (w * 32 + row) * 64 + c4);
        s = s * oscale;
        v2u o; o.x = pk2(s.x, s.y); o.y = pk2(s.z, s.w);
        *(GAS v2u*)(C + (size_t)(32 * rm + row) * D + 64 * cn + c4) = o;
        LDS_WAIT(); __syncthreads();
    }
}
__device__ __forceinline__ void p1_mod(Frame& F) {
    const int gw = F.vcu * NWAVES + F.wave, NGW = F.G * NWAVES;
    const float* mod = (const float*)(F.ws + WS_MOD); bf16* XM = (bf16*)(F.ws + WS_XM);
    for (int m = gw; m < M; m += NGW) {
        const float* xr = m < MP ? F.a->in[0] + (size_t)m * D : F.a->in[1] + (size_t)(m - MP) * D;
        const float* ms = mod + (size_t)seq_of(m) * MODW;
#pragma unroll
        for (int j = 0; j < 4; ++j) { const int d = 4 * F.lane + 256 * j;
            const f32x4 v = *(const f32x4*)(xr + d), sh = *(const f32x4*)(ms + d), sc = *(const f32x4*)(ms + D + d);
            const f32x4 o = v * (sc + 1.0f) + sh;
            if (F8_FFN1) *(GAS unsigned*)((unsigned char*)XM + (size_t)m * D + d) = pg8::pk4_fp8(o.x, o.y, o.z, o.w);
            else { v2u w; w.x = pk2(o.x, o.y); w.y = pk2(o.z, o.w); *(GAS v2u*)(XM + (size_t)m * D + d) = w; } }
    }
}
template <int I, bool AB, int NR>
__device__ __forceinline__ void ln_rows(Frame& F, int m0, float yscale, LAS float* W8, const bf16* Y, bf16* XM) {
    const float* mod = (const float*)(F.ws + WS_MOD);
    const float* ms = mod + (size_t)seq_of(m0) * MODW + I * 3 * D;
    const int lane = F.lane;
    f32x4 gt[4], lg[4], lb[4], sh[4], sc[4];
#pragma unroll
    for (int j = 0; j < 4; ++j) { const int d = 4 * lane + 256 * j;
        gt[j] = *(const f32x4*)(ms + 2 * D + d) * yscale; lg[j] = *(const f32x4*)(F.a->in[9] + I * D + d); lb[j] = *(const f32x4*)(F.a->in[10] + I * D + d);
        if (I < 2) { sh[j] = *(const f32x4*)(ms + 3 * D + d); sc[j] = *(const f32x4*)(ms + 4 * D + d) + 1.0f; } }
    f32x4 xn[4]; v2u yn[4];
#define LN_LOAD(m_) do { \
        if (I == 0) { const float* xr_ = (m_) < MP ? F.a->in[0] + (size_t)(m_) * D : F.a->in[1] + (size_t)((m_) - MP) * D; \
            _Pragma("unroll") for (int j = 0; j < 4; ++j) xn[j] = *(const f32x4*)(xr_ + 4 * lane + 256 * j); } \
        else { const bf16* xb_ = (I == 1 ? (const bf16*)F.out : (const bf16*)(F.ws + WS_X2B)) + (size_t)(m_) * D; \
            _Pragma("unroll") for (int j = 0; j < 4; ++j) { const v2u w_ = *(const GAS v2u*)(xb_ + 4 * lane + 256 * j); xn[j] = (f32x4){bf_lo(w_.x), bf_hi(w_.x), bf_lo(w_.y), bf_hi(w_.y)}; } } \
        _Pragma("unroll") for (int j = 0; j < 4; ++j) yn[j] = *(const GAS v2u*)(Y + (size_t)(m_) * D + 4 * lane + 256 * j); } while (0)
    LN_LOAD(m0);
#pragma unroll 1
    for (int i = 0; i < NR; ++i) {
        const int m = m0 + i;
        f32x4 v[4]; float s = 0.f;
#pragma unroll
        for (int j = 0; j < 4; ++j) { const f32x4 y = (f32x4){bf_lo(yn[j].x), bf_hi(yn[j].x), bf_lo(yn[j].y), bf_hi(yn[j].y)};
            v[j] = xn[j] * ALPHA + gt[j] * y; s += (v[j].x + v[j].y) + (v[j].z + v[j].w); }
        if (i + 1 < NR) LN_LOAD(m + 1);
        const float mean = wave_sum(s) * (1.f / D); float s2 = 0.f;
#pragma unroll
        for (int j = 0; j < 4; ++j) { v[j] = v[j] - mean; s2 += (v[j].x * v[j].x + v[j].y * v[j].y) + (v[j].z * v[j].z + v[j].w * v[j].w); }
        const float rstd = 1.f / sqrtf(wave_sum(s2) * (1.f / D) + LN_EPS);
        f32x4 uu[4];
#pragma unroll
        for (int j = 0; j < 4; ++j) { const int d = 4 * lane + 256 * j;
            const f32x4 o = v[j] * rstd * lg[j] + lb[j];
            if (I == 2) *(f32x4*)(F.out + (size_t)m * D + d) = o;
            else { v2u ow; ow.x = pk2(o.x, o.y); ow.y = pk2(o.z, o.w); *(GAS v2u*)((I == 0 ? (bf16*)F.out : (bf16*)(F.ws + WS_X2B)) + (size_t)m * D + d) = ow; }
            if (I < 2) { const f32x4 u = o * sc[j] + sh[j];
                if (I == 1 && F8_FFN2) *(GAS unsigned*)((unsigned char*)XM + (size_t)m * D + d) = pg8::pk4_fp8(u.x, u.y, u.z, u.w);
                else { v2u w; w.x = pk2(u.x, u.y); w.y = pk2(u.z, u.w); *(GAS v2u*)(XM + (size_t)m * D + d) = w; }
                uu[j] = u; }
        }
        if (AB) {
            float pa[8];
#pragma unroll
            for (int q = 0; q < 8; ++q) { typedef float f32x2s __attribute__((ext_vector_type(2))); f32x2s a2 = {0.f, 0.f};
#pragma unroll
                for (int j = 0; j < 4; ++j) { const f32x4 wv = *(const LAS f32x4*)(W8 + q * D + 4 * lane + 256 * j);
                    a2 = a2 + (f32x2s){uu[j].x, uu[j].y} * (f32x2s){wv.x, wv.y}; a2 = a2 + (f32x2s){uu[j].z, uu[j].w} * (f32x2s){wv.z, wv.w}; }
                float a_ = a2.x + a2.y;
                asm volatile("" : "+v"(a_));
                pa[q] = a_; }
            float p4[4], p2[2];
#pragma unroll
            for (int q = 0; q < 4; ++q) { const float keep = (lane & 1) ? pa[q + 4] : pa[q], give = (lane & 1) ? pa[q] : pa[q + 4]; p4[q] = keep + __shfl_xor(give, 1); }
#pragma unroll
            for (int q = 0; q < 2; ++q) { const float keep = (lane & 2) ? p4[q + 2] : p4[q], give = (lane & 2) ? p4[q] : p4[q + 2]; p2[q] = keep + __shfl_xor(give, 2); }
            float p1; { const float keep = (lane & 4) ? p2[1] : p2[0], give = (lane & 4) ? p2[0] : p2[1]; p1 = keep + __shfl_xor(give, 4); }
            p1 += __shfl_xor(p1, 8); p1 += __shfl_xor(p1, 16); p1 += __shfl_xor(p1, 32);
            if (lane < 8) { const int q = 4 * (lane & 1) + 2 * ((lane >> 1) & 1) + ((lane >> 2) & 1), h = q & 3;
                float* GB = (float*)(F.ws + WS_GB);
                if (q < 4) { const float z = p1 + F.a->in[20][h]; const float sp = z > 20.f ? z : log1pf(__expf(z)); GB[(size_t)m * 4 + h] = -__expf(F.a->in[19][h]) * sp; }
                else GB[(size_t)M * 4 + (size_t)m * 4 + h] = 1.f / (1.f + __expf(-p1)); }
        }
    }
#undef LN_LOAD
}
template <int I, bool AB = (I == 0)>
__device__ __forceinline__ void ln_pass(Frame& F, float yscale) {
    const int gw = F.vcu * NWAVES + F.wave, NGW = F.G * NWAVES;
    LAS float* W8 = (LAS float*)(F.lds + RING_OFF);
    if (AB) {
        for (int e = F.tid; e < 8 * D; e += NWAVES * 64) { const int d = e >> 3, j = e & 7; W8[j * D + d] = F.a->in[17][(size_t)d * PROJ + QKV + j]; }
        LDS_WAIT(); __syncthreads();
    }
    for (int m0 = 8 * gw; m0 < MP; m0 += 8 * NGW) ln_rows<I, AB, 8>(F, m0, yscale, W8, (const bf16*)(F.ws + WS_Y), (bf16*)(F.ws + WS_XM));
    for (int m = MP + gw; m < M; m += NGW) ln_rows<I, AB, 1>(F, m, yscale, W8, (const bf16*)(F.ws + WS_Y), (bf16*)(F.ws + WS_XM));
    if (AB) { LDS_WAIT(); __syncthreads(); }
}

constexpr size_t WS_YS = WS_HP + (size_t)M * NIN * 2;
template <int I>
__device__ __forceinline__ void ln_sample(Frame& F, float yscale, bf16* XMbase) {
    const int gw = F.vcu * NWAVES + F.wave, NGW = F.G * NWAVES;
    for (int m = MP + gw; m < M; m += NGW) ln_rows<I, false, 1>(F, m, yscale, nullptr, (const bf16*)(F.ws + WS_YS) - (size_t)MP * D, XMbase);
}

__device__ __forceinline__ void ab_rows(Frame& F, int first_wg) {
    LAS float* W8 = (LAS float*)(F.lds + RING_OFF);
    for (int e = F.tid; e < 8 * D; e += NWAVES * 64) { const int d = e >> 3, j = e & 7; W8[j * D + d] = F.a->in[17][(size_t)d * PROJ + QKV + j]; }
    LDS_WAIT(); __syncthreads();
    const int gw = ((int)blockIdx.x - first_wg) * NWAVES + F.wave, ngw = (F.G - first_wg) * NWAVES, lane = F.lane;
    const bf16* XM = (const bf16*)(F.ws + WS_XM); float* GB = (float*)(F.ws + WS_GB);
    for (int m = gw; m < M; m += ngw) {
        const v4u x0 = *(const GAS v4u*)(XM + (size_t)m * D + 8 * lane), x1 = *(const GAS v4u*)(XM + (size_t)m * D + 512 + 8 * lane);
        float u[16];
        u[0] = bf_lo(x0.x); u[1] = bf_hi(x0.x); u[2] = bf_lo(x0.y); u[3] = bf_hi(x0.y); u[4] = bf_lo(x0.z); u[5] = bf_hi(x0.z); u[6] = bf_lo(x0.w); u[7] = bf_hi(x0.w);
        u[8] = bf_lo(x1.x); u[9] = bf_hi(x1.x); u[10] = bf_lo(x1.y); u[11] = bf_hi(x1.y); u[12] = bf_lo(x1.z); u[13] = bf_hi(x1.z); u[14] = bf_lo(x1.w); u[15] = bf_hi(x1.w);
        float pa[8];
#pragma unroll
        for (int q = 0; q < 8; ++q) { const LAS float* w = W8 + q * D + 8 * lane;
            const f32x4 w0 = *(const LAS f32x4*)w, w1 = *(const LAS f32x4*)(w + 4), w2 = *(const LAS f32x4*)(w + 512), w3 = *(const LAS f32x4*)(w + 516);
            float a_ = (u[0] * w0.x + u[1] * w0.y) + (u[2] * w0.z + u[3] * w0.w) + (u[4] * w1.x + u[5] * w1.y) + (u[6] * w1.z + u[7] * w1.w)
                     + (u[8] * w2.x + u[9] * w2.y) + (u[10] * w2.z + u[11] * w2.w) + (u[12] * w3.x + u[13] * w3.y) + (u[14] * w3.z + u[15] * w3.w);
            asm volatile("" : "+v"(a_));
            pa[q] = a_; }
        float p4[4], p2[2];
#pragma unroll
        for (int q = 0; q < 4; ++q) { const float keep = (lane & 1) ? pa[q + 4] : pa[q], give = (lane & 1) ? pa[q] : pa[q + 4]; p4[q] = keep + __shfl_xor(give, 1); }
#pragma unroll
        for (int q = 0; q < 2; ++q) { const float keep = (lane & 2) ? p4[q + 2] : p4[q], give = (lane & 2) ? p4[q] : p4[q + 2]; p2[q] = keep + __shfl_xor(give, 2); }
        float p1; { const float keep = (lane & 4) ? p2[1] : p2[0], give = (lane & 4) ? p2[0] : p2[1]; p1 = keep + __shfl_xor(give, 4); }
        p1 += __shfl_xor(p1, 8); p1 += __shfl_xor(p1, 16); p1 += __shfl_xor(p1, 32);
        if (lane < 8) { const int q = 4 * (lane & 1) + 2 * ((lane >> 1) & 1) + ((lane >> 2) & 1), h = q & 3;
            if (q < 4) { const float z = p1 + F.a->in[20][h]; const float sp = z > 20.f ? z : log1pf(__expf(z)); GB[(size_t)m * 4 + h] = -__expf(F.a->in[19][h]) * sp; }
            else GB[(size_t)M * 4 + (size_t)m * 4 + h] = 1.f / (1.f + __expf(-p1)); }
    }
    LDS_WAIT(); __syncthreads();
}
constexpr int PQ_LD = 1536, PR_LD = 2048, PR_OG = 0, PR_SB = 512, PR_SC = 1024, PR_SH = 1536;
constexpr size_t WS_PQ = WS_HP, WS_PR = WS_HP + (size_t)M * PQ_LD * 2, WS_TAIL = WS_HP + (size_t)M * NIN * 2;
constexpr size_t FRB_AW = WS_Y, FRB_AQD = WS_Y + 16 * MiB;
constexpr size_t FRB_AQK = WS_TAIL, FRB_U = WS_TAIL + 8 * MiB, FRB_GL = WS_GL;
constexpr size_t FRB_SH = WS_PQ;
static_assert(FRB_AQD + 16 * MiB <= WS_HP && FRB_U + 16 * MiB <= WS_XCH && WS_XCH + 3 * 512 * KiB <= WS_END && (size_t)32 * MiB <= (size_t)MP * PQ_LD * 2, "fragment map");
constexpr size_t FRB_AKD = WS_W2U;
static_assert(FRB_AKD + 16 * MiB <= WS_WIN, "AKD inside the FFN2 weight region");
__device__ __forceinline__ unsigned char* fr_akd(const Frame& F) { return F.ws + FRB_AKD; }

__device__ __forceinline__ void unpack8(const v4u w, float (&f)[8]) {
    f[0] = bf_lo(w.x); f[1] = bf_hi(w.x); f[2] = bf_lo(w.y); f[3] = bf_hi(w.y); f[4] = bf_lo(w.z); f[5] = bf_hi(w.z); f[6] = bf_lo(w.w); f[7] = bf_hi(w.w);
}
__device__ __forceinline__ void d1_unit(Frame& F, int ci) {
    constexpr int RAW = 0, RAWS = 768, KBI = 0, KHI = 17408, QHI = 34816, IMS = 272, VB = 52224, KG = 84992, SC = 117760, CW = 118784;
    constexpr int LM = 0, QKI = 17408, QKS = 136, WIM = 34816;
    const int bh = ci >> 5, n = ci & 31, b = bh >> 2, h = bh & 3, row0 = b * T + 64 * n;
    int tid_l = F.tid; asm volatile("" : "+v"(tid_l));
    const int tid = tid_l, lane = tid & 63, wave = F.wave;
    LAS unsigned char* L = F.lds;
    LAS float* SCf = (LAS float*)(L + SC);
    LAS float* CWf = (LAS float*)(L + CW);
    const bf16* P = (const bf16*)(F.ws + WS_PQ);
    const float* GB = (const float*)(F.ws + WS_GB);
    {
        v4u rv[7]; float cwv[3];
#pragma unroll
        for (int it = 0; it < 7; ++it) { const int p = tid + 512 * it, r = p / 48, q = p % 48, part = q >> 4, c8 = q & 15, tok = r - 3;
            rv[it] = (v4u){0u, 0u, 0u, 0u};
            if (p < 67 * 48 && (n > 0 || tok >= 0)) rv[it] = *(const GAS v4u*)(P + (size_t)(row0 + tok) * PQ_LD + part * 512 + h * 128 + c8 * 8); }
#pragma unroll
        for (int it = 0; it < 3; ++it) { const int e = tid + 512 * it, i = e / 384, q = e % 384; cwv[it] = F.a->in[18][i * QKV + (q >> 7) * 512 + h * 128 + (q & 127)]; }
#pragma unroll
        for (int it = 0; it < 7; ++it) { const int p = tid + 512 * it, r = p / 48, q = p % 48; if (p < 67 * 48) *(LAS v4u*)(L + RAW + r * RAWS + q * 16) = rv[it]; }
        if (n == 31) {
#pragma unroll
            for (int it = 6; it < 7; ++it) { const int p = tid + 512 * it, r = p / 48, q = p % 48, part = q >> 4, c8 = q & 15;
                if (p < 67 * 48 && r >= 64) { float x[8]; unpack8(rv[it], x); float* cq = F.out + O_CQ_P + ((size_t)b * 3 + (r - 64)) * QKV + part * 512 + h * 128 + c8 * 8;
                    *(f32x4*)cq = (f32x4){x[0], x[1], x[2], x[3]}; *(f32x4*)(cq + 4) = (f32x4){x[4], x[5], x[6], x[7]}; } }
        }
#pragma unroll
        for (int it = 0; it < 3; ++it) CWf[tid + 512 * it] = cwv[it];
    }
    if (wave == 0) {
        const float gv = GB[(size_t)(row0 + lane) * 4 + h], bt = GB[(size_t)M * 4 + (size_t)(row0 + lane) * 4 + h];
        float gc = gv;
#pragma unroll
        for (int o = 1; o < 64; o <<= 1) { const float t = __shfl_up(gc, o); if (lane >= o) gc += t; }
        const float glast = __shfl(gc, 63);
        SCf[lane] = gc; SCf[64 + lane] = bt; SCf[128 + lane] = __expf(gc); SCf[192 + lane] = __expf(glast - gc);
        if (lane == 0) ((float*)(F.ws + FRB_GL))[ci] = __expf(glast);
    }
    LDS_WAIT(); __syncthreads();
    const int tok = tid >> 3, sub = tid & 7;
    float val[6][8];
#pragma unroll
    for (int i = 0; i < 6; ++i) { const int cg = (i >> 1) * 16 + (i & 1) * 8 + sub;
        float a[8];
#pragma unroll
        for (int e = 0; e < 8; ++e) a[e] = 0.f;
#pragma unroll
        for (int tap = 0; tap < 4; ++tap) { float x[8]; unpack8(*(const LAS v4u*)(L + RAW + (tok + tap) * RAWS + cg * 16), x);
            const f32x4 w0 = *(const LAS f32x4*)(CWf + tap * 384 + cg * 8), w1 = *(const LAS f32x4*)(CWf + tap * 384 + cg * 8 + 4);
            a[0] += x[0] * w0.x; a[1] += x[1] * w0.y; a[2] += x[2] * w0.z; a[3] += x[3] * w0.w; a[4] += x[4] * w1.x; a[5] += x[5] * w1.y; a[6] += x[6] * w1.z; a[7] += x[7] * w1.w; }
#pragma unroll
        for (int e = 0; e < 8; ++e) val[i][e] = silu_f(a[e]); }
    float sq = 0.f, sk = 0.f;
#pragma unroll
    for (int e = 0; e < 8; ++e) { sq += val[0][e] * val[0][e] + val[1][e] * val[1][e]; sk += val[2][e] * val[2][e] + val[3][e] * val[3][e]; }
#define D1_DPP(v_, ctrl_) __builtin_bit_cast(float, __builtin_amdgcn_update_dpp(0, __builtin_bit_cast(int, v_), ctrl_, 0xF, 0xF, false))
    sq += D1_DPP(sq, 0xB1); sk += D1_DPP(sk, 0xB1); sq += D1_DPP(sq, 0x4E); sk += D1_DPP(sk, 0x4E); sq += D1_DPP(sq, 0x141); sk += D1_DPP(sk, 0x141);
#undef D1_DPP
    const float rq = rsqrtf(sq + 1e-6f) * 0.08838834764831845f, rk = rsqrtf(sk + 1e-6f);
    const float bt = SCf[64 + tok], egt = SCf[128 + tok];
    LDS_WAIT(); __syncthreads();
    unsigned char* AQD = F.ws + FRB_AQD + (size_t)ci * 16384;
#pragma unroll
    for (int i = 0; i < 2; ++i) { const int dk0 = (i * 8 + sub) * 8;
        float q[8];
#pragma unroll
        for (int e = 0; e < 8; ++e) q[e] = val[i][e] * rq;
        v4u w; w.x = pk2(q[0], q[1]); w.y = pk2(q[2], q[3]); w.z = pk2(q[4], q[5]); w.w = pk2(q[6], q[7]);
        *(LAS v4u*)(L + QHI + tok * IMS + dk0 * 2) = w;
        const int s = dk0 >> 5, jh = (dk0 >> 4) & 1, g2 = (dk0 >> 3) & 1, mt = tok >> 4, m = tok & 15;
#pragma unroll
        for (int half = 0; half < 2; ++half) { const int g = 2 * g2 + half;
            v2u o; o.x = pk2(q[4 * half] * egt, q[4 * half + 1] * egt); o.y = pk2(q[4 * half + 2] * egt, q[4 * half + 3] * egt);
            *(GAS v2u*)(AQD + ((size_t)((mt * 4 + s) * 64 + m + 16 * g) * 8 + 4 * jh) * 2) = o; } }
#pragma unroll
    for (int i = 0; i < 2; ++i) { const int dk0 = (i * 8 + sub) * 8;
        float k[8];
#pragma unroll
        for (int e = 0; e < 8; ++e) k[e] = val[2 + i][e] * rk;
        v4u w; w.x = pk2(k[0], k[1]); w.y = pk2(k[2], k[3]); w.z = pk2(k[4], k[5]); w.w = pk2(k[6], k[7]);
        *(LAS v4u*)(L + KHI + tok * IMS + dk0 * 2) = w;
        v4u wb; wb.x = pk2(k[0] * bt, k[1] * bt); wb.y = pk2(k[2] * bt, k[3] * bt); wb.z = pk2(k[4] * bt, k[5] * bt); wb.w = pk2(k[6] * bt, k[7] * bt);
        *(LAS v4u*)(L + KBI + tok * IMS + dk0 * 2) = wb;
        const float f = bt * egt;
        *(LAS f32x4*)(L + KG + tok * 512 + dk0 * 4) = (f32x4){k[0] * f, k[1] * f, k[2] * f, k[3] * f};
        *(LAS f32x4*)(L + KG + tok * 512 + dk0 * 4 + 16) = (f32x4){k[4] * f, k[5] * f, k[6] * f, k[7] * f}; }
#pragma unroll
    for (int i = 0; i < 2; ++i) { const int dv0 = (i * 8 + sub) * 8;
        *(LAS f32x4*)(L + VB + tok * 512 + dv0 * 4) = (f32x4){val[4 + i][0] * bt, val[4 + i][1] * bt, val[4 + i][2] * bt, val[4 + i][3] * bt};
        *(LAS f32x4*)(L + VB + tok * 512 + dv0 * 4 + 16) = (f32x4){val[4 + i][4] * bt, val[4 + i][5] * bt, val[4 + i][6] * bt, val[4 + i][7] * bt}; }
    LDS_WAIT(); __syncthreads();
    const int kind = wave >> 2, ti = wave & 3, m16 = lane & 15, g4 = lane >> 4;
    f32x4 acc[4];
#pragma unroll
    for (int tj = 0; tj < 4; ++tj) acc[tj] = (f32x4){0.f, 0.f, 0.f, 0.f};
#pragma unroll
    for (int s = 0; s < 4; ++s) {
        const bf16x8 A = *(const LAS bf16x8*)(L + (kind == 0 ? KBI : QHI) + (16 * ti + m16) * IMS + (32 * s + 8 * g4) * 2);
#pragma unroll
        for (int tj = 0; tj < 4; ++tj) if (tj <= ti) {
            const bf16x8 B = *(const LAS bf16x8*)(L + KHI + (16 * tj + m16) * IMS + (32 * s + 8 * g4) * 2);
            acc[tj] = __builtin_amdgcn_mfma_f32_16x16x32_bf16(A, B, acc[tj], 0, 0, 0); }
    }
    {
        unsigned char* AKD = fr_akd(F) + (size_t)ci * 16384;
#pragma unroll
        for (int rep = 0; rep < 2; ++rep) { const int lf = tid + 512 * rep, frag = lf >> 6, ln = lf & 63, Tt = frag >> 1, s2 = frag & 1, m = ln & 15, g = ln >> 4;
            float kd[8];
#pragma unroll
            for (int j = 0; j < 8; ++j) { const int tk = 32 * s2 + 16 * (j >> 2) + 4 * g + (j & 3);
                const unsigned short hv = *(const LAS unsigned short*)(L + KHI + tk * IMS + (16 * Tt + m) * 2);
                kd[j] = __builtin_bit_cast(float, (unsigned)hv << 16) * SCf[192 + tk]; }
            v4u o; o.x = pk2(kd[0], kd[1]); o.y = pk2(kd[2], kd[3]); o.z = pk2(kd[4], kd[5]); o.w = pk2(kd[6], kd[7]);
            *(GAS v4u*)(AKD + (size_t)lf * 16) = o; }
    }
    LDS_WAIT(); __syncthreads();
#pragma unroll
    for (int tj = 0; tj < 4; ++tj)
#pragma unroll
        for (int r = 0; r < 4; ++r) { const int i = 16 * ti + 4 * g4 + r, j = 16 * tj + m16;
            const float dec = (tj <= ti && i >= j) ? __expf(SCf[i] - SCf[j]) : 0.f;
            const float v = (tj <= ti) ? acc[tj][r] * dec : 0.f;
            if (kind == 0) { if (tj <= ti) *(LAS float*)(L + LM + ((i >> 2) * 64 + j) * 16 + (i & 3) * 4) = (i > j) ? v : 0.f; }
            else *(LAS unsigned short*)(L + QKI + i * QKS + j * 2) = (unsigned short)f2bf(v); }
    LDS_WAIT(); __syncthreads();
    if (wave < 4) {
        const int c = tid;
        const LAS unsigned char* rhsp = L + (c < 128 ? VB : KG) + (c & 127) * 4;
        typedef float f32x2s __attribute__((ext_vector_type(2)));
        float x[64];
#pragma unroll
        for (int blk = 0; blk < 16; ++blk) { const int i0 = 4 * blk;
            f32x2s sa, sb;
            sa.x = *(const LAS float*)(rhsp + (i0 + 0) * 512); sa.y = *(const LAS float*)(rhsp + (i0 + 1) * 512);
            sb.x = *(const LAS float*)(rhsp + (i0 + 2) * 512); sb.y = *(const LAS float*)(rhsp + (i0 + 3) * 512);
            f32x2s ta = {0.f, 0.f}, tb = {0.f, 0.f};
#pragma unroll
            for (int jb = 0; jb < i0; jb += 16) {
                f32x4 l[16];
#pragma unroll
                for (int q = 0; q < 16; ++q) if (jb + q < i0) l[q] = *(const LAS f32x4*)(L + LM + (blk * 64 + jb + q) * 16);
                __builtin_amdgcn_sched_barrier(0);
#pragma unroll
                for (int q = 0; q < 16; q += 2) if (jb + q < i0) {
                    sa = sa - (f32x2s){l[q].x, l[q].y} * x[jb + q]; sb = sb - (f32x2s){l[q].z, l[q].w} * x[jb + q];
                    ta = ta - (f32x2s){l[q + 1].x, l[q + 1].y} * x[jb + q + 1]; tb = tb - (f32x2s){l[q + 1].z, l[q + 1].w} * x[jb + q + 1]; }
            }
            sa = sa + ta; sb = sb + tb;
            const f32x4 d0 = *(const LAS f32x4*)(L + LM + (blk * 64 + i0) * 16), d1 = *(const LAS f32x4*)(L + LM + (blk * 64 + i0 + 1) * 16), d2 = *(const LAS f32x4*)(L + LM + (blk * 64 + i0 + 2) * 16);
            x[i0] = sa.x;
            x[i0 + 1] = sa.y - d0.y * x[i0];
            sb = sb - (f32x2s){d0.z, d0.w} * x[i0];
            sb = sb - (f32x2s){d1.z, d1.w} * x[i0 + 1];
            x[i0 + 2] = sb.x;
            x[i0 + 3] = sb.y - d2.w * x[i0 + 2];
        }
        if (c < 128) {
            unsigned char* U = F.ws + FRB_U + (size_t)ci * 16384 + (size_t)(c >> 4) * 2048;
#pragma unroll
            for (int mt = 0; mt < 4; ++mt)
#pragma unroll
                for (int g = 0; g < 4; ++g) { const int t0 = 16 * mt + 4 * g; v2u o; o.x = pk2(x[t0], x[t0 + 1]); o.y = pk2(x[t0 + 2], x[t0 + 3]);
                    *(GAS v2u*)(U + (size_t)(mt * 64 + (c & 15) + 16 * g) * 8) = o; }
        } else {
            const int dk = c - 128;
#pragma unroll
            for (int i = 0; i < 64; ++i) *(LAS unsigned short*)(L + WIM + i * IMS + dk * 2) = (unsigned short)f2bf(x[i]);
        }
    } else {
        unsigned char* AQK = F.ws + FRB_AQK + (size_t)ci * 8192;
#pragma unroll
        for (int rep = 0; rep < 2; ++rep) { const int lf = (tid - 256) + 256 * rep, frag = lf >> 6, ln = lf & 63, mt = frag >> 1, s2 = frag & 1, m = ln & 15, g = ln >> 4;
            const v2u a = *(const LAS v2u*)(L + QKI + (16 * mt + m) * QKS + (32 * s2 + 4 * g) * 2);
            const v2u bq = *(const LAS v2u*)(L + QKI + (16 * mt + m) * QKS + (32 * s2 + 16 + 4 * g) * 2);
            *(GAS v4u*)(AQK + (size_t)lf * 16) = (v4u){a.x, a.y, bq.x, bq.y}; }
    }
    LDS_WAIT(); __syncthreads();
    {
        unsigned char* AW = F.ws + FRB_AW + (size_t)ci * 16384;
#pragma unroll
        for (int rep = 0; rep < 2; ++rep) { const int lf = tid + 512 * rep, frag = lf >> 6, ln = lf & 63, mt = frag >> 2, s = frag & 3, m = ln & 15, g = ln >> 4;
            const v2u a = *(const LAS v2u*)(L + WIM + (16 * mt + m) * IMS + (32 * s + 4 * g) * 2);
            const v2u bq = *(const LAS v2u*)(L + WIM + (16 * mt + m) * IMS + (32 * s + 16 + 4 * g) * 2);
            *(GAS v4u*)(AW + (size_t)lf * 16) = (v4u){a.x, a.y, bq.x, bq.y}; }
    }
    LDS_WAIT(); __syncthreads();
}
template <int ABL = 0>
__device__ __forceinline__ void scan_phase(Frame& F) {
    if ((int)blockIdx.x >= 64) return;
    constexpr int BUFB = 40960;
    const int unit = (int)blockIdx.x, bh = unit & 31, half = unit >> 5, lane = F.lane, wave = F.wave;
    LAS unsigned char* L = F.lds;
    if (wave >= 4) {
        __builtin_amdgcn_s_setprio(3);
        const int lw = wave - 4;
        const unsigned char* src[10];
#pragma unroll
        for (int i = 0; i < 10; ++i) { const int p = 10 * lw + i;
            src[i] = (p < 16 ? F.ws + FRB_AW + (size_t)p * 1024 : p < 32 ? fr_akd(F) + (size_t)(p - 16) * 1024 : F.ws + FRB_U + (size_t)half * 8192 + (size_t)(p - 32) * 1024) + (size_t)bh * 32 * 16384 + lane * 16; }
#define SCAN_ISSUE(c_, buf_) do { _Pragma("unroll") for (int i_ = 0; i_ < 10; ++i_) \
            __builtin_amdgcn_global_load_lds((const unsigned*)(src[i_] + (size_t)(c_) * 16384), (LAS unsigned*)(L + (buf_) * BUFB + (10 * lw + i_) * 1024), 16, 0, 0); } while (0)
        if (!(ABL & 8)) { SCAN_ISSUE(0, 0); SCAN_ISSUE(1, 1); }
        int nb = 2;
        for (int n = 0; n < 32; ++n) {
            if (!(ABL & 8)) asm volatile("s_waitcnt vmcnt(10)" ::: "memory");
            __builtin_amdgcn_s_barrier();
            asm volatile("" ::: "memory");
            const int c = n + 2 < 32 ? n + 2 : 31;
            if (!(ABL & 8)) SCAN_ISSUE(c, nb); nb = nb == 2 ? 0 : nb + 1;
        }
        asm volatile("s_waitcnt vmcnt(0)" ::: "memory");
#undef SCAN_ISSUE
    } else {
        const int dvl = lane & 15, g = lane >> 4, sl = 4 * half + wave;
        const float* GL = (const float*)(F.ws + FRB_GL) + bh * 32;
        unsigned char* SH = F.ws + FRB_SH + ((size_t)bh * 32 * 8 + sl) * 4096 + lane * 16;
        f32x4 St[8];
#pragma unroll
        for (int t = 0; t < 8; ++t) St[t] = (f32x4){0.f, 0.f, 0.f, 0.f};
        const float glv = __hip_atomic_load(GL + (lane & 31), __ATOMIC_RELAXED, __HIP_MEMORY_SCOPE_AGENT);
        int cb = 0;
        for (int n = 0; n < 32; ++n) {
            const float gl = __builtin_bit_cast(float, __builtin_amdgcn_readlane(__builtin_bit_cast(int, glv), n));
            v4u Bw[4];
#pragma unroll
            for (int s = 0; s < 4; ++s) { Bw[s].x = pk2(St[2 * s][0], St[2 * s][1]); Bw[s].y = pk2(St[2 * s][2], St[2 * s][3]); Bw[s].z = pk2(St[2 * s + 1][0], St[2 * s + 1][1]); Bw[s].w = pk2(St[2 * s + 1][2], St[2 * s + 1][3]);
                if (ABL & 1) asm volatile("" :: "v"(Bw[s])); else *(GAS v4u*)(SH + (size_t)n * 32768 + s * 1024) = Bw[s]; }
            __builtin_amdgcn_s_barrier();
            asm volatile("" ::: "memory");
            const LAS unsigned char* B = L + cb * BUFB + lane * 16;
            f32x4 accA[4];
#pragma unroll
            for (int mt = 0; mt < 4; ++mt) accA[mt] = (f32x4){0.f, 0.f, 0.f, 0.f};
#pragma unroll
            for (int s = 0; s < 4; ++s)
#pragma unroll
                for (int mt = 0; mt < 4; ++mt) accA[mt] = __builtin_amdgcn_mfma_f32_16x16x32_bf16(*(const LAS bf16x8*)(B + (mt * 4 + s) * 1024), __builtin_bit_cast(bf16x8, Bw[s]), accA[mt], 0, 0, 0);
            f32x4 vn[4];
#pragma unroll
            for (int mt = 0; mt < 4; ++mt) { const v2u uw = *(const LAS v2u*)(L + cb * BUFB + 32768 + wave * 2048 + (mt * 64 + lane) * 8);
                vn[mt] = (f32x4){bf_lo(uw.x), bf_hi(uw.x), bf_lo(uw.y), bf_hi(uw.y)} - accA[mt]; }
            bf16x8 Bv[2];
#pragma unroll
            for (int s2 = 0; s2 < 2; ++s2) { v4u w; w.x = pk2(vn[2 * s2][0], vn[2 * s2][1]); w.y = pk2(vn[2 * s2][2], vn[2 * s2][3]); w.z = pk2(vn[2 * s2 + 1][0], vn[2 * s2 + 1][1]); w.w = pk2(vn[2 * s2 + 1][2], vn[2 * s2 + 1][3]);
                Bv[s2] = __builtin_bit_cast(bf16x8, w); }
#pragma unroll
            for (int t = 0; t < 8; ++t) St[t] = St[t] * gl;
#pragma unroll
            for (int s2 = 0; s2 < 2; ++s2)
#pragma unroll
                for (int t = 0; t < 8; ++t) St[t] = __builtin_amdgcn_mfma_f32_16x16x32_bf16(*(const LAS bf16x8*)(B + 16384 + (t * 2 + s2) * 1024), Bv[s2], St[t], 0, 0, 0);
            cb = cb == 2 ? 0 : cb + 1;
        }
        float* So = F.out + O_SSM_P + (size_t)bh * 128 * 128;
#pragma unroll
        for (int t = 0; t < 8; ++t)
#pragma unroll
            for (int r = 0; r < 4; ++r) So[(size_t)(16 * t + 4 * g + r) * 128 + 16 * sl + dvl] = St[t][r];
    }
}
__device__ __forceinline__ float dpp_add(float v, const int ctrl_sel) {
    const int iv = __builtin_bit_cast(int, v); int o;
    if (ctrl_sel == 0) o = __builtin_amdgcn_update_dpp(0, iv, 0xB1, 0xF, 0xF, true);
    else if (ctrl_sel == 1) o = __builtin_amdgcn_update_dpp(0, iv, 0x4E, 0xF, 0xF, true);
    else if (ctrl_sel == 2) o = __builtin_amdgcn_update_dpp(0, iv, 0x141, 0xF, 0xF, true);
    else o = __builtin_amdgcn_update_dpp(0, iv, 0x140, 0xF, 0xF, true);
    return v + __builtin_bit_cast(float, o);
}
__device__ __forceinline__ f32x4 row16_sum4(f32x4 v) {
#pragma unroll
    for (int st = 0; st < 4; ++st) { v.x = dpp_add(v.x, st); v.y = dpp_add(v.y, st); v.z = dpp_add(v.z, st); v.w = dpp_add(v.w, st); }
    return v;
}
template <int ABL = 0>
__device__ __forceinline__ void d3_phase(Frame& F) {
    constexpr int BUFB = 57344, RED = 114688;
    int tid_l = F.tid; asm volatile("" : "+v"(tid_l));
    const int lane = tid_l & 63, wave = F.wave, dvl = lane & 15, g = lane >> 4;
    LAS unsigned char* L = F.lds;
    LAS float* red = (LAS float*)(L + RED);
    bf16* MIX = (bf16*)(F.ws + WS_XM); const bf16* PR = (const bf16*)(F.ws + WS_PR);
    const float gdn = F.a->in[21][16 * wave + dvl];
    const int nk = (1024 - (int)blockIdx.x + F.G - 1) / F.G;
#define D3_ISSUE(ci_, buf_) do { _Pragma("unroll") for (int i_ = 0; i_ < 7; ++i_) { const int p_ = 7 * wave + i_; \
            const unsigned char* s_ = (p_ < 16 ? F.ws + FRB_AW + (size_t)(ci_) * 16384 + (size_t)p_ * 1024 : p_ < 32 ? F.ws + FRB_AQD + (size_t)(ci_) * 16384 + (size_t)(p_ - 16) * 1024 : \
                                       p_ < 40 ? F.ws + FRB_AQK + (size_t)(ci_) * 8192 + (size_t)(p_ - 32) * 1024 : F.ws + FRB_U + (size_t)(ci_) * 16384 + (size_t)(p_ - 40) * 1024) + lane * 16; \
            __builtin_amdgcn_global_load_lds((const unsigned*)s_, (LAS unsigned*)(L + (buf_) * BUFB + p_ * 1024), 16, 0, 0); } } while (0)
#define D3_LOADS(ci_, dst_) do { const unsigned char* sh_ = F.ws + FRB_SH + ((size_t)(ci_) * 8 + wave) * 4096 + lane * 16; \
            _Pragma("unroll") for (int s_ = 0; s_ < 4; ++s_) dst_[s_] = *(const GAS v4u*)(sh_ + s_ * 1024); } while (0)
#define D3_OG(ci_) do { const int bh_ = (ci_) >> 5, n_ = (ci_) & 31, r0_ = (bh_ >> 2) * T + 64 * n_, h_ = bh_ & 3; \
            _Pragma("unroll") for (int mt_ = 0; mt_ < 4; ++mt_) _Pragma("unroll") for (int r_ = 0; r_ < 4; ++r_) ogn[mt_][r_] = PR[(size_t)(r0_ + 16 * mt_ + 4 * g + r_) * PR_LD + PR_OG + h_ * 128 + 16 * wave + dvl]; } while (0)
    v4u Bn[4]; unsigned short ogn[4][4];
    if (nk > 0) { if (!(ABL & 8)) D3_ISSUE((int)blockIdx.x, 0); D3_LOADS((int)blockIdx.x, Bn); D3_OG((int)blockIdx.x); }
    for (int k = 0; k < nk; ++k) {
        const int ci = (int)blockIdx.x + k * F.G, bh = ci >> 5, n = ci & 31, b = bh >> 2, h = bh & 3, row0 = b * T + 64 * n;
        asm volatile("s_waitcnt vmcnt(0)" ::: "memory");
        __builtin_amdgcn_s_barrier();
        asm volatile("" ::: "memory");
        v4u Bw[4];
#pragma unroll
        for (int s = 0; s < 4; ++s) Bw[s] = Bn[s];
        if (k + 1 < nk) { if (!(ABL & 8)) D3_ISSUE(ci + F.G, (k + 1) & 1); if (!(ABL & 16)) D3_LOADS(ci + F.G, Bn); }
        unsigned short ogv[4][4];
#pragma unroll
        for (int mt = 0; mt < 4; ++mt)
#pragma unroll
            for (int r = 0; r < 4; ++r) ogv[mt][r] = ogn[mt][r];
        if (k + 1 < nk) D3_OG(ci + F.G);
        const LAS unsigned char* B = L + (k & 1) * BUFB + lane * 16;
        f32x4 accA[4], accO[4];
#pragma unroll
        for (int mt = 0; mt < 4; ++mt) { accA[mt] = (f32x4){0.f, 0.f, 0.f, 0.f}; accO[mt] = (f32x4){0.f, 0.f, 0.f, 0.f};
#pragma unroll
            for (int s = 0; s < 4; ++s) { accA[mt] = __builtin_amdgcn_mfma_f32_16x16x32_bf16(*(const LAS bf16x8*)(B + (mt * 4 + s) * 1024), __builtin_bit_cast(bf16x8, Bw[s]), accA[mt], 0, 0, 0);
                accO[mt] = __builtin_amdgcn_mfma_f32_16x16x32_bf16(*(const LAS bf16x8*)(B + 16384 + (mt * 4 + s) * 1024), __builtin_bit_cast(bf16x8, Bw[s]), accO[mt], 0, 0, 0); } }
        f32x4 vn[4];
#pragma unroll
        for (int mt = 0; mt < 4; ++mt) { const v2u uw = *(const LAS v2u*)(L + (k & 1) * BUFB + 40960 + wave * 2048 + (mt * 64 + lane) * 8);
            vn[mt] = (f32x4){bf_lo(uw.x), bf_hi(uw.x), bf_lo(uw.y), bf_hi(uw.y)} - accA[mt]; }
        bf16x8 Bv[2];
#pragma unroll
        for (int s2 = 0; s2 < 2; ++s2) { v4u w; w.x = pk2(vn[2 * s2][0], vn[2 * s2][1]); w.y = pk2(vn[2 * s2][2], vn[2 * s2][3]); w.z = pk2(vn[2 * s2 + 1][0], vn[2 * s2 + 1][1]); w.w = pk2(vn[2 * s2 + 1][2], vn[2 * s2 + 1][3]);
            Bv[s2] = __builtin_bit_cast(bf16x8, w); }
#pragma unroll
        for (int mt = 0; mt < 4; ++mt)
#pragma unroll
            for (int s2 = 0; s2 < 2; ++s2) accO[mt] = __builtin_amdgcn_mfma_f32_16x16x32_bf16(*(const LAS bf16x8*)(B + 32768 + (mt * 2 + s2) * 1024), Bv[s2], accO[mt], 0, 0, 0);
#pragma unroll
        for (int mt = 0; mt < 4; ++mt) { f32x4 ss = accO[mt] * accO[mt];
            ss = row16_sum4(ss);
            if (dvl == 0) *(LAS f32x4*)(red + wave * 64 + 16 * mt + 4 * g) = ss; }
        asm volatile("s_waitcnt lgkmcnt(0)" ::: "memory"); __builtin_amdgcn_s_barrier(); asm volatile("" ::: "memory");
        f32x4 tot[4];
#pragma unroll
        for (int mt = 0; mt < 4; ++mt) { f32x4 pr[8];
#pragma unroll
            for (int w = 0; w < 8; ++w) pr[w] = *(const LAS f32x4*)(red + w * 64 + 16 * mt + 4 * g);
            tot[mt] = ((pr[0] + pr[1]) + (pr[2] + pr[3])) + ((pr[4] + pr[5]) + (pr[6] + pr[7])); }
#pragma unroll
        for (int mt = 0; mt < 4; ++mt)
#pragma unroll
            for (int r = 0; r < 4; ++r) { const int tk = 16 * mt + 4 * g + r;
                const float rn = rsqrtf(tot[mt][r] * (1.f / 128.f) + 1e-6f);
                const float ogf = __builtin_bit_cast(float, (unsigned)ogv[mt][r] << 16);
                const unsigned ov = pk2(accO[mt][r] * rn * gdn * silu_f(ogf), 0.f) & 0xffffu;
                if (ABL & 1) asm volatile("" :: "v"(ov)); else MIX[(size_t)(row0 + tk) * D + h * 128 + 16 * wave + dvl] = (bf16)ov; }
    }
    asm volatile("s_waitcnt vmcnt(0) lgkmcnt(0)" ::: "memory"); __builtin_amdgcn_s_barrier();
#undef D3_ISSUE
#undef D3_LOADS
#undef D3_OG
}
__device__ __forceinline__ void sc_rows(Frame& F, int first_wg) {
    const int gw = ((int)blockIdx.x - first_wg) * NWAVES + F.wave, NGW = (F.G - first_wg) * NWAVES, lane = F.lane;
    if (gw < 0) return;
    bf16* MIX = (bf16*)(F.ws + WS_XM); const bf16* PR = (const bf16*)(F.ws + WS_PR);
    f32x4 w0[3], w1[3];
#pragma unroll
    for (int i = 0; i < 3; ++i) { w0[i] = *(const f32x4*)(F.a->in[22] + i * 512 + lane * 8); w1[i] = *(const f32x4*)(F.a->in[22] + i * 512 + lane * 8 + 4); }
    for (int m = gw; m < M; m += NGW) {
        const bool prm = m < MP; const int t = prm ? (m & (T - 1)) : ((m - MP) & 3), sq = prm ? (m >> 11) : ((m - MP) >> 2);
        v4u cw[3], hw[3]; f32x4 sa[2], sbq[2];
#pragma unroll
        for (int i = 0; i < 3; ++i) { const int tt = t - 2 + i; cw[i] = (v4u){0u, 0u, 0u, 0u}; hw[i] = cw[i];
            if (tt >= 0) { cw[i] = *(const GAS v4u*)(PR + (size_t)(m - 2 + i) * PR_LD + PR_SC + lane * 8); hw[i] = *(const GAS v4u*)(PR + (size_t)(m - 2 + i) * PR_LD + PR_SH + lane * 8); } }
        const v4u sbw = *(const GAS v4u*)(PR + (size_t)m * PR_LD + PR_SB + lane * 8);
        if (!prm && t < 2) {
#pragma unroll
            for (int i = 0; i < 2; ++i) { sa[i] = (f32x4){0.f, 0.f, 0.f, 0.f}; sbq[i] = sa[i];
                if (t - 2 + i < 0) { const float* sb = F.a->in[4] + ((size_t)sq * 2 + (t + i)) * 512 + lane * 8; sa[i] = *(const f32x4*)sb; sbq[i] = *(const f32x4*)(sb + 4); } } }
        float zc[8], z2[8];
#pragma unroll
        for (int e = 0; e < 8; ++e) zc[e] = 0.f;
#pragma unroll
        for (int i = 0; i < 3; ++i) { const int tt = t - 2 + i; float z[8];
            if (tt >= 0) { float c[8], hh[8]; unpack8(cw[i], c); unpack8(hw[i], hh);
#pragma unroll
                for (int e = 0; e < 8; ++e) z[e] = c[e] * hh[e]; }
            else if (!prm && i < 2) { z[0] = sa[i].x; z[1] = sa[i].y; z[2] = sa[i].z; z[3] = sa[i].w; z[4] = sbq[i].x; z[5] = sbq[i].y; z[6] = sbq[i].z; z[7] = sbq[i].w; }
            else {
#pragma unroll
                for (int e = 0; e < 8; ++e) z[e] = 0.f; }
            zc[0] += z[0] * w0[i].x; zc[1] += z[1] * w0[i].y; zc[2] += z[2] * w0[i].z; zc[3] += z[3] * w0[i].w; zc[4] += z[4] * w1[i].x; zc[5] += z[5] * w1[i].y; zc[6] += z[6] * w1[i].z; zc[7] += z[7] * w1[i].w;
            if (i == 2) {
#pragma unroll
                for (int e = 0; e < 8; ++e) z2[e] = z[e]; }
        }
        float sb[8]; unpack8(sbw, sb);
        *(GAS v4u*)(MIX + (size_t)m * D + 512 + lane * 8) = (v4u){pk2(sb[0] * zc[0], sb[1] * zc[1]), pk2(sb[2] * zc[2], sb[3] * zc[3]), pk2(sb[4] * zc[4], sb[5] * zc[5]), pk2(sb[6] * zc[6], sb[7] * zc[7])};
        const int Tg = prm ? T : TS;
        if (t >= Tg - 2) { float* cm = F.out + (prm ? O_CM_P : O_CM_S) + ((size_t)sq * 2 + (t - (Tg - 2))) * 512 + lane * 8;
            *(f32x4*)cm = (f32x4){z2[0], z2[1], z2[2], z2[3]}; *(f32x4*)(cm + 4) = (f32x4){z2[4], z2[5], z2[6], z2[7]}; }
    }
}
__device__ __forceinline__ void p8_sample_unit(Frame& F, int unit) {
    int tid_l = F.tid; asm volatile("" : "+v"(tid_l));
    const int sq = unit >> 2, h = unit & 3, tid = tid_l, lane = tid & 63, wave = F.wave;
    LAS float* Lf = (LAS float*)F.lds;
    LAS float* QKV_ = Lf;
    LAS float* RED = Lf + 1536;
    LAS float* SCAL = Lf + 2048;
    LAS float* OB = Lf + 2080;
    const bf16* P = (const bf16*)(F.ws + WS_PQ); const bf16* PR = (const bf16*)(F.ws + WS_PR); const float* GB = (const float*)(F.ws + WS_GB);
    const int m0 = MP + 4 * sq;
    const int kq = tid >> 7, dv = tid & 127;
    float S[32];
    const float* S0 = F.a->in[2] + ((size_t)(sq * 4 + h) * 128 + 32 * kq) * 128 + dv;
#pragma unroll
    for (int i = 0; i < 32; ++i) S[i] = S0[(size_t)i * 128];
    float decv[4], btv[4];
#pragma unroll
    for (int t = 0; t < 4; ++t) { decv[t] = GB[(size_t)(m0 + t) * 4 + h]; btv[t] = GB[(size_t)M * 4 + (size_t)(m0 + t) * 4 + h]; }
    if (tid < 384) { const int part = tid >> 7, ch = tid & 127, c = part * 512 + h * 128 + ch;
        float xp[7];
#pragma unroll
        for (int i = 0; i < 3; ++i) xp[i] = F.a->in[3][((size_t)sq * 3 + i) * QKV + c];
#pragma unroll
        for (int t = 0; t < 4; ++t) xp[3 + t] = __builtin_bit_cast(float, (unsigned)P[(size_t)(m0 + t) * PQ_LD + c] << 16);
#pragma unroll
        for (int t = 1; t < 4; ++t) F.out[O_CQ_S + ((size_t)sq * 3 + (t - 1)) * QKV + c] = xp[3 + t];
        const float w0 = F.a->in[18][c], w1 = F.a->in[18][QKV + c], w2 = F.a->in[18][2 * QKV + c], w3 = F.a->in[18][3 * QKV + c];
#pragma unroll
        for (int t = 0; t < 4; ++t) QKV_[(part * 4 + t) * 128 + ch] = silu_f(xp[t] * w0 + xp[t + 1] * w1 + xp[t + 2] * w2 + xp[t + 3] * w3); }
    LDS_WAIT(); __syncthreads();
    {
        const int part = wave >> 2, t = wave & 3; const float a = QKV_[(part * 4 + t) * 128 + lane], bq = QKV_[(part * 4 + t) * 128 + 64 + lane];
        const float ss = wave_sum(a * a + bq * bq); const float rn = rsqrtf(ss + 1e-6f) * (part == 0 ? 0.08838834764831845f : 1.0f);
        QKV_[(part * 4 + t) * 128 + lane] = a * rn; QKV_[(part * 4 + t) * 128 + 64 + lane] = bq * rn; }
    LDS_WAIT(); __syncthreads();
#pragma unroll
    for (int t = 0; t < 4; ++t) {
        const float dec = __expf(decv[t]), bt = btv[t];
        const LAS float* qv = QKV_ + (0 * 4 + t) * 128 + 32 * kq; const LAS float* kv = QKV_ + (1 * 4 + t) * 128 + 32 * kq;
        float ks = 0.f;
#pragma unroll
        for (int i = 0; i < 32; ++i) { S[i] *= dec; ks += kv[i] * S[i]; }
        RED[kq * 128 + dv] = ks;
        LDS_WAIT(); __syncthreads();
        const float kS = (RED[dv] + RED[128 + dv]) + (RED[256 + dv] + RED[384 + dv]);
        const float vn = bt * (QKV_[(2 * 4 + t) * 128 + dv] - kS);
        float o = 0.f;
#pragma unroll
        for (int i = 0; i < 32; ++i) { S[i] += kv[i] * vn; o += qv[i] * S[i]; }
        LDS_WAIT(); __syncthreads();
        RED[kq * 128 + dv] = o;
        LDS_WAIT(); __syncthreads();
        if (kq == 0) OB[t * 128 + dv] = (RED[dv] + RED[128 + dv]) + (RED[256 + dv] + RED[384 + dv]);
        LDS_WAIT(); __syncthreads();
    }
    float* So = F.out + O_SSM_S + ((size_t)(sq * 4 + h) * 128 + 32 * kq) * 128 + dv;
#pragma unroll
    for (int i = 0; i < 32; ++i) So[(size_t)i * 128] = S[i];
    if (wave < 4) { const int t = wave; const float a = OB[t * 128 + lane], bq = OB[t * 128 + 64 + lane];
        const float rn = rsqrtf(wave_sum(a * a + bq * bq) * (1.f / 128.f) + 1e-6f);
        bf16* MIX = (bf16*)(F.ws + WS_XM);
        const float og0 = __builtin_bit_cast(float, (unsigned)PR[(size_t)(m0 + t) * PR_LD + PR_OG + h * 128 + lane] << 16), og1 = __builtin_bit_cast(float, (unsigned)PR[(size_t)(m0 + t) * PR_LD + PR_OG + h * 128 + 64 + lane] << 16);
        MIX[(size_t)(m0 + t) * D + h * 128 + lane] = (bf16)f2bf(a * rn * F.a->in[21][lane] * silu_f(og0));
        MIX[(size_t)(m0 + t) * D + h * 128 + 64 + lane] = (bf16)f2bf(bq * rn * F.a->in[21][64 + lane] * silu_f(og1)); }
    LDS_WAIT(); __syncthreads();
}
__device__ __forceinline__ int opaque_i(int v) { asm volatile("" : "+v"(v)); return __builtin_amdgcn_readfirstlane(v); }
constexpr int N_PHASES = 14;
__global__ void __launch_bounds__(NWAVES * 64, 2) mk_fwd(Args args) {
    extern __shared__ __attribute__((aligned(16))) unsigned char lds[];
    Frame F;
    F.lds = (LAS unsigned char*)lds;
    F.MISC = (volatile LAS unsigned*)(F.lds + MISC_OFF);
    F.tid = threadIdx.x; F.lane = F.tid & 63; F.wave = __builtin_amdgcn_readfirstlane(F.tid >> 6);
    F.G = gridDim.x; { const int bx = blockIdx.x; F.vcu = (F.G % 8 == 0) ? (bx % 8) * (F.G / 8) + bx / 8 : bx; }
    F.a = &args;
    F.out = args.out; F.ws = args.ws;
    F.ctl = (gu32*)(F.ws + WS_CTL);
    for (int u = F.tid; u < (LDS_BYTES - LDSCTL_OFF) / 4; u += NWAVES * 64) ((LAS unsigned*)(F.lds + LDSCTL_OFF))[u] = 0u;
    __syncthreads();
    XcdBarrier bar = xcd_barrier_post((unsigned*)(F.ctl + CW_BAR), F.MISC + 8);
    xcd_barrier_census(bar);
    constexpr int lo = 0, hi = N_PHASES;
#ifndef PHASE_MASK
#define PHASE_MASK 0xFFFFF
#endif
#define IN(k) (((PHASE_MASK >> (k)) & 1) && lo <= (k) && (k) < hi)
#ifndef REP_MASK
#define REP_MASK 0
#endif
#ifndef GEMM_ALIGN
#define GEMM_ALIGN true
#endif
#ifndef GEMM_SP2
#define GEMM_SP2 true
#endif
#ifndef SCAN_ABL
#define SCAN_ABL 0
#endif
#ifndef D3_ABL
#define D3_ABL 0
#endif
#ifndef REP_SUB
#define REP_SUB 0
#endif
#define FRESH() do { int t_ = threadIdx.x; asm volatile("" : "+v"(t_)); F.tid = t_; F.lane = t_ & 63; } while (0)
#if REP_MASK
#define PHASE_BEGIN(k) _Pragma("unroll 1") for (int rep_ = 0; rep_ < 1 + ((REP_MASK >> (k)) & 1); ++rep_) { if (rep_) xcd_barrier(bar); FRESH();
#else
#define PHASE_BEGIN(k) if (IN(k)) { const int rep_ = 0; (void)rep_; FRESH();
#endif
#define PHASE_END(k) } if (IN(k) && IN((k) + 1)) xcd_barrier(bar);
    bf16* const XM = (bf16*)(F.ws + WS_XM); bf16* const Yb = (bf16*)(F.ws + WS_Y); bf16* const HB = (bf16*)(F.ws + WS_HP);

    PHASE_BEGIN(0) p0_ada(F); convert_items(F, CV_W1U, CV_W1D, F.vcu * NWAVES + F.wave, F.G * NWAVES); PHASE_END(0)
    PHASE_BEGIN(1) p1_mod(F); PHASE_END(1)
    PHASE_BEGIN(2)
        pg8::StaticOrder S; S.init(M, NUP, F.G, (int)blockIdx.x);
#if F8_FFN1
        { pg8::Gemm g{XM, (const bf16*)(F.ws + WS_W1U), M, NUP, D / 2}; pg8::EpiSwiglu8 E{(unsigned char*)HB, FF};
          pg8::gemm_phase<pg8::EpiSwiglu8, pg8::StaticOrder, GEMM_ALIGN, GEMM_SP2, 127 - F8_UP_SH>(F.lds + RING_OFF, g, S, E); }
#else
        { pg8::Gemm g{XM, (const bf16*)(F.ws + WS_W1U), M, NUP, D}; pg8::EpiSwiglu E{HB, FF};
          pg8::gemm_phase<pg8::EpiSwiglu, pg8::StaticOrder, GEMM_ALIGN, GEMM_SP2>(F.lds + RING_OFF, g, S, E); }
#endif
        { const int nfull = (M / 256) * (NUP / 256) - ((M / 256) * (NUP / 256) / F.G) * F.G;
          if ((int)blockIdx.x >= nfull) { LDS_WAIT(); __syncthreads(); convert_items(F, CV_W1D, CV_W2U, ((int)blockIdx.x - nfull) * NWAVES + F.wave, (F.G - nfull) * NWAVES); } } PHASE_END(2)
    PHASE_BEGIN(3)
        pg8::StaticOrder S; S.init(MP, D, F.G, (int)blockIdx.x);
        pg8::EpiBf16P E{Yb, D, 0, nullptr, 0};
#if F8_FFN1
        { pg8::Gemm g{HB, (const bf16*)(F.ws + WS_W1D), MP, D, FF / 2};
          pg8::gemm_phase<pg8::EpiBf16P, pg8::StaticOrder, true, true, 127 - F8_DN_SH>(F.lds + RING_OFF, g, S, E); }
        sample_gemm8<FF>(F, (const unsigned char*)HB + (size_t)MP * FF, F.ws + WS_W1D, Yb + (size_t)MP * D, 1.f / (1 << F8_DN_SH)); PHASE_END(3)
#else
        { pg8::Gemm g{HB, (const bf16*)(F.ws + WS_W1D), MP, D, FF};
          pg8::gemm_phase<pg8::EpiBf16P, pg8::StaticOrder, true, true>(F.lds + RING_OFF, g, S, E); }
        sample_gemm<FF>(F, HB + (size_t)MP * FF, (const bf16*)(F.ws + WS_W1D), Yb + (size_t)MP * D); PHASE_END(3)
#endif
    PHASE_BEGIN(4) ln_pass<0>(F, 0.5f); PHASE_END(4)
    PHASE_BEGIN(5)
        pg8::Gemm g{XM, (const bf16*)(F.ws + WS_WIN), M, NIN, D}; pg8::StaticOrder S; S.init(M, NIN, F.G, (int)blockIdx.x);
        pg8::EpiWin E{(bf16*)(F.ws + WS_PQ), (bf16*)(F.ws + WS_PR), (float*)(F.ws + WS_GB), F.a->in[19], F.a->in[20], M};
        pg8::gemm_phase<pg8::EpiWin, pg8::StaticOrder, true, true>(F.lds + RING_OFF, g, S, E); PHASE_END(5)
    PHASE_BEGIN(6) _Pragma("unroll 1") for (int ci = (int)blockIdx.x; ci < 1024; ci += F.G) d1_unit(F, ci); PHASE_END(6)
    PHASE_BEGIN(7) if (!(rep_ && (REP_SUB & 1))) { if (rep_) scan_phase<SCAN_ABL>(F); else scan_phase<0>(F); } if (!(rep_ && (REP_SUB & 2))) { sc_rows(F, 64); for (int u = (int)blockIdx.x - 64; u >= 0 && u < 4 * NS; u += F.G - 64) p8_sample_unit(F, u); } PHASE_END(7)
    PHASE_BEGIN(8) if (!(rep_ && (REP_SUB & 1))) { if (rep_) d3_phase<D3_ABL>(F); else d3_phase<0>(F); } if (!(rep_ && (REP_SUB & 2))) { LDS_WAIT(); __syncthreads(); convert_items(F, CV_W2U, CV_END, F.vcu * NWAVES + F.wave, F.G * NWAVES); } PHASE_END(8)
    PHASE_BEGIN(9)
        pg8::Gemm g{XM, (const bf16*)(F.ws + WS_WOUT), MP, D, D}; pg8::StaticOrder S; S.init(MP, D, F.G, (int)blockIdx.x);
        pg8::EpiBf16P E{Yb, D, 0, nullptr, 0};
        pg8::gemm_phase<pg8::EpiBf16P, pg8::StaticOrder, true, true>(F.lds + RING_OFF, g, S, E);
        sample_gemm<D>(F, XM + (size_t)MP * D, (const bf16*)(F.ws + WS_WOUT), Yb + (size_t)MP * D); PHASE_END(9)
    PHASE_BEGIN(10) ln_pass<1>(F, 1.0f); PHASE_END(10)
    PHASE_BEGIN(11)
        pg8::StaticOrder S; S.init(M, NUP, F.G, (int)blockIdx.x);
#if F8_FFN2
        { pg8::Gemm g{XM, (const bf16*)(F.ws + WS_W2U), M, NUP, D / 2}; pg8::EpiSwiglu8 E{(unsigned char*)HB, FF};
          pg8::gemm_phase<pg8::EpiSwiglu8, pg8::StaticOrder, GEMM_ALIGN, GEMM_SP2, 127 - F8_UP_SH>(F.lds + RING_OFF, g, S, E); } PHASE_END(11)
#else
        { pg8::Gemm g{XM, (const bf16*)(F.ws + WS_W2U), M, NUP, D}; pg8::EpiSwiglu E{HB, FF};
          pg8::gemm_phase<pg8::EpiSwiglu, pg8::StaticOrder, GEMM_ALIGN, GEMM_SP2>(F.lds + RING_OFF, g, S, E); } PHASE_END(11)
#endif
    PHASE_BEGIN(12)
        pg8::StaticOrder S; S.init(MP, D, F.G, (int)blockIdx.x);
        pg8::EpiBf16P E{Yb, D, 0, nullptr, 0};
#if F8_FFN2
        { pg8::Gemm g{HB, (const bf16*)(F.ws + WS_W2D), MP, D, FF / 2};
          pg8::gemm_phase<pg8::EpiBf16P, pg8::StaticOrder, true, true, 127 - F8_DN_SH>(F.lds + RING_OFF, g, S, E); }
        sample_gemm8<FF>(F, (const unsigned char*)HB + (size_t)MP * FF, F.ws + WS_W2D, Yb + (size_t)MP * D, 1.f / (1 << F8_DN_SH)); PHASE_END(12)
#else
        { pg8::Gemm g{HB, (const bf16*)(F.ws + WS_W2D), MP, D, FF};
          pg8::gemm_phase<pg8::EpiBf16P, pg8::StaticOrder, true, true>(F.lds + RING_OFF, g, S, E); }
        sample_gemm<FF>(F, HB + (size_t)MP * FF, (const bf16*)(F.ws + WS_W2D), Yb + (size_t)MP * D); PHASE_END(12)
#endif
    PHASE_BEGIN(13) ln_pass<2>(F, 0.5f); PHASE_END(13)
#undef IN
#undef SEAM
}
extern "C" void kernel_launch(void* const* d_in, const int* in_sizes, int n_in, void* d_out, int out_size, void* d_ws, size_t ws_size, hipStream_t stream) {
    static int ok = 0;
    if (ok == 0) {
        int dev = 0, cus = 0;
        if (n_in != 24 || out_size != (int)O_END || ws_size < WS_END || hipGetDevice(&dev) != hipSuccess || hipDeviceGetAttribute(&cus, hipDeviceAttributeMultiprocessorCount, dev) != hipSuccess || cus < 256 ||
            hipFuncSetAttribute((const void*)mk_fwd, hipFuncAttributeMaxDynamicSharedMemorySize, LDS_BYTES) != hipSuccess) {
            fprintf(stderr, "kernel_launch: unexpected problem/device (n_in %d out %d ws %zu cus %d); nothing launched\n", n_in, out_size, ws_size, cus); ok = -1; return; }
        ok = 1;
    }
    if (ok < 0) return;
    (void)hipMemsetAsync((char*)d_ws + WS_CTL, 0, CTL_ZERO_BYTES, stream);
    Args a{};
    for (int i = 0; i < 24; ++i) a.in[i] = (const float*)d_in[i];
    a.out = (float*)d_out; a.ws = (unsigned char*)d_ws; a.ph_lo = 0; a.ph_hi = N_PHASES;
    hipLaunchKernelGGL(mk_fwd, dim3(256), dim3(NWAVES * 64), LDS_BYTES, stream, a);
}
```

```cpp
#include <hip/hip_runtime.h>
#include <cstdio>
#include <cstdint>
namespace pg8 {
#define PG8_LAS __attribute__((address_space(3)))
typedef unsigned short bf16_t;
typedef short bf16x8 __attribute__((ext_vector_type(8)));
typedef float f32x4 __attribute__((ext_vector_type(4)));
typedef unsigned u32x4 __attribute__((ext_vector_type(4)));
constexpr int BM = 256, BK = 64, HALF = 128, HTB = HALF * BK * 2  , STAGE_BYTES = 8 * HTB, NXCD = 8, WGM = 8;

__host__ __device__ __forceinline__ int lds_byte(int r, int c) { const int st = (r >> 4) * 2 + (c >> 5), rr = r & 15, cc = c & 31, ob = rr * 64 + cc * 2; return st * 1024 + (ob ^ (((ob >> 9) & 1) << 5)); }
__host__ __device__ __forceinline__ void stage_rc(int b, int& R, int& C) { const int st = b / 1024, sb = b % 1024, swz = sb ^ (((sb >> 9) & 1) << 5); R = (st >> 1) * 16 + swz / 64; C = (st & 1) * 32 + (swz % 64) / 2; }
__host__ __device__ __forceinline__ int perm32(int rho) { const int n = rho >> 4, i = rho & 15; return 8 * (i >> 2) + 4 * n + (i & 3); }

struct Unit { int pm, pn; };
struct Gemm { const bf16_t* A; const bf16_t* Bt; int M, N, K; };

struct StaticOrder {
    int nM, nN, nwg, G, c;
    __host__ __device__ void init(int M, int N, int G_, int c_) { nM = M / BM; nN = N / BM; nwg = nM * nN; G = G_; c = c_; }
    __host__ __device__ bool next(int i, Unit& u) const {
        const long L = (long)i * G + c; if (L >= nwg) return false;
        int wgid = (int)L; { const int q = nwg / NXCD, r = nwg % NXCD, xcd = wgid % NXCD, off = wgid / NXCD; wgid = (xcd < r ? xcd * (q + 1) : r * (q + 1) + (xcd - r) * q) + off; }
        const int nig = WGM * nN, gid = wgid / nig, fm = gid * WGM, gsz = (nM - fm) < WGM ? (nM - fm) : WGM;
        u.pm = fm + ((wgid % nig) % gsz); u.pn = (wgid % nig) / gsz; return true;
    }
    __device__ __forceinline__ void a_ready(const Unit&) const {}
    __device__ __forceinline__ void done(const Unit&) const {}
};

__device__ __forceinline__ unsigned cvt_pk_bf16(float lo, float hi) { unsigned r; asm volatile("v_cvt_pk_bf16_f32 %0, %1, %2" : "=v"(r) : "v"(lo), "v"(hi)); return r; }
typedef float f32x2 __attribute__((ext_vector_type(2)));
#ifndef EPI_X
#define EPI_X 0
#endif
struct EpiBf16P {
    static constexpr bool PERM = true, AFTER_DRAIN = false;
    bf16_t* O; int ldc; int split_pn; bf16_t* O2; int ldc2;
    __device__ __forceinline__ void operator()(const f32x4 (&acc)[2][2][4][2], const Unit& u, int wr, int wc, int fr, int fq) const {
        const bool second = split_pn > 0 && u.pn >= split_pn;
        bf16_t* const base = second ? O2 : O; const int ld = second ? ldc2 : ldc;
        const int row0 = u.pm * BM + wr * 64 + fr, col0 = (second ? u.pn - split_pn : u.pn) * BM + wc * 32 + 8 * fq;
#pragma unroll
        for (int ai = 0; ai < 2; ++ai)
#pragma unroll
            for (int m = 0; m < 4; ++m) { bf16_t* rowp = base + (size_t)(row0 + ai * HALF + m * 16) * ld + col0;
#pragma unroll
                for (int bj = 0; bj < 2; ++bj) { const f32x4 v0 = acc[ai][bj][m][0], v1 = acc[ai][bj][m][1];
                    u32x4 w; w.x = cvt_pk_bf16(v0[0], v0[1]); w.y = cvt_pk_bf16(v0[2], v0[3]); w.z = cvt_pk_bf16(v1[0], v1[1]); w.w = cvt_pk_bf16(v1[2], v1[3]);
                    *(u32x4*)(rowp + bj * HALF) = w; } }
    }
};
__device__ __forceinline__ unsigned pk4_fp8(float a, float b, float c, float d) { int r = __builtin_amdgcn_cvt_pk_fp8_f32(a, b, 0, false); r = __builtin_amdgcn_cvt_pk_fp8_f32(c, d, r, true); return (unsigned)r; }
struct EpiFp8P {
    static constexpr bool PERM = true, AFTER_DRAIN = false;
    unsigned char* O; int ldc;
    __device__ __forceinline__ void operator()(const f32x4 (&acc)[2][2][4][2], const Unit& u, int wr, int wc, int fr, int fq) const {
        const int row0 = u.pm * BM + wr * 64 + fr, col0 = u.pn * BM + wc * 32 + 8 * fq;
        typedef unsigned u32x2 __attribute__((ext_vector_type(2)));
#pragma unroll
        for (int ai = 0; ai < 2; ++ai)
#pragma unroll
            for (int m = 0; m < 4; ++m) { unsigned char* rowp = O + (size_t)(row0 + ai * HALF + m * 16) * ldc + col0;
#pragma unroll
                for (int bj = 0; bj < 2; ++bj) { const f32x4 v0 = acc[ai][bj][m][0], v1 = acc[ai][bj][m][1];
                    u32x2 w; w.x = pk4_fp8(v0[0], v0[1], v0[2], v0[3]); w.y = pk4_fp8(v1[0], v1[1], v1[2], v1[3]);
                    *(u32x2*)(rowp + bj * HALF) = w; } }
    }
};
__device__ __forceinline__ float swiglu1(float g, float u) { return g * u * __builtin_amdgcn_rcpf(1.0f + __builtin_amdgcn_exp2f(-1.4426950408889634f * g)); }
struct EpiSwiglu {
    static constexpr bool PERM = true, AFTER_DRAIN = false;
    bf16_t* O; int ldc;
    __device__ __forceinline__ void operator()(const f32x4 (&acc)[2][2][4][2], const Unit& u, int wr, int wc, int fr, int fq) const {
        const int row0 = u.pm * BM + wr * 64 + fr, col0 = u.pn * HALF + wc * 32 + 8 * fq;
#pragma unroll
        for (int ai = 0; ai < 2; ++ai)
#pragma unroll
            for (int m = 0; m < 4; ++m) { bf16_t* rowp = O + (size_t)(row0 + ai * HALF + m * 16) * ldc + col0;
                const f32x4 g0 = acc[ai][0][m][0], g1 = acc[ai][0][m][1], u0 = acc[ai][1][m][0], u1 = acc[ai][1][m][1];
                u32x4 w; w.x = cvt_pk_bf16(swiglu1(g0[0], u0[0]), swiglu1(g0[1], u0[1])); w.y = cvt_pk_bf16(swiglu1(g0[2], u0[2]), swiglu1(g0[3], u0[3]));
                w.z = cvt_pk_bf16(swiglu1(g1[0], u1[0]), swiglu1(g1[1], u1[1])); w.w = cvt_pk_bf16(swiglu1(g1[2], u1[2]), swiglu1(g1[3], u1[3]));
                *(u32x4*)rowp = w; }
    }
};


struct EpiSwiglu8 {
    static constexpr bool PERM = true, AFTER_DRAIN = false;
    unsigned char* O; int ldc;
    static __device__ __forceinline__ f32x2 sw2(float ga, float gb, float ua, float ub) {
        const f32x2 g = {ga, gb}, u = {ua, ub}; const f32x2 d = (f32x2){__builtin_amdgcn_exp2f(ga), __builtin_amdgcn_exp2f(gb)} + 1.0f;
        return (g * u) * (f32x2){__builtin_amdgcn_rcpf(d.x), __builtin_amdgcn_rcpf(d.y)}; }
    __device__ __forceinline__ void operator()(const f32x4 (&acc)[2][2][4][2], const Unit& u, int wr, int wc, int fr, int fq) const {
        const int row0 = u.pm * BM + wr * 64 + fr, col0 = u.pn * HALF + wc * 32 + 8 * fq;
#pragma unroll
        for (int ai = 0; ai < 2; ++ai)
#pragma unroll
            for (int m = 0; m < 4; ++m) { unsigned char* rowp = O + (size_t)(row0 + ai * HALF + m * 16) * ldc + col0;
                const f32x4 g0 = acc[ai][0][m][0], g1 = acc[ai][0][m][1], u0 = acc[ai][1][m][0], u1 = acc[ai][1][m][1];
                typedef unsigned u32x2 __attribute__((ext_vector_type(2)));
                const f32x2 h0 = sw2(g0[0], g0[1], u0[0], u0[1]), h1 = sw2(g0[2], g0[3], u0[2], u0[3]), h2 = sw2(g1[0], g1[1], u1[0], u1[1]), h3 = sw2(g1[2], g1[3], u1[2], u1[3]);
                u32x2 w; w.x = pk4_fp8(h0.x, h0.y, h1.x, h1.y); w.y = pk4_fp8(h2.x, h2.y, h3.x, h3.y);
                *(u32x2*)rowp = w; }
    }
};
struct PanelStats {
    unsigned* xbuf;
    unsigned* cnt;
    unsigned* tmo;
    int ntn; float eps;
    unsigned code;
    __device__ __forceinline__ bool run(const f32x4 (&v)[2][2][4][2], const Unit& u, int wr, int wc, int fr, int fq, PG8_LAS unsigned char* lds, int wid, int lane) const {
        typedef float f32x2v __attribute__((ext_vector_type(2)));
        PG8_LAS f32x2v* P = (PG8_LAS f32x2v*)lds;
        PG8_LAS f32x2v* S = (PG8_LAS f32x2v*)(lds + 8192);
        PG8_LAS unsigned* flag = (PG8_LAS unsigned*)(lds + 8192 + 2048);
#pragma unroll
        for (int ai = 0; ai < 2; ++ai)
#pragma unroll
            for (int m = 0; m < 4; ++m) {
                float s = 0.f;
#pragma unroll
                for (int bj = 0; bj < 2; ++bj)
#pragma unroll
                    for (int n = 0; n < 2; ++n) { const f32x4 x = v[ai][bj][m][n]; s += (x[0] + x[1]) + (x[2] + x[3]); }
                s += __shfl_xor(s, 16); s += __shfl_xor(s, 32);
                const float mw = s * (1.0f / 64.0f); float q = 0.f;
#pragma unroll
                for (int bj = 0; bj < 2; ++bj)
#pragma unroll
                    for (int n = 0; n < 2; ++n) { const f32x4 d = v[ai][bj][m][n] - mw; q += (d[0] * d[0] + d[1] * d[1]) + (d[2] * d[2] + d[3] * d[3]); }
                q += __shfl_xor(q, 16); q += __shfl_xor(q, 32);
                if (fq == 0) P[(ai * HALF + wr * 64 + m * 16 + fr) * 4 + wc] = (f32x2v){mw, q};
            }
        asm volatile("s_waitcnt lgkmcnt(0)" ::: "memory"); __builtin_amdgcn_s_barrier(); asm volatile("" ::: "memory");
#if defined(BROKEN_EXCHANGE_NO_WAIT)
#warning BROKEN CONTROL BUILD: the row-statistics exchange does not wait; results are wrong by design
        if (blockIdx.x >= 64) { const long long t0_ = clock64(); while (clock64() - t0_ < 60000) __builtin_amdgcn_s_sleep(8); }
#endif
        const int row = wid * 32 + (lane & 31);
        if (lane < 32) {
            const f32x2v a = P[row * 4 + 0], b = P[row * 4 + 1], c = P[row * 4 + 2], d = P[row * 4 + 3];
            const float mt = (a.x + b.x + c.x + d.x) * 0.25f;
            const float da = a.x - mt, db = b.x - mt, dc = c.x - mt, dd = d.x - mt;
            const float m2 = (a.y + b.y) + (c.y + d.y) + 64.0f * ((da * da + db * db) + (dc * dc + dd * dd));
            unsigned long long* slot = (unsigned long long*)xbuf + ((size_t)(u.pm * BM + row) * 4 + u.pn);
            __hip_atomic_store(slot, ((unsigned long long)__float_as_uint(m2) << 32) | __float_as_uint(mt), __ATOMIC_RELAXED, __HIP_MEMORY_SCOPE_AGENT);
        }
        asm volatile("s_waitcnt vmcnt(0)" ::: "memory");
        if (lane == 0) __hip_atomic_fetch_add(cnt + 64 * u.pm, 1u, __ATOMIC_RELAXED, __HIP_MEMORY_SCOPE_AGENT);
        if (wid == 0) {
            bool dead = false; const unsigned long long t0 = __builtin_amdgcn_s_memrealtime(); const unsigned want = 8u * (unsigned)ntn;
            for (;;) {
#if defined(BROKEN_EXCHANGE_NO_WAIT)
                break;
#endif
                if ((unsigned)__builtin_amdgcn_readfirstlane(__hip_atomic_load(cnt + 64 * u.pm, __ATOMIC_RELAXED, __HIP_MEMORY_SCOPE_AGENT)) >= want) break;
                if (__builtin_amdgcn_s_memrealtime() - t0 > 2000000ull) {
                    if (lane == 0) { unsigned expect = 0u; __hip_atomic_compare_exchange_strong(tmo + 1, &expect, code | (unsigned)(u.pm & 0xff), __ATOMIC_RELAXED, __ATOMIC_RELAXED, __HIP_MEMORY_SCOPE_AGENT);
                                     __hip_atomic_store(tmo, 1u, __ATOMIC_RELAXED, __HIP_MEMORY_SCOPE_AGENT); }
                    dead = true; break; }
                __builtin_amdgcn_s_sleep(2);
            }
            __builtin_amdgcn_fence(__ATOMIC_ACQUIRE, "agent");
            if (lane == 0) flag[0] = dead ? 1u : 0u;
        }
        asm volatile("s_waitcnt vmcnt(0) lgkmcnt(0)" ::: "memory"); __builtin_amdgcn_s_barrier(); asm volatile("" ::: "memory");
        const bool bad = flag[0] != 0u;
        if (lane < 32) {
            const unsigned long long* slot = (const unsigned long long*)xbuf + (size_t)(u.pm * BM + row) * 4; float mt[4], m2[4]; float ms = 0.f;
#pragma unroll
            for (int t = 0; t < 4; ++t) { if (t < ntn) { const unsigned long long w = __hip_atomic_load(slot + t, __ATOMIC_RELAXED, __HIP_MEMORY_SCOPE_AGENT); mt[t] = __uint_as_float((unsigned)w); m2[t] = __uint_as_float((unsigned)(w >> 32)); } else { mt[t] = 0.f; m2[t] = 0.f; } ms += mt[t]; }
            const float mean = ms / (float)ntn; float q = 0.f;
#pragma unroll
            for (int t = 0; t < 4; ++t) if (t < ntn) { const float dm = mt[t] - mean; q += m2[t] + 256.0f * dm * dm; }
            S[row] = (f32x2v){mean, 1.0f / sqrtf(q / (256.0f * (float)ntn) + eps)};
        }
        asm volatile("s_waitcnt lgkmcnt(0)" ::: "memory"); __builtin_amdgcn_s_barrier(); asm volatile("" ::: "memory");
        return bad;
    }
};

template <int I> struct EpiLnMod {
    static constexpr bool PERM = true, AFTER_DRAIN = true;
    const float* xin; float* out; bf16_t* xm; const float* mod; const float* lg; const float* lb; PanelStats st;
    static constexpr float yscale = (I == 1) ? 1.0f : 0.5f;
    __device__ __forceinline__ void fused(f32x4 (&acc)[2][2][4][2], const Unit& u, int wr, int wc, int fr, int fq, PG8_LAS unsigned char* lds, int wid, int lane) const {
        typedef float f32x2v __attribute__((ext_vector_type(2)));
        const PG8_LAS f32x2v* S = (const PG8_LAS f32x2v*)(lds + 8192);
        const int col0 = u.pn * BM + wc * 32 + 8 * fq;
        const float* ms = mod + (size_t)(u.pm >> 3) * 9216 + I * 3072;
        const float alpha = 1.189207115002721f;
        const unsigned loff = (unsigned)fr * 4096u + (unsigned)(u.pn * BM + wc * 32 + 8 * fq) * 4u;
#pragma unroll
        for (int bj = 0; bj < 2; ++bj)
#pragma unroll
            for (int n = 0; n < 2; ++n) { const f32x4 gt = *(const f32x4*)(ms + 2048 + col0 + bj * HALF + 4 * n) * yscale;
                f32x4 xv[2][4];
#pragma unroll
                for (int ai = 0; ai < 2; ++ai)
#pragma unroll
                    for (int m = 0; m < 4; ++m) {
                        const char* rb = (const char*)xin + (size_t)(u.pm * BM + ai * HALF + wr * 64 + m * 16) * 4096 + (bj * HALF + 4 * n) * 4;
                        xv[ai][m] = *(const f32x4*)(rb + loff); }
#pragma unroll
                for (int ai = 0; ai < 2; ++ai)
#pragma unroll
                    for (int m = 0; m < 4; ++m) { acc[ai][bj][m][n] = xv[ai][m] * alpha + gt * acc[ai][bj][m][n]; asm volatile("" : "+v"(acc[ai][bj][m][n])); }
                asm volatile("" ::: "memory");
            }
        const bool bad = st.run(acc, u, wr, wc, fr, fq, lds, wid, lane);
        const float qnan = __builtin_nanf("");
#pragma unroll
        for (int bj = 0; bj < 2; ++bj) {
            f32x4 g4[2], b4[2], sc4[2], sh4[2];
#pragma unroll
            for (int n = 0; n < 2; ++n) {
#if EPI_X & 2
                g4[n] = (f32x4){1.f, 1.f, 1.f, 1.f}; b4[n] = g4[n];
#else
                g4[n] = *(const f32x4*)(lg + col0 + bj * HALF + 4 * n); b4[n] = *(const f32x4*)(lb + col0 + bj * HALF + 4 * n);
#endif
                if (I < 2) { sh4[n] = *(const f32x4*)(ms + 3072 + col0 + bj * HALF + 4 * n); sc4[n] = *(const f32x4*)(ms + 4096 + col0 + bj * HALF + 4 * n) + 1.0f; } }
#pragma unroll
            for (int ai = 0; ai < 2; ++ai)
#pragma unroll
                for (int m = 0; m < 4; ++m) { const int r = ai * HALF + wr * 64 + m * 16 + fr; const f32x2v sr = S[r];
                    float* const outp = (float*)((char*)out + (size_t)(u.pm * BM + ai * HALF + wr * 64 + m * 16) * 4096 + bj * HALF * 4 + loff);
                    bf16_t* const xmp = (bf16_t*)((char*)xm + (size_t)(u.pm * BM + ai * HALF + wr * 64 + m * 16) * 2048 + bj * HALF * 2 + (loff >> 1));
                    f32x4 o0 = (acc[ai][bj][m][0] - sr.x) * sr.y * g4[0] + b4[0], o1 = (acc[ai][bj][m][1] - sr.x) * sr.y * g4[1] + b4[1];
                    if (bad) { o0 = (f32x4){qnan, qnan, qnan, qnan}; o1 = o0; }
                    *(f32x4*)outp = o0; *(f32x4*)(outp + 4) = o1;
                    if (I < 2) { const f32x4 u0 = o0 * sc4[0] + sh4[0], u1 = o1 * sc4[1] + sh4[1];
                        u32x4 w; w.x = cvt_pk_bf16(u0[0], u0[1]); w.y = cvt_pk_bf16(u0[2], u0[3]); w.z = cvt_pk_bf16(u1[0], u1[1]); w.w = cvt_pk_bf16(u1[2], u1[3]);
                        *(u32x4*)xmp = w; }
                    asm volatile("" ::: "memory"); }
            asm volatile("" ::: "memory");
        }
    }
};
struct EpiWin {
    static constexpr bool PERM = true, AFTER_DRAIN = false;
    bf16_t* PQ; bf16_t* PR; float* GB; const float* a_log; const float* dt_bias; int Mrows;
    __device__ __forceinline__ void operator()(const f32x4 (&acc)[2][2][4][2], const Unit& u, int wr, int wc, int fr, int fq) const {
        const int row0 = u.pm * BM + wr * 64 + fr;
        if (u.pn < 14) {
            const bool second = u.pn >= 6; bf16_t* const base = second ? PR : PQ; const int ld = second ? 2048 : 1536;
            const int col0 = (second ? u.pn - 6 : u.pn) * BM + wc * 32 + 8 * fq;
#pragma unroll
            for (int ai = 0; ai < 2; ++ai)
#pragma unroll
                for (int m = 0; m < 4; ++m) { bf16_t* rowp = base + (size_t)(row0 + ai * HALF + m * 16) * ld + col0;
#pragma unroll
                    for (int bj = 0; bj < 2; ++bj) { const f32x4 v0 = acc[ai][bj][m][0], v1 = acc[ai][bj][m][1];
                        u32x4 w; w.x = cvt_pk_bf16(v0[0], v0[1]); w.y = cvt_pk_bf16(v0[2], v0[3]); w.z = cvt_pk_bf16(v1[0], v1[1]); w.w = cvt_pk_bf16(v1[2], v1[3]);
                        *(u32x4*)(rowp + bj * HALF) = w; } }
        } else if (wc == 0 && fq == 0) {
            const f32x4 al = *(const f32x4*)a_log, dt = *(const f32x4*)dt_bias;
#pragma unroll
            for (int ai = 0; ai < 2; ++ai)
#pragma unroll
                for (int m = 0; m < 4; ++m) { const int row = row0 + ai * HALF + m * 16; const f32x4 a = acc[ai][0][m][0], b = acc[ai][0][m][1]; f32x4 gv, bv;
#pragma unroll
                    for (int h = 0; h < 4; ++h) { const float z = a[h] + dt[h]; const float sp = z > 20.f ? z : log1pf(__expf(z)); gv[h] = -__expf(al[h]) * sp; bv[h] = 1.f / (1.f + __expf(-b[h])); }
                    *(f32x4*)(GB + (size_t)row * 4) = gv; *(f32x4*)(GB + (size_t)Mrows * 4 + (size_t)row * 4) = bv; }
        }
    }
};
template <class Epi, class Sched, bool ALIGN_EPI = false, bool SP2 = false, int F8 = 0>
__device__ __forceinline__ void gemm_phase(PG8_LAS unsigned char* lds, const Gemm g, const Sched& S, const Epi& E) {
    int tid_l = threadIdx.x; asm volatile("" : "+v"(tid_l));
    const int tid = tid_l, wid = __builtin_amdgcn_readfirstlane(tid >> 6), lane = tid & 63, wr = wid >> 2, wc = wid & 3, fr = lane & 15, fq = lane >> 4;
    const int K = g.K, nt = K / BK;
    typedef int i32x4 __attribute__((ext_vector_type(4))); typedef int i32x8 __attribute__((ext_vector_type(8)));
    const int f8sw = F8 * 0x01010101, f8sa = 0x7F7F7F7F; (void)f8sw; (void)f8sa;
    unsigned voffA[2], voffB[2];
#pragma unroll
    for (int i = 0; i < 2; ++i) { int R, C; stage_rc(tid * 16 + i * 8192, R, C); const int Rb = Epi::PERM ? ((R & ~31) + perm32(R & 31)) : R;
        voffA[i] = (unsigned)(R * K + C) * 2u; voffB[i] = (unsigned)(Rb * K + C) * 2u; }
    const size_t kstep = (size_t)(BK * 2);
    const size_t hstep = (size_t)HALF * K * 2;
    const size_t tstep = 2 * hstep;
    const unsigned ldsw = (unsigned)wid * 1024u;
    const int aoff = lds_byte(wr * 64 + fr, fq * 8), boff = lds_byte(wc * 32 + fr, fq * 8);
#define PG8_SA(b, h) (((b) * 2 + (h)) * HTB)
#define PG8_SB(b, h) ((4 + (b) * 2 + (h)) * HTB)
#define PG8_STAGE(bufoff, gbase, voff) do { _Pragma("unroll") for (int _i = 0; _i < 2; ++_i) \
        __builtin_amdgcn_global_load_lds((const unsigned*)((const char*)(gbase) + (voff)[_i]), (PG8_LAS unsigned*)(lds + (bufoff) + ldsw + _i * 8192), 16, 0, 0); } while (0)
#define PG8_LDA(dst, b, h) do { _Pragma("unroll") for (int m = 0; m < 4; ++m) _Pragma("unroll") for (int k = 0; k < 2; ++k) dst[m][k] = *(const PG8_LAS bf16x8*)(lds + PG8_SA(b, h) + aoff + m * 2048 + k * 1024); } while (0)
#define PG8_LDB(dst, b, h) do { _Pragma("unroll") for (int n = 0; n < 2; ++n) _Pragma("unroll") for (int k = 0; k < 2; ++k) dst[n][k] = *(const PG8_LAS bf16x8*)(lds + PG8_SB(b, h) + boff + n * 2048 + k * 1024); } while (0)
#define PG8_CAT(lo, hi) __builtin_shufflevector(__builtin_bit_cast(i32x4, lo), __builtin_bit_cast(i32x4, hi), 0, 1, 2, 3, 4, 5, 6, 7)
#define PG8_MMA(ai, bj, At, Bt) do { __builtin_amdgcn_s_setprio(1); _Pragma("unroll") for (int m = 0; m < 4; ++m) _Pragma("unroll") for (int n = 0; n < 2; ++n) { \
        if constexpr (F8 != 0) { const i32x8 a8_ = PG8_CAT(Bt[n][0], Bt[n][1]), b8_ = PG8_CAT(At[m][0], At[m][1]); \
            asm volatile("v_mfma_scale_f32_16x16x128_f8f6f4 %0, %1, %2, %0, %3, %4 op_sel_hi:[0,0,0]" : "+v"(acc[ai][bj][m][n]) : "v"(a8_), "v"(b8_), "v"(f8sw), "v"(f8sa)); } \
        else { _Pragma("unroll") for (int k = 0; k < 2; ++k) acc[ai][bj][m][n] = __builtin_amdgcn_mfma_f32_16x16x32_bf16(Bt[n][k], At[m][k], acc[ai][bj][m][n], 0, 0, 0); } } __builtin_amdgcn_s_setprio(0); } while (0)
#define PG8_WAIT_V(n) asm volatile("s_waitcnt vmcnt(" #n ")" ::: "memory")
#define PG8_WAIT_L(n) asm volatile("s_waitcnt lgkmcnt(" #n ")" ::: "memory")
#define PG8_BAR __builtin_amdgcn_s_barrier()
#define PG8_SCHED __builtin_amdgcn_sched_barrier(0)
    Unit cur, nxt; int ui = 0;
    if (!S.next(0, cur)) return;
    f32x4 acc[2][2][4][2];
#pragma unroll
    for (int a = 0; a < 2; ++a)
#pragma unroll
        for (int b = 0; b < 2; ++b)
#pragma unroll
            for (int m = 0; m < 4; ++m)
#pragma unroll
                for (int n = 0; n < 2; ++n) acc[a][b][m][n] = (f32x4){0.f, 0.f, 0.f, 0.f};
    bf16x8 At[4][2], B0[2][2], B1[2][2];
    const char* cA = (const char*)g.A + (size_t)cur.pm * tstep; const char* cB = (const char*)g.Bt + (size_t)cur.pn * tstep;
    S.a_ready(cur);
    if constexpr (SP2) {
        PG8_STAGE(PG8_SB(0, 0), cB, voffB); PG8_STAGE(PG8_SB(0, 1), cB + hstep, voffB); PG8_STAGE(PG8_SA(0, 0), cA, voffA); PG8_STAGE(PG8_SA(0, 1), cA + hstep, voffA);
        if (wr == 1) PG8_BAR;
        PG8_WAIT_V(2); PG8_BAR;
        PG8_STAGE(PG8_SB(1, 0), cB + kstep, voffB); PG8_STAGE(PG8_SA(1, 0), cA + kstep, voffA); PG8_STAGE(PG8_SB(1, 1), cB + hstep + kstep, voffB);
        PG8_WAIT_V(6); PG8_BAR;
    } else {
        PG8_STAGE(PG8_SB(0, 0), cB, voffB); PG8_STAGE(PG8_SA(0, 0), cA, voffA); PG8_STAGE(PG8_SB(0, 1), cB + hstep, voffB); PG8_STAGE(PG8_SA(0, 1), cA + hstep, voffA);
        if (wr == 1) PG8_BAR;
        PG8_WAIT_V(4); PG8_BAR;
        PG8_STAGE(PG8_SB(1, 0), cB + kstep, voffB); PG8_STAGE(PG8_SA(1, 0), cA + kstep, voffA); PG8_STAGE(PG8_SB(1, 1), cB + hstep + kstep, voffB);
        PG8_WAIT_V(6); PG8_BAR;
    }
    for (;;) {
        const bool has_next = S.next(ui + 1, nxt);
        const char* nA = has_next ? (const char*)g.A + (size_t)nxt.pm * tstep : cA; const char* nB = has_next ? (const char*)g.Bt + (size_t)nxt.pn * tstep : cB;
#pragma unroll 1
        for (int t = 0; t < nt; t += 2) {
            const bool last = (t == nt - 2);
            const char* a1 = cA + (size_t)(t + 1) * kstep;
            const char* a2 = last ? nA : cA + (size_t)(t + 2) * kstep; const char* b2 = last ? nB : cB + (size_t)(t + 2) * kstep;
            const char* a3 = a2 + kstep; const char* b3 = b2 + kstep;
            if (last && has_next) S.a_ready(nxt);
            if constexpr (SP2) {
            PG8_LDB(B0, 0, 0); PG8_LDB(B1, 0, 1); PG8_SCHED; PG8_LDA(At, 0, 0); PG8_STAGE(PG8_SA(1, 1), a1 + hstep, voffA);
            PG8_WAIT_V(8); PG8_WAIT_L(0); PG8_BAR; PG8_MMA(0, 0, At, B0); PG8_MMA(0, 1, At, B1); PG8_BAR; PG8_SCHED;
            PG8_LDA(At, 0, 1); PG8_STAGE(PG8_SB(0, 0), b2, voffB); PG8_STAGE(PG8_SB(0, 1), b2 + hstep, voffB); PG8_STAGE(PG8_SA(0, 0), a2, voffA);
            PG8_WAIT_V(8); PG8_WAIT_L(0); PG8_BAR; PG8_MMA(1, 0, At, B0); PG8_MMA(1, 1, At, B1); PG8_BAR; PG8_SCHED;
            PG8_LDB(B0, 1, 0); PG8_LDB(B1, 1, 1); PG8_SCHED; PG8_LDA(At, 1, 0); PG8_STAGE(PG8_SA(0, 1), a2 + hstep, voffA);
            PG8_WAIT_V(8); PG8_WAIT_L(0); PG8_BAR; PG8_MMA(0, 0, At, B0); PG8_MMA(0, 1, At, B1); PG8_BAR; PG8_SCHED;
            PG8_LDA(At, 1, 1); PG8_STAGE(PG8_SB(1, 0), b3, voffB); PG8_STAGE(PG8_SB(1, 1), b3 + hstep, voffB); PG8_STAGE(PG8_SA(1, 0), a3, voffA);
            PG8_WAIT_V(8); PG8_WAIT_L(0); PG8_BAR; PG8_MMA(1, 0, At, B0); PG8_MMA(1, 1, At, B1); PG8_BAR; PG8_SCHED;
            } else {
            PG8_LDB(B0, 0, 0); PG8_SCHED; PG8_LDA(At, 0, 0); PG8_STAGE(PG8_SA(1, 1), a1 + hstep, voffA);
            PG8_WAIT_L(8); PG8_BAR; PG8_WAIT_L(0); PG8_MMA(0, 0, At, B0); PG8_BAR; PG8_SCHED;
            PG8_LDB(B1, 0, 1); PG8_STAGE(PG8_SB(0, 0), b2, voffB);
            PG8_BAR; PG8_WAIT_L(0); PG8_MMA(0, 1, At, B1); PG8_BAR;
            PG8_LDA(At, 0, 1); PG8_STAGE(PG8_SA(0, 0), a2, voffA);
            PG8_BAR; PG8_WAIT_L(0); PG8_MMA(1, 0, At, B0); PG8_BAR; PG8_SCHED;
            PG8_STAGE(PG8_SB(0, 1), b2 + hstep, voffB);
            PG8_WAIT_V(6); PG8_BAR; PG8_MMA(1, 1, At, B1); PG8_BAR;
            PG8_LDB(B0, 1, 0); PG8_SCHED; PG8_LDA(At, 1, 0); PG8_STAGE(PG8_SA(0, 1), a2 + hstep, voffA);
            PG8_WAIT_L(8); PG8_BAR; PG8_WAIT_L(0); PG8_MMA(0, 0, At, B0); PG8_BAR; PG8_SCHED;
            PG8_LDB(B1, 1, 1); PG8_STAGE(PG8_SB(1, 0), b3, voffB);
            PG8_BAR; PG8_WAIT_L(0); PG8_MMA(0, 1, At, B1); PG8_BAR;
            PG8_LDA(At, 1, 1); PG8_STAGE(PG8_SA(1, 0), a3, voffA);
            PG8_BAR; PG8_WAIT_L(0); PG8_MMA(1, 0, At, B0); PG8_BAR; PG8_SCHED;
            PG8_STAGE(PG8_SB(1, 1), b3 + hstep, voffB);
            PG8_WAIT_V(6); PG8_BAR; PG8_MMA(1, 1, At, B1); PG8_BAR;
            }
        }
        if constexpr (F8 != 0) asm volatile("s_nop 15\n\ts_nop 15" ::: "memory");
        if constexpr (ALIGN_EPI) { if (wr == 0) PG8_BAR; }
        if constexpr (!Epi::AFTER_DRAIN) { E(acc, cur, wr, wc, fr, fq);
            S.done(cur); }
        if (!has_next) break;
#pragma unroll
        for (int a = 0; a < 2; ++a)
#pragma unroll
            for (int b = 0; b < 2; ++b)
#pragma unroll
                for (int m = 0; m < 4; ++m)
#pragma unroll
                    for (int n = 0; n < 2; ++n) acc[a][b][m][n] = (f32x4){0.f, 0.f, 0.f, 0.f};
        cur = nxt; cA = nA; cB = nB; ++ui;
        if constexpr (ALIGN_EPI) { if (wr == 1) PG8_BAR; }
    }
    PG8_WAIT_V(0);
    if constexpr (!ALIGN_EPI) { if (wr == 0) PG8_BAR; }
    PG8_BAR;
    if constexpr (Epi::AFTER_DRAIN) { E.fused(acc, cur, wr, wc, fr, fq, lds, wid, lane); S.done(cur); }
#undef PG8_SA
#undef PG8_SB
#undef PG8_STAGE
#undef PG8_LDA
#undef PG8_LDB
#undef PG8_MMA
#undef PG8_CAT
#undef PG8_WAIT_V
#undef PG8_WAIT_L
#undef PG8_BAR
#undef PG8_SCHED
}
}
constexpr int NWAVES = 8;
constexpr int D = 1024, NB = 8, T = 2048, NS = 128, TS = 4, FF = 2816, PROJ = 3592, QKV = 1536, NH = 4;
constexpr int MP = NB * T, MS = NS * TS, M = MP + MS, NSEQ = NB + NS;
constexpr int NUP = 2 * FF, NIN = 3584, MODW = 9 * D;
constexpr float ALPHA = 1.189207115002721f, LN_EPS = 1e-5f;
constexpr size_t O_Y = 0, O_SSM_P = (size_t)M * D, O_CQ_P = O_SSM_P + (size_t)NB * NH * 128 * 128, O_CM_P = O_CQ_P + (size_t)NB * 3 * QKV,
                 O_SSM_S = O_CM_P + (size_t)NB * 2 * 512, O_CQ_S = O_SSM_S + (size_t)NS * NH * 128 * 128, O_CM_S = O_CQ_S + (size_t)NS * 3 * QKV,
                 O_END = O_CM_S + (size_t)NS * 2 * 512;
constexpr size_t MiB = 1u << 20, KiB = 1u << 10;
constexpr size_t WS_CTL = 0, CTL_ZERO_BYTES = 128 * KiB;
constexpr size_t WS_MOD = 1 * MiB;
constexpr size_t WS_W1U = 6 * MiB, WS_W1D = 17 * MiB, WS_W2U = 22 * MiB + 512 * KiB, WS_W2D = 33 * MiB + 512 * KiB, WS_WIN = 39 * MiB, WS_WOUT = 46 * MiB + 512 * KiB;
constexpr size_t WS_SILU = 720 * KiB;
constexpr size_t WS_GB = 128 * KiB, WS_GL = 704 * KiB;
constexpr int NING = 3840;
constexpr size_t WS_XM = 49 * MiB, WS_Y = 82 * MiB, WS_HP = 115 * MiB, WS_END = 256 * MiB;
static_assert(WS_MOD + (size_t)NSEQ * MODW * 4 <= WS_W1U && WS_W1U + (size_t)NUP * D * 2 <= WS_W1D && WS_W1D + (size_t)D * FF * 2 <= WS_W2U && WS_W2U + (size_t)NUP * D * 2 <= WS_W2D &&
              WS_W2D + (size_t)D * FF * 2 <= WS_WIN && WS_WIN + (size_t)NING * D * 2 <= WS_WOUT && WS_WOUT + (size_t)D * D * 2 <= WS_XM && WS_GB + (size_t)M * 8 * 4 <= WS_GL && WS_GL + 4096 <= WS_MOD &&
              WS_XM + (size_t)M * D * 2 <= WS_Y && WS_Y + (size_t)M * D * 2 <= WS_HP && WS_HP + (size_t)M * NIN * 2 <= WS_END, "d_ws map");
constexpr size_t WS_X2B = WS_HP + 100 * MiB;
static_assert(WS_X2B >= WS_HP + (size_t)M * FF * 2 && WS_X2B + (size_t)M * D * 2 <= WS_END - 2 * MiB, "x2 above H");
constexpr int CW_TMO = 0, CW_CODE = 1, CW_BAR = 4096, CW_SEAM = 8192, SEAM_BANK = 64 * 64;
static_assert((CW_SEAM + 3 * SEAM_BANK) * 4 <= (int)CTL_ZERO_BYTES && CW_BAR + 3456 <= CW_SEAM, "control words");
constexpr size_t WS_XCH = 254 * MiB + 512 * KiB;
constexpr int RING_OFF = 0, RING_BYTES = 131072, LDSCTL_OFF = RING_BYTES, MISC_OFF = LDSCTL_OFF + 320, LDS_BYTES = 147456;

#define GAS __attribute__((address_space(1)))
#define LAS __attribute__((address_space(3)))
typedef unsigned short bf16;
typedef unsigned v4u __attribute__((ext_vector_type(4)));
typedef unsigned v2u __attribute__((ext_vector_type(2)));
typedef float f32x4 __attribute__((ext_vector_type(4)));
typedef short bf16x8 __attribute__((ext_vector_type(8)));
typedef GAS unsigned gu32;
#define RLX_AGENT __ATOMIC_RELAXED, __HIP_MEMORY_SCOPE_AGENT
#define LDS_WAIT() asm volatile("s_waitcnt lgkmcnt(0)" ::: "memory")
#define VM_WAIT() asm volatile("s_waitcnt vmcnt(0)" ::: "memory")
__device__ __forceinline__ unsigned f2bf(float f) { unsigned u = __builtin_bit_cast(unsigned, f); return (u + 0x7fffu + ((u >> 16) & 1u)) >> 16; }
typedef float f32x2_t __attribute__((ext_vector_type(2))); typedef __bf16 bf16x2_t __attribute__((ext_vector_type(2)));
__device__ __forceinline__ unsigned pk2(float lo, float hi) { const f32x2_t v = {lo, hi}; const bf16x2_t b = __builtin_convertvector(v, bf16x2_t); return __builtin_bit_cast(unsigned, b); }
__device__ __forceinline__ float bf_lo(unsigned w) { return __builtin_bit_cast(float, w << 16); }
__device__ __forceinline__ float bf_hi(unsigned w) { return __builtin_bit_cast(float, w & 0xffff0000u); }
__device__ __forceinline__ float silu_f(float x) { return x * __builtin_amdgcn_rcpf(1.0f + __builtin_amdgcn_exp2f(-1.4426950408889634f * x)); }

#define XB_TMO      128
#define XB_XCNT(j)  (256  + 64 * (j))
#define XB_XSUB(j)  (1280 + 64 * (j))
#define XB_XGEN(j)  (2304 + 64 * (j))
#define XB_TOP      3328
#define XB_TOPGEN   3392
#define XCD_BAR_WORDS 3456
#define XB_SPIN_CAP (1u << 18)
__device__ __forceinline__ unsigned xb_ld(unsigned* p)              { return __hip_atomic_load(p, __ATOMIC_RELAXED, __HIP_MEMORY_SCOPE_AGENT); }
__device__ __forceinline__ unsigned xb_add(unsigned* p, unsigned v) { return __hip_atomic_fetch_add(p, v, __ATOMIC_RELAXED, __HIP_MEMORY_SCOPE_AGENT); }
__device__ __forceinline__ unsigned xb_xcc_id() { return (unsigned)__builtin_amdgcn_s_getreg((3 << 11) | 20) & 0xFu; }
#define XB_SPIN(cond, bar) do { unsigned _sp = 0; while (cond) { __builtin_amdgcn_s_sleep(1); \
    if ((++_sp & 255u) == 0u) { if (xb_ld(&(bar)[XB_TMO])) break; if (_sp > XB_SPIN_CAP) { atomicAdd(&(bar)[XB_TMO], 1u); break; } } } } while (0)
struct XcdBarrier { unsigned* bar; unsigned x; volatile LAS unsigned* st; };
__device__ __forceinline__ XcdBarrier xcd_barrier_post(unsigned* bar, volatile LAS unsigned* st) {
    XcdBarrier b; b.bar = bar; b.x = xb_xcc_id(); b.st = st;
    if (threadIdx.x == 0) { asm volatile("s_waitcnt vmcnt(0)" ::: "memory"); (void)xb_add(&bar[XB_XCNT(b.x)], 1u); }
    return b;
}
__device__ __forceinline__ void xcd_barrier_complete(unsigned* bar, unsigned x, unsigned& nloc, unsigned& nx) {
    const unsigned G = gridDim.x * gridDim.y * gridDim.z;
    unsigned sum, cnt, mine, sp = 0u;
    for (;;) {
        sum = 0u; cnt = 0u; mine = 0u;
#pragma unroll
        for (unsigned j = 0; j < 16; ++j) { const unsigned c = xb_ld(&bar[XB_XCNT(j)]); sum += c; cnt += (c > 0u) ? 1u : 0u; mine = (j == x) ? c : mine; }
        if (sum == G) break;
        __builtin_amdgcn_s_sleep(1);
        if ((++sp & 255u) == 0u) { if (xb_ld(&bar[XB_TMO])) break; if (sp > XB_SPIN_CAP) { atomicAdd(&bar[XB_TMO], 1u); break; } }
    }
    nloc = mine > 0u ? mine : 1u; nx = cnt > 0u ? cnt : 1u;
}
__device__ __forceinline__ void xcd_barrier_census(const XcdBarrier& b) {
    if (threadIdx.x == 0) { unsigned nloc, nx; asm volatile("buffer_inv sc1" ::: "memory");
        xcd_barrier_complete(b.bar, b.x, nloc, nx); asm volatile("s_waitcnt vmcnt(0)" ::: "memory"); b.st[0] = nloc; b.st[1] = nx; }
    __syncthreads();
}
__device__ __forceinline__ void xcd_barrier(const XcdBarrier& b) {
    asm volatile("s_waitcnt vmcnt(0)" ::: "memory");
    __syncthreads();
    if (threadIdx.x == 0) {
        unsigned* bar = b.bar;
        __builtin_amdgcn_s_waitcnt(0);
        unsigned nloc = b.st[0], nx = b.st[1];
        asm volatile("buffer_inv sc1" ::: "memory");
        const unsigned old = xb_add(&bar[XB_XSUB(b.x)], 1u);
        const unsigned gen = old / nloc;
        if (old + 1u == (gen + 1u) * nloc) {
            __builtin_amdgcn_fence(__ATOMIC_RELEASE, "agent");
            asm volatile("s_waitcnt vmcnt(0)" ::: "memory");
            (void)xb_add(&bar[XB_TOP], 1u);
        }
        const unsigned target = (gen + 1u) * nx;
        XB_SPIN((int)(xb_ld(&bar[XB_TOP]) - target) < 0, bar);
        asm volatile("s_waitcnt vmcnt(0)" ::: "memory");
    }
    __syncthreads();
}

struct Args { const float* in[24]; float* out; unsigned char* ws; int ph_lo, ph_hi; };
struct Frame {
    LAS unsigned char* lds;
    volatile LAS unsigned* MISC;
    gu32* ctl;
    int tid, lane, wave, vcu, G;
    const struct Args* a; float* out; unsigned char* ws;
};
__device__ __forceinline__ float wave_sum(float v) {
#define WS_DPP(ctrl_, rm_) __builtin_bit_cast(float, __builtin_amdgcn_update_dpp(0, __builtin_bit_cast(int, v), ctrl_, rm_, 0xF, false))
    v += WS_DPP(0xB1, 0xF); v += WS_DPP(0x4E, 0xF); v += WS_DPP(0x141, 0xF); v += WS_DPP(0x140, 0xF);
    v += WS_DPP(0x142, 0xA); v += WS_DPP(0x143, 0xC);
#undef WS_DPP
    return __builtin_bit_cast(float, __builtin_amdgcn_readlane(__builtin_bit_cast(int, v), 63));
}
__device__ __forceinline__ int seq_of(int m) { return m < MP ? (m >> 11) : NB + ((m - MP) >> 2); }

constexpr int CV_W1U = 0, CV_W1D = 2816, CV_WIN = 4224, CV_WOUT = 6032, CV_W2U = 6544, CV_W2D = 9360, CV_END = 10768;
#ifndef CV_P0_END
#define CV_P0_END CV_W2U
#endif
#ifndef F8_FFN1
#define F8_FFN1 1
#endif
#ifndef F8_FFN2
#define F8_FFN2 1
#endif
#ifndef F8_WOUT
#define F8_WOUT 1
#endif
constexpr int F8_WO_SH = 6;
constexpr int Y8_SH = 3;
constexpr int F8_UP_SH = 5, F8_DN_SH = 6;
struct CvP { const float* src; unsigned char* dst; int ldw, scol, K, drow, kb, f8; float scale; };
__device__ __forceinline__ void cv_load(const CvP& c, f32x4 (&tv)[8], int lane) {
    const int k0 = 64 * c.kb;
#pragma unroll
    for (int i = 0; i < 8; ++i) tv[i] = __builtin_nontemporal_load((const f32x4*)(c.src + (size_t)(k0 + 8 * i + (lane >> 3)) * c.ldw + c.scol + 4 * (lane & 7)));
}
__device__ __forceinline__ void cv_finish(const CvP& c, const f32x4 (&tv)[8], LAS float* scr, int lane) {
    const int k0 = 64 * c.kb;
#pragma unroll
    for (int i = 0; i < 8; ++i) { LAS float* d = scr + (8 * i + (lane >> 3)) * 33 + 4 * (lane & 7); d[0] = tv[i].x; d[1] = tv[i].y; d[2] = tv[i].z; d[3] = tv[i].w; }
    LDS_WAIT(); asm volatile("" ::: "memory");
    const int cc = lane & 7; const float scale = c.scale;
#pragma unroll
    for (int j = 0; j < 4; ++j) { const int n = (lane >> 3) + 8 * j; const LAS float* s = scr + (8 * cc) * 33 + n;
        if (c.f8) { v2u o; o.x = pg8::pk4_fp8(s[0 * 33] * scale, s[1 * 33] * scale, s[2 * 33] * scale, s[3 * 33] * scale); o.y = pg8::pk4_fp8(s[4 * 33] * scale, s[5 * 33] * scale, s[6 * 33] * scale, s[7 * 33] * scale);
            *(GAS v2u*)(c.dst + (size_t)(c.drow + n) * c.K + k0 + 8 * cc) = o; }
        else { v4u o; o.x = pk2(s[0 * 33], s[1 * 33]); o.y = pk2(s[2 * 33], s[3 * 33]); o.z = pk2(s[4 * 33], s[5 * 33]); o.w = pk2(s[6 * 33], s[7 * 33]);
            *(GAS v4u*)((bf16*)c.dst + (size_t)(c.drow + n) * c.K + k0 + 8 * cc) = o; } }
    LDS_WAIT(); asm volatile("" ::: "memory");
}
__device__ __forceinline__ CvP cv_params(Frame& F, int it) {
    CvP c; c.scale = 1.f; c.f8 = 0;
    if (it < CV_W1D || (it >= CV_W2U && it < CV_W2D)) { const bool second = it >= CV_W2U; int r = it - (second ? CV_W2U : CV_W1U); const int w = r / 1408; r -= w * 1408; const int kb = r / 88, nb = r % 88;
        c.src = second ? (w == 0 ? F.a->in[14] : F.a->in[15]) : (w == 0 ? F.a->in[11] : F.a->in[12]); c.dst = F.ws + (second ? WS_W2U : WS_W1U); c.ldw = FF; c.scol = 32 * nb; c.K = D; c.drow = 256 * (nb >> 2) + 32 * (nb & 3) + 128 * w; c.kb = kb;
        if (second ? F8_FFN2 : F8_FFN1) { c.f8 = 1; c.scale = (w == 0 ? -1.4426950408889634f : 1.0f) * (float)(1 << F8_UP_SH); } }
    else if (it < CV_WIN || it >= CV_W2D) { const bool second = it >= CV_W2D; const int r = it - (second ? CV_W2D : CV_W1D), kb = r / 32, nb = r % 32;
        c.src = second ? F.a->in[16] : F.a->in[13]; c.dst = F.ws + (second ? WS_W2D : WS_W1D); c.ldw = D; c.scol = 32 * nb; c.K = FF; c.drow = 32 * nb; c.kb = kb;
        if (second ? F8_FFN2 : F8_FFN1) { c.f8 = 1; c.scale = -0.6931471805599453f * (float)(1 << F8_DN_SH); } }
    else if (it < CV_WOUT) { const int r = it - CV_WIN, kb = r / 113, nb = r % 113;
        c.src = F.a->in[17]; c.dst = F.ws + WS_WIN; c.ldw = PROJ; c.scol = nb < 48 ? 32 * nb : nb < 112 ? 1544 + 32 * (nb - 48) : 1536; c.K = D; c.drow = nb < 48 ? 32 * nb : nb < 112 ? 1536 + 32 * (nb - 48) : 3584; c.kb = kb; }
    else { const int r = it - CV_WOUT, kb = r / 32, nb = r % 32; c.src = F.a->in[23]; c.dst = F.ws + WS_WOUT; c.ldw = D; c.scol = 32 * nb; c.K = D; c.drow = 32 * nb; c.kb = kb;
        if (F8_WOUT) { c.f8 = 1; c.scale = (float)(1 << F8_WO_SH); } }
    return c;
}
__device__ __forceinline__ void convert_items(Frame& F, int it0, int it1, int gw, int ngw) {
    LAS float* scr = (LAS float*)(F.lds + RING_OFF + F.wave * 16384);
    int it = it0 + gw; if (it >= it1) return;
    CvP c = cv_params(F, it); f32x4 tv[8]; cv_load(c, tv, F.lane);
#pragma unroll 1
    for (;;) { const int nit = it + ngw; const bool hn = nit < it1;
        CvP cn = c; f32x4 tn[8];
        if (hn) { cn = cv_params(F, nit); cv_load(cn, tn, F.lane); }
        cv_finish(c, tv, scr, F.lane);
        if (!hn) break;
        c = cn; it = nit;
#pragma unroll
        for (int i = 0; i < 8; ++i) tv[i] = tn[i]; }
}
__device__ __forceinline__ void p0_ada(Frame& F) {
    constexpr int RS = 528;
    const int lin = F.wave * F.G + (int)blockIdx.x, pair = (F.wave >> 1) * F.G + (int)blockIdx.x, unit = 2 * pair + (F.wave & 1), h1 = 288 - F.G;
    const bool has = pair < 288;
    const bf16* SILU = (const bf16*)(F.ws + WS_SILU);
    v4u stg[9];
#define ADA_SLOAD(kc_) do { _Pragma("unroll") for (int i = 0; i < 9; ++i) { const int gi = F.tid + 512 * i, row = gi >> 5, kg = gi & 31; \
        stg[i] = (v4u){0u, 0u, 0u, 0u}; if (row < NSEQ) stg[i] = *(const GAS v4u*)(SILU + (size_t)row * D + (kc_) * 256 + kg * 8); } } while (0)
#define ADA_SSTORE() do { _Pragma("unroll") for (int i = 0; i < 9; ++i) { const int gi = F.tid + 512 * i, row = gi >> 5, kg = gi & 31; *(LAS v4u*)(F.lds + row * RS + kg * 16) = stg[i]; } } while (0)
    ADA_SLOAD(0);
    if (has) {
        const int n0 = unit * 16, m = F.lane & 15, g = F.lane >> 4;
        const float* wada = F.a->in[7];
        f32x4 acc[9];
#pragma unroll
        for (int i = 0; i < 9; ++i) acc[i] = (f32x4){0.f, 0.f, 0.f, 0.f};
        float afn[8][8];
#define ADA_LOAD(kc_) do { _Pragma("unroll") for (int ks = 0; ks < 8; ++ks) _Pragma("unroll") for (int j = 0; j < 8; ++j) \
        afn[ks][j] = __builtin_nontemporal_load(wada + (size_t)((kc_) * 256 + ks * 32 + 8 * g + j) * MODW + n0 + m); } while (0)
        ADA_LOAD(0);
#pragma unroll 1
        for (int kc = 0; kc < 4; ++kc) {
            ADA_SSTORE(); if (kc + 1 < 4) ADA_SLOAD(kc + 1);
            v4u aw[8];
#pragma unroll
            for (int ks = 0; ks < 8; ++ks) { aw[ks].x = pk2(afn[ks][0], afn[ks][1]); aw[ks].y = pk2(afn[ks][2], afn[ks][3]); aw[ks].z = pk2(afn[ks][4], afn[ks][5]); aw[ks].w = pk2(afn[ks][6], afn[ks][7]); }
            if (kc + 1 < 4) ADA_LOAD(kc + 1);
            LDS_WAIT(); __syncthreads();
#pragma unroll
            for (int ks = 0; ks < 8; ++ks) {
                const bf16x8 A = __builtin_bit_cast(bf16x8, aw[ks]);
#pragma unroll
                for (int nt = 0; nt < 9; ++nt) {
                    const bf16x8 B = *(const LAS bf16x8*)(F.lds + (16 * nt + m) * RS + (ks * 32 + 8 * g) * 2);
                    acc[nt] = __builtin_amdgcn_mfma_f32_16x16x32_bf16(A, B, acc[nt], 0, 0, 0);
                }
            }
            LDS_WAIT(); __syncthreads();
        }
#undef ADA_LOAD
        const f32x4 bv = *(const f32x4*)(F.a->in[8] + n0 + 4 * g);
        float* mod = (float*)(F.ws + WS_MOD);
#pragma unroll
        for (int nt = 0; nt < 9; ++nt) { const int s = 16 * nt + m; if (s < NSEQ) *(f32x4*)(mod + (size_t)s * MODW + n0 + 4 * g) = acc[nt] + bv; }
    } else {
        const int nidle = NWAVES * F.G - 576; int cit = CV_W1U + (lin < 3 * F.G ? lin - (2 * F.G + h1) : (F.G - h1) + (lin - (3 * F.G + h1)));
        LAS float* cscr = (LAS float*)(F.lds + 144 * RS + (F.wave >= 2 ? F.wave - 2 : 0) * 8448);
        bool have = cit < CV_P0_END; CvP c = cv_params(F, have ? cit : CV_W1U); f32x4 tv[8];
        if (have) cv_load(c, tv, F.lane);
#define ADA_CVSTEP() do { const int nit = cit + nidle; const bool hn = nit < CV_P0_END; CvP cn = c; f32x4 tn[8]; \
            if (hn) { cn = cv_params(F, nit); cv_load(cn, tn, F.lane); } \
            cv_finish(c, tv, cscr, F.lane); c = cn; cit = nit; have = hn; \
            _Pragma("unroll") for (int i = 0; i < 8; ++i) tv[i] = tn[i]; } while (0)
#pragma unroll 1
        for (int kc = 0; kc < 4; ++kc) {
            ADA_SSTORE(); if (kc + 1 < 4) ADA_SLOAD(kc + 1);
            LDS_WAIT(); __syncthreads();
            if (have) ADA_CVSTEP();
            LDS_WAIT(); __syncthreads();
        }
#pragma unroll 1
        while (have) ADA_CVSTEP();
#undef ADA_CVSTEP
    }
#undef ADA_SLOAD
#undef ADA_SSTORE
}
template <int K>
__device__ __forceinline__ void sample_gemm(Frame& F, const bf16* A, const bf16* Bt, bf16* C) {
    static_assert(K % 256 == 0, "K split over 8 waves in 32-deep steps");
    int tid_l = F.tid; asm volatile("" : "+v"(tid_l));
    const int tid = tid_l, lane = tid & 63, wave = F.wave, m = lane & 15, g = lane >> 4;
    for (int tile = (int)blockIdx.x; tile < 256; tile += F.G) {
        const int rm = tile >> 4, cn = tile & 15;
        const bf16* a0 = A + (size_t)(32 * rm + m) * K + wave * (K / 8) + 8 * g;
        const bf16* b0 = Bt + (size_t)(64 * cn + m) * K + wave * (K / 8) + 8 * g;
        f32x4 acc[2][4];
#pragma unroll
        for (int i = 0; i < 2; ++i)
#pragma unroll
            for (int j = 0; j < 4; ++j) acc[i][j] = (f32x4){0.f, 0.f, 0.f, 0.f};
#pragma unroll 4
        for (int ks = 0; ks < K / 256; ++ks) {
            bf16x8 a[2], b[4];
#pragma unroll
            for (int i = 0; i < 2; ++i) a[i] = *(const GAS bf16x8*)(a0 + (size_t)(16 * i) * K + 32 * ks);
#pragma unroll
            for (int j = 0; j < 4; ++j) b[j] = *(const GAS bf16x8*)(b0 + (size_t)(16 * j) * K + 32 * ks);
#pragma unroll
            for (int i = 0; i < 2; ++i)
#pragma unroll
                for (int j = 0; j < 4; ++j) acc[i][j] = __builtin_amdgcn_mfma_f32_16x16x32_bf16(a[i], b[j], acc[i][j], 0, 0, 0);
        }
        LAS float* red = (LAS float*)(F.lds + RING_OFF);
#pragma unroll
        for (int i = 0; i < 2; ++i)
#pragma unroll
            for (int j = 0; j < 4; ++j)
#pragma unroll
                for (int r = 0; r < 4; ++r) red[(wave * 32 + 16 * i + 4 * g + r) * 64 + 16 * j + m] = acc[i][j][r];
        LDS_WAIT(); __syncthreads();
        const int row = tid >> 4, c4 = (tid & 15) * 4;
        f32x4 s = (f32x4){0.f, 0.f, 0.f, 0.f};
#pragma unroll
        for (int w = 0; w < 8; ++w) s = s + *(const LAS f32x4*)(red + (w * 32 + row) * 64 + c4);
        v2u o; o.x = pk2(s.x, s.y); o.y = pk2(s.z, s.w);
        *(GAS v2u*)(C + (size_t)(32 * rm + row) * D + 64 * cn + c4) = o;
        LDS_WAIT(); __syncthreads();
    }
}
template <int K>
__device__ __forceinline__ void sample_gemm8(Frame& F, const unsigned char* A, const unsigned char* Bt, bf16* C, float oscale) {
    static_assert(K % 256 == 0, "K split over 8 waves in 32-deep steps");
    int tid_l = F.tid; asm volatile("" : "+v"(tid_l));
    const int tid = tid_l, lane = tid & 63, wave = F.wave, m = lane & 15, g = lane >> 4;
    for (int tile = (int)blockIdx.x; tile < 256; tile += F.G) {
        const int rm = tile >> 4, cn = tile & 15;
        const unsigned char* a0 = A + (size_t)(32 * rm + m) * K + wave * (K / 8) + 8 * g;
        const unsigned char* b0 = Bt + (size_t)(64 * cn + m) * K + wave * (K / 8) + 8 * g;
        f32x4 acc[2][4];
#pragma unroll
        for (int i = 0; i < 2; ++i)
#pragma unroll
            for (int j = 0; j < 4; ++j) acc[i][j] = (f32x4){0.f, 0.f, 0.f, 0.f};
#pragma unroll 4
        for (int ks = 0; ks < K / 256; ++ks) {
            long a[2], b[4];
#pragma unroll
            for (int i = 0; i < 2; ++i) a[i] = *(const GAS long*)(a0 + (size_t)(16 * i) * K + 32 * ks);
#pragma unroll
            for (int j = 0; j < 4; ++j) b[j] = *(const GAS long*)(b0 + (size_t)(16 * j) * K + 32 * ks);
#pragma unroll
            for (int i = 0; i < 2; ++i)
#pragma unroll
                for (int j = 0; j < 4; ++j) acc[i][j] = __builtin_amdgcn_mfma_f32_16x16x32_fp8_fp8(a[i], b[j], acc[i][j], 0, 0, 0);
        }
        LAS float* red = (LAS float*)(F.lds + RING_OFF);
#pragma unroll
        for (int i = 0; i < 2; ++i)
#pragma unroll
            for (int j = 0; j < 4; ++j)
#pragma unroll
                for (int r = 0; r < 4; ++r) red[(wave * 32 + 16 * i + 4 * g + r) * 64 + 16 * j + m] = acc[i][j][r];
        LDS_WAIT(); __syncthreads();
        const int row = tid >> 4, c4 = (tid & 15) * 4;
        f32x4 s = (f32x4){0.f, 0.f, 0.f, 0.f};
#pragma unroll
        for (int w = 0; w < 8; ++w) s = s + *(const LAS f32x4*)(red + (w * 32 + row) * 64 + c4);
        s = s * oscale;
        v2u o; o.x = pk2(s.x, s.y); o.y = pk2(s.z, s.w);
        *(GAS v2u*)(C + (size_t)(32 * rm + row) * D + 64 * cn + c4) = o;
        LDS_WAIT(); __syncthreads();
    }
}
template <int K>
__device__ __forceinline__ void sample_gemm8s(Frame& F, const unsigned char* A, const unsigned char* Bt, bf16* C, int ws8) {
    static_assert(K % 128 == 0, "128-deep steps");
    constexpr int NST = K / 128, NQ = (NST + 7) / 8;
    typedef int i32x4s __attribute__((ext_vector_type(4))); typedef int i32x8s __attribute__((ext_vector_type(8)));
    int tid_l = F.tid; asm volatile("" : "+v"(tid_l));
    const int tid = tid_l, lane = tid & 63, wave = F.wave, m = lane & 15, g = lane >> 4;
    const int wsv = ws8 * 0x01010101;
    for (int tile = (int)blockIdx.x; tile < 256; tile += F.G) {
        const int rm = tile >> 4, cn = tile & 15;
        const unsigned char* a0 = A + (size_t)(32 * rm + m) * K + 32 * g;
        const unsigned char* b0 = Bt + (size_t)(64 * cn + m) * K + 32 * g;
        f32x4 acc[2][4];
#pragma unroll
        for (int i = 0; i < 2; ++i)
#pragma unroll
            for (int j = 0; j < 4; ++j) acc[i][j] = (f32x4){0.f, 0.f, 0.f, 0.f};
        i32x4s al[NQ][2][2], bl[NQ][4][2];
#pragma unroll
        for (int q = 0; q < NQ; ++q) { const int st = wave + 8 * q;
            if (st < NST) {
#pragma unroll
                for (int i = 0; i < 2; ++i)
#pragma unroll
                    for (int h = 0; h < 2; ++h) al[q][i][h] = *(const GAS i32x4s*)(a0 + (size_t)(16 * i) * K + 128 * st + 16 * h);
#pragma unroll
                for (int j = 0; j < 4; ++j)
#pragma unroll
                    for (int h = 0; h < 2; ++h) bl[q][j][h] = *(const GAS i32x4s*)(b0 + (size_t)(16 * j) * K + 128 * st + 16 * h);
            } }
#pragma unroll
        for (int q = 0; q < NQ; ++q) { const int st = wave + 8 * q;
            if (st < NST) {
#pragma unroll
                for (int i = 0; i < 2; ++i)
#pragma unroll
                    for (int j = 0; j < 4; ++j) { const i32x8s a8 = __builtin_shufflevector(al[q][i][0], al[q][i][1], 0, 1, 2, 3, 4, 5, 6, 7), b8 = __builtin_shufflevector(bl[q][j][0], bl[q][j][1], 0, 1, 2, 3, 4, 5, 6, 7);
                        acc[i][j] = __builtin_amdgcn_mfma_scale_f32_16x16x128_f8f6f4(a8, b8, acc[i][j], 0, 0, 0, 0x7F7F7F7F, 0, wsv); }
            } }
        LAS float* red = (LAS float*)(F.lds + RING_OFF);
#pragma unroll
        for (int i = 0; i < 2; ++i)
#pragma unroll
            for (int j = 0; j < 4; ++j)
#pragma unroll
                for (int r = 0; r < 4; ++r) red[(wave * 32 + 16 * i + 4 * g + r) * 64 + 16 * j + m] = acc[i][j][r];
        LDS_WAIT(); __syncthreads();
        const int row = tid >> 4, c4 = (tid & 15) * 4;
        f32x4 s = (f32x4){0.f, 0.f, 0.f, 0.f};
#pragma unroll
        for (int w = 0; w < 8; ++w) s = s + *(const LAS f32x4*)(red + (w * 32 + row) * 64 + c4);
        *(GAS unsigned*)((unsigned char*)C + (size_t)(32 * rm + row) * D + 64 * cn + c4) = pg8::pk4_fp8(s.x, s.y, s.z, s.w);
        LDS_WAIT(); __syncthreads();
    }
}
__device__ __forceinline__ void p1_mod(Frame& F) {
    const int gw = F.vcu * NWAVES + F.wave, NGW = F.G * NWAVES;
    const float* mod = (const float*)(F.ws + WS_MOD); bf16* XM = (bf16*)(F.ws + WS_XM);
    for (int m = gw; m < M; m += NGW) {
        const float* xr = m < MP ? F.a->in[0] + (size_t)m * D : F.a->in[1] + (size_t)(m - MP) * D;
        const float* ms = mod + (size_t)seq_of(m) * MODW;
#pragma unroll
        for (int j = 0; j < 4; ++j) { const int d = 4 * F.lane + 256 * j;
            const f32x4 v = __builtin_nontemporal_load((const f32x4*)(xr + d)), sh = *(const f32x4*)(ms + d), sc = *(const f32x4*)(ms + D + d);
            const f32x4 o = v * (sc + 1.0f) + sh;
            if (F8_FFN1) *(GAS unsigned*)((unsigned char*)XM + (size_t)m * D + d) = pg8::pk4_fp8(o.x, o.y, o.z, o.w);
            else { v2u w; w.x = pk2(o.x, o.y); w.y = pk2(o.z, o.w); *(GAS v2u*)(XM + (size_t)m * D + d) = w; } }
    }
}
__device__ __forceinline__ void ab_tail(Frame& F, int m, int lane, float p1) {
    const int q = 4 * (lane & 1) + 2 * ((lane >> 1) & 1) + ((lane >> 2) & 1), h = q & 3;
    float* GB = (float*)(F.ws + WS_GB);
    if (q < 4) { const float z = p1 + F.a->in[20][h]; const float sp = z > 20.f ? z : log1pf(__expf(z)); GB[(size_t)m * 4 + h] = -__expf(F.a->in[19][h]) * sp; }
    else GB[(size_t)M * 4 + (size_t)m * 4 + h] = 1.f / (1.f + __expf(-p1));
}
template <int I, bool AB, int NR>
__device__ __forceinline__ void ln_rows(Frame& F, int m0, float yscale, LAS float* W8, const bf16* Y, bf16* XM) {
    const float* mod = (const float*)(F.ws + WS_MOD);
    const float* ms = mod + (size_t)seq_of(m0) * MODW + I * 3 * D;
    const int lane = F.lane;
    f32x4 gt[4], lg[4], lb[4], sh[4], sc[4];
#pragma unroll
    for (int j = 0; j < 4; ++j) { const int d = 4 * lane + 256 * j;
        gt[j] = *(const f32x4*)(ms + 2 * D + d) * (yscale * (1.f / (1 << Y8_SH))); lg[j] = *(const f32x4*)(F.a->in[9] + I * D + d); lb[j] = *(const f32x4*)(F.a->in[10] + I * D + d);
        if (I < 2) { sh[j] = *(const f32x4*)(ms + 3 * D + d); sc[j] = *(const f32x4*)(ms + 4 * D + d) + 1.0f; } }
    f32x4 xn[4]; unsigned yn[4];
#define LN_LOAD(m_) do { \
        if (I == 0) { const float* xr_ = (m_) < MP ? F.a->in[0] + (size_t)(m_) * D : F.a->in[1] + (size_t)((m_) - MP) * D; \
            _Pragma("unroll") for (int j = 0; j < 4; ++j) xn[j] = __builtin_nontemporal_load((const f32x4*)(xr_ + 4 * lane + 256 * j)); } \
        else { const bf16* xb_ = (I == 1 ? (const bf16*)F.out : (const bf16*)(F.ws + WS_X2B)) + (size_t)(m_) * D; \
            _Pragma("unroll") for (int j = 0; j < 4; ++j) { const v2u w_ = *(const GAS v2u*)(xb_ + 4 * lane + 256 * j); xn[j] = (f32x4){bf_lo(w_.x), bf_hi(w_.x), bf_lo(w_.y), bf_hi(w_.y)}; } } \
        _Pragma("unroll") for (int j = 0; j < 4; ++j) yn[j] = *(const GAS unsigned*)((const unsigned char*)Y + (size_t)(m_) * D + 4 * lane + 256 * j); } while (0)
    LN_LOAD(m0);
    float psel = 0.f;
#pragma unroll 1
    for (int i = 0; i < NR; ++i) {
        const int m = m0 + i;
        f32x4 v[4]; float s = 0.f;
#pragma unroll
        for (int j = 0; j < 4; ++j) { typedef float f32x2y __attribute__((ext_vector_type(2))); const f32x2y y01 = __builtin_amdgcn_cvt_pk_f32_fp8((int)yn[j], false), y23 = __builtin_amdgcn_cvt_pk_f32_fp8((int)yn[j], true); const f32x4 y = (f32x4){y01.x, y01.y, y23.x, y23.y};
            v[j] = xn[j] * ALPHA + gt[j] * y; s += (v[j].x + v[j].y) + (v[j].z + v[j].w); }
        if (i + 1 < NR) LN_LOAD(m + 1);
        const float mean = wave_sum(s) * (1.f / D); float s2 = 0.f;
#pragma unroll
        for (int j = 0; j < 4; ++j) { v[j] = v[j] - mean; s2 += (v[j].x * v[j].x + v[j].y * v[j].y) + (v[j].z * v[j].z + v[j].w * v[j].w); }
        const float rstd = 1.f / sqrtf(wave_sum(s2) * (1.f / D) + LN_EPS);
        f32x4 uu[4];
#pragma unroll
        for (int j = 0; j < 4; ++j) { const int d = 4 * lane + 256 * j;
            const f32x4 o = v[j] * rstd * lg[j] + lb[j];
            if (I == 2) *(f32x4*)(F.out + (size_t)m * D + d) = o;
            else { v2u ow; ow.x = pk2(o.x, o.y); ow.y = pk2(o.z, o.w); *(GAS v2u*)((I == 0 ? (bf16*)F.out : (bf16*)(F.ws + WS_X2B)) + (size_t)m * D + d) = ow; }
            if (I < 2) { const f32x4 u = o * sc[j] + sh[j];
                if (I == 1 && F8_FFN2) *(GAS unsigned*)((unsigned char*)XM + (size_t)m * D + d) = pg8::pk4_fp8(u.x, u.y, u.z, u.w);
                else { v2u w; w.x = pk2(u.x, u.y); w.y = pk2(u.z, u.w); *(GAS v2u*)(XM + (size_t)m * D + d) = w; }
                uu[j] = u; }
        }
        if (AB) {
            float pa[8];
#pragma unroll
            for (int q = 0; q < 8; ++q) { typedef float f32x2s __attribute__((ext_vector_type(2))); f32x2s a2 = {0.f, 0.f};
#pragma unroll
                for (int j = 0; j < 4; ++j) { const f32x4 wv = *(const LAS f32x4*)(W8 + q * D + 4 * lane + 256 * j);
                    a2 = a2 + (f32x2s){uu[j].x, uu[j].y} * (f32x2s){wv.x, wv.y}; a2 = a2 + (f32x2s){uu[j].z, uu[j].w} * (f32x2s){wv.z, wv.w}; }
                float a_ = a2.x + a2.y;
                asm volatile("" : "+v"(a_));
                pa[q] = a_; }
            float p4[4], p2[2];
#define LN_XDPP(v_, ctrl_) __builtin_bit_cast(float, __builtin_amdgcn_update_dpp(0, __builtin_bit_cast(int, v_), ctrl_, 0xF, 0xF, false))
#pragma unroll
            for (int q = 0; q < 4; ++q) { const float keep = (lane & 1) ? pa[q + 4] : pa[q], give = (lane & 1) ? pa[q] : pa[q + 4]; p4[q] = keep + LN_XDPP(give, 0xB1); }
#pragma unroll
            for (int q = 0; q < 2; ++q) { const float keep = (lane & 2) ? p4[q + 2] : p4[q], give = (lane & 2) ? p4[q] : p4[q + 2]; p2[q] = keep + LN_XDPP(give, 0x4E); }
            float p1; { const float keep = (lane & 4) ? p2[1] : p2[0], give = (lane & 4) ? p2[0] : p2[1]; p1 = keep + __shfl_xor(give, 4); }
            p1 += LN_XDPP(p1, 0x128); p1 += __shfl_xor(p1, 16); p1 += __shfl_xor(p1, 32);
#undef LN_XDPP
            if (NR == 8) psel = ((lane >> 3) == i) ? p1 : psel;
            else if (lane < 8) ab_tail(F, m, lane, p1);
        }
    }
    if (AB && NR == 8) ab_tail(F, m0 + (lane >> 3), lane, psel);
#undef LN_LOAD
}
template <int I, bool AB = (I == 0)>
__device__ __forceinline__ void ln_pass(Frame& F, float yscale) {
    const int gw = F.vcu * NWAVES + F.wave, NGW = F.G * NWAVES;
    LAS float* W8 = (LAS float*)(F.lds + RING_OFF);
    if (AB) {
        for (int e = F.tid; e < 8 * D; e += NWAVES * 64) { const int d = e >> 3, j = e & 7; W8[j * D + d] = F.a->in[17][(size_t)d * PROJ + QKV + j]; }
        LDS_WAIT(); __syncthreads();
    }
    for (int m0 = 8 * gw; m0 < MP; m0 += 8 * NGW) ln_rows<I, AB, 8>(F, m0, yscale, W8, (const bf16*)(F.ws + WS_Y), (bf16*)(F.ws + WS_XM));
    for (int m = MP + F.wave * F.G + F.vcu; m < M; m += NGW) ln_rows<I, AB, 1>(F, m, yscale, W8, (const bf16*)(F.ws + WS_Y), (bf16*)(F.ws + WS_XM));
    if (AB) { LDS_WAIT(); __syncthreads(); }
}

constexpr size_t WS_YS = WS_HP + (size_t)M * NIN * 2;
template <int I>
__device__ __forceinline__ void ln_sample(Frame& F, float yscale, bf16* XMbase) {
    const int gw = F.vcu * NWAVES + F.wave, NGW = F.G * NWAVES;
    for (int m = MP + gw; m < M; m += NGW) ln_rows<I, false, 1>(F, m, yscale, nullptr, (const bf16*)(F.ws + WS_YS) - (size_t)MP * D, XMbase);
}

__device__ __forceinline__ void ab_rows(Frame& F, int first_wg) {
    LAS float* W8 = (LAS float*)(F.lds + RING_OFF);
    for (int e = F.tid; e < 8 * D; e += NWAVES * 64) { const int d = e >> 3, j = e & 7; W8[j * D + d] = F.a->in[17][(size_t)d * PROJ + QKV + j]; }
    LDS_WAIT(); __syncthreads();
    const int gw = ((int)blockIdx.x - first_wg) * NWAVES + F.wave, ngw = (F.G - first_wg) * NWAVES, lane = F.lane;
    const bf16* XM = (const bf16*)(F.ws + WS_XM); float* GB = (float*)(F.ws + WS_GB);
    for (int m = gw; m < M; m += ngw) {
        const v4u x0 = *(const GAS v4u*)(XM + (size_t)m * D + 8 * lane), x1 = *(const GAS v4u*)(XM + (size_t)m * D + 512 + 8 * lane);
        float u[16];
        u[0] = bf_lo(x0.x); u[1] = bf_hi(x0.x); u[2] = bf_lo(x0.y); u[3] = bf_hi(x0.y); u[4] = bf_lo(x0.z); u[5] = bf_hi(x0.z); u[6] = bf_lo(x0.w); u[7] = bf_hi(x0.w);
        u[8] = bf_lo(x1.x); u[9] = bf_hi(x1.x); u[10] = bf_lo(x1.y); u[11] = bf_hi(x1.y); u[12] = bf_lo(x1.z); u[13] = bf_hi(x1.z); u[14] = bf_lo(x1.w); u[15] = bf_hi(x1.w);
        float pa[8];
#pragma unroll
        for (int q = 0; q < 8; ++q) { const LAS float* w = W8 + q * D + 8 * lane;
            const f32x4 w0 = *(const LAS f32x4*)w, w1 = *(const LAS f32x4*)(w + 4), w2 = *(const LAS f32x4*)(w + 512), w3 = *(const LAS f32x4*)(w + 516);
            float a_ = (u[0] * w0.x + u[1] * w0.y) + (u[2] * w0.z + u[3] * w0.w) + (u[4] * w1.x + u[5] * w1.y) + (u[6] * w1.z + u[7] * w1.w)
                     + (u[8] * w2.x + u[9] * w2.y) + (u[10] * w2.z + u[11] * w2.w) + (u[12] * w3.x + u[13] * w3.y) + (u[14] * w3.z + u[15] * w3.w);
            asm volatile("" : "+v"(a_));
            pa[q] = a_; }
        float p4[4], p2[2];
#pragma unroll
        for (int q = 0; q < 4; ++q) { const float keep = (lane & 1) ? pa[q + 4] : pa[q], give = (lane & 1) ? pa[q] : pa[q + 4]; p4[q] = keep + __shfl_xor(give, 1); }
#pragma unroll
        for (int q = 0; q < 2; ++q) { const float keep = (lane & 2) ? p4[q + 2] : p4[q], give = (lane & 2) ? p4[q] : p4[q + 2]; p2[q] = keep + __shfl_xor(give, 2); }
        float p1; { const float keep = (lane & 4) ? p2[1] : p2[0], give = (lane & 4) ? p2[0] : p2[1]; p1 = keep + __shfl_xor(give, 4); }
        p1 += __shfl_xor(p1, 8); p1 += __shfl_xor(p1, 16); p1 += __shfl_xor(p1, 32);
        if (lane < 8) { const int q = 4 * (lane & 1) + 2 * ((lane >> 1) & 1) + ((lane >> 2) & 1), h = q & 3;
            if (q < 4) { const float z = p1 + F.a->in[20][h]; const float sp = z > 20.f ? z : log1pf(__expf(z)); GB[(size_t)m * 4 + h] = -__expf(F.a->in[19][h]) * sp; }
            else GB[(size_t)M * 4 + (size_t)m * 4 + h] = 1.f / (1.f + __expf(-p1)); }
    }
    LDS_WAIT(); __syncthreads();
}
constexpr int PQ_LD = 1536, PR_LD = 2048, PR_OG = 0, PR_SB = 512, PR_SC = 1024, PR_SH = 1536;
constexpr size_t WS_PQ = WS_HP, WS_PR = WS_HP + (size_t)M * PQ_LD * 2, WS_TAIL = WS_HP + (size_t)M * NIN * 2;
constexpr size_t FRB_AW = WS_Y, FRB_AQD = WS_Y + 16 * MiB;
constexpr size_t FRB_AQK = WS_TAIL, FRB_U = WS_TAIL + 8 * MiB, FRB_GL = WS_GL;
constexpr size_t FRB_SH = WS_PQ;
static_assert(FRB_AQD + 16 * MiB <= WS_HP && FRB_U + 16 * MiB <= WS_XCH && WS_XCH + 3 * 512 * KiB <= WS_END && (size_t)32 * MiB <= (size_t)MP * PQ_LD * 2, "fragment map");
constexpr size_t FRB_AKD = WS_W2U;
static_assert(FRB_AKD + 16 * MiB <= WS_WIN, "AKD inside the FFN2 weight region");
__device__ __forceinline__ unsigned char* fr_akd(const Frame& F) { return F.ws + FRB_AKD; }

__device__ __forceinline__ void unpack8(const v4u w, float (&f)[8]) {
    f[0] = bf_lo(w.x); f[1] = bf_hi(w.x); f[2] = bf_lo(w.y); f[3] = bf_hi(w.y); f[4] = bf_lo(w.z); f[5] = bf_hi(w.z); f[6] = bf_lo(w.w); f[7] = bf_hi(w.w);
}
__device__ __forceinline__ void d1_prefetch_tile(Frame& F, int ci, v4u (&rv)[13]) {
    const int bh = ci >> 5, n = ci & 31, b = bh >> 2, h = bh & 3, row0 = b * T + 64 * n;
    int tid_l = F.tid; asm volatile("" : "+v"(tid_l));
    const bf16* P = (const bf16*)(F.ws + WS_PQ);
#pragma unroll
    for (int it = 0; it < 13; ++it) { const int p = (tid_l - 256) + 256 * it, r = p / 48, q = p % 48, part = q >> 4, c8 = q & 15, tok = r - 3;
        rv[it] = (v4u){0u, 0u, 0u, 0u};
        if (p < 67 * 48 && (n > 0 || tok >= 0)) rv[it] = *(const GAS v4u*)(P + (size_t)(row0 + tok) * PQ_LD + part * 512 + h * 128 + c8 * 8); }
}
__device__ __forceinline__ void d1_scalars(Frame& F, int ci, LAS float* SCf) {
    const int bh = ci >> 5, n = ci & 31, b = bh >> 2, h = bh & 3, row0 = b * T + 64 * n, lane = F.lane;
    const float* GB = (const float*)(F.ws + WS_GB);
    const float gv = GB[(size_t)(row0 + lane) * 4 + h], bt = GB[(size_t)M * 4 + (size_t)(row0 + lane) * 4 + h];
    float gc = gv;
#pragma unroll
    for (int o = 1; o < 64; o <<= 1) { const float t = __shfl_up(gc, o); if (lane >= o) gc += t; }
    const float glast = __shfl(gc, 63);
    SCf[lane] = gc; SCf[64 + lane] = bt; SCf[128 + lane] = __expf(gc); SCf[192 + lane] = __expf(glast - gc);
    if (lane == 0) ((float*)(F.ws + FRB_GL))[ci] = __expf(glast);
}
__device__ __forceinline__ void d1_unit(Frame& F, int ci, int ci_next, v4u (&rv)[13]) {
    constexpr int RAW = 0, RAWS = 768, KBI = 0, KHI = 17408, QHI = 34816, IMS = 272, VB = 52224, KG = 84992, SC = 117760, CW = 118784;
    constexpr int LM = 0, QKI = 17408, QKS = 136, WIM = 34816;
    const int bh = ci >> 5, n = ci & 31, b = bh >> 2, h = bh & 3, row0 = b * T + 64 * n;
    int tid_l = F.tid; asm volatile("" : "+v"(tid_l));
    const int tid = tid_l, lane = tid & 63, wave = F.wave;
    LAS unsigned char* L = F.lds;
    LAS float* SCf = (LAS float*)(L + SC);
    LAS float* CWf = (LAS float*)(L + CW);
    const bf16* P = (const bf16*)(F.ws + WS_PQ);
    const float* GB = (const float*)(F.ws + WS_GB);
    if (wave >= 4) {
#pragma unroll
        for (int it = 0; it < 13; ++it) { const int p = (tid - 256) + 256 * it, r = p / 48, q = p % 48; if (p < 67 * 48) *(LAS v4u*)(L + RAW + r * RAWS + q * 16) = rv[it]; }
        if (n == 31) {
            const int p = (tid - 256) + 256 * 12, r = p / 48, q = p % 48, part = q >> 4, c8 = q & 15;
            if (p < 67 * 48 && r >= 64) { float x[8]; unpack8(rv[12], x); float* cq = F.out + O_CQ_P + ((size_t)b * 3 + (r - 64)) * QKV + part * 512 + h * 128 + c8 * 8;
                *(f32x4*)cq = (f32x4){x[0], x[1], x[2], x[3]}; *(f32x4*)(cq + 4) = (f32x4){x[4], x[5], x[6], x[7]}; }
        }
    }
    LDS_WAIT(); __syncthreads();
    const int tok = tid >> 3, sub = tid & 7;
    float val[6][8];
#pragma unroll
    for (int i = 0; i < 6; ++i) { const int cg = (i >> 1) * 16 + (i & 1) * 8 + sub;
        float a[8];
#pragma unroll
        for (int e = 0; e < 8; ++e) a[e] = 0.f;
#pragma unroll
        for (int tap = 0; tap < 4; ++tap) { float x[8]; unpack8(*(const LAS v4u*)(L + RAW + (tok + tap) * RAWS + cg * 16), x);
            const f32x4 w0 = *(const LAS f32x4*)(CWf + tap * 384 + cg * 8), w1 = *(const LAS f32x4*)(CWf + tap * 384 + cg * 8 + 4);
            a[0] += x[0] * w0.x; a[1] += x[1] * w0.y; a[2] += x[2] * w0.z; a[3] += x[3] * w0.w; a[4] += x[4] * w1.x; a[5] += x[5] * w1.y; a[6] += x[6] * w1.z; a[7] += x[7] * w1.w; }
#pragma unroll
        for (int e = 0; e < 8; ++e) val[i][e] = silu_f(a[e]); }
    float sq = 0.f, sk = 0.f;
#pragma unroll
    for (int e = 0; e < 8; ++e) { sq += val[0][e] * val[0][e] + val[1][e] * val[1][e]; sk += val[2][e] * val[2][e] + val[3][e] * val[3][e]; }
#define D1_DPP(v_, ctrl_) __builtin_bit_cast(float, __builtin_amdgcn_update_dpp(0, __builtin_bit_cast(int, v_), ctrl_, 0xF, 0xF, false))
    sq += D1_DPP(sq, 0xB1); sk += D1_DPP(sk, 0xB1); sq += D1_DPP(sq, 0x4E); sk += D1_DPP(sk, 0x4E); sq += D1_DPP(sq, 0x141); sk += D1_DPP(sk, 0x141);
#undef D1_DPP
    const float rq = rsqrtf(sq + 1e-6f) * 0.08838834764831845f, rk = rsqrtf(sk + 1e-6f);
    const float bt = SCf[64 + tok], egt = SCf[128 + tok];
    LDS_WAIT(); __syncthreads();
    unsigned char* AQD = F.ws + FRB_AQD + (size_t)ci * 16384;
#pragma unroll
    for (int i = 0; i < 2; ++i) { const int dk0 = (i * 8 + sub) * 8;
        float q[8];
#pragma unroll
        for (int e = 0; e < 8; ++e) q[e] = val[i][e] * rq;
        v4u w; w.x = pk2(q[0], q[1]); w.y = pk2(q[2], q[3]); w.z = pk2(q[4], q[5]); w.w = pk2(q[6], q[7]);
        *(LAS v4u*)(L + QHI + tok * IMS + dk0 * 2) = w;
        const int s = dk0 >> 5, jh = (dk0 >> 4) & 1, g2 = (dk0 >> 3) & 1, mt = tok >> 4, m = tok & 15;
#pragma unroll
        for (int half = 0; half < 2; ++half) { const int g = 2 * g2 + half;
            v2u o; o.x = pk2(q[4 * half] * egt, q[4 * half + 1] * egt); o.y = pk2(q[4 * half + 2] * egt, q[4 * half + 3] * egt);
            *(GAS v2u*)(AQD + ((size_t)((mt * 4 + s) * 64 + m + 16 * g) * 8 + 4 * jh) * 2) = o; } }
#pragma unroll
    for (int i = 0; i < 2; ++i) { const int dk0 = (i * 8 + sub) * 8;
        float k[8];
#pragma unroll
        for (int e = 0; e < 8; ++e) k[e] = val[2 + i][e] * rk;
        v4u w; w.x = pk2(k[0], k[1]); w.y = pk2(k[2], k[3]); w.z = pk2(k[4], k[5]); w.w = pk2(k[6], k[7]);
        *(LAS v4u*)(L + KHI + tok * IMS + dk0 * 2) = w;
        v4u wb; wb.x = pk2(k[0] * bt, k[1] * bt); wb.y = pk2(k[2] * bt, k[3] * bt); wb.z = pk2(k[4] * bt, k[5] * bt); wb.w = pk2(k[6] * bt, k[7] * bt);
        *(LAS v4u*)(L + KBI + tok * IMS + dk0 * 2) = wb;
        const float f = bt * egt;
        *(LAS f32x4*)(L + KG + tok * 512 + dk0 * 4) = (f32x4){k[0] * f, k[1] * f, k[2] * f, k[3] * f};
        *(LAS f32x4*)(L + KG + tok * 512 + dk0 * 4 + 16) = (f32x4){k[4] * f, k[5] * f, k[6] * f, k[7] * f}; }
#pragma unroll
    for (int i = 0; i < 2; ++i) { const int dv0 = (i * 8 + sub) * 8;
        *(LAS f32x4*)(L + VB + tok * 512 + dv0 * 4) = (f32x4){val[4 + i][0] * bt, val[4 + i][1] * bt, val[4 + i][2] * bt, val[4 + i][3] * bt};
        *(LAS f32x4*)(L + VB + tok * 512 + dv0 * 4 + 16) = (f32x4){val[4 + i][4] * bt, val[4 + i][5] * bt, val[4 + i][6] * bt, val[4 + i][7] * bt}; }
    LDS_WAIT(); __syncthreads();
    const int kind = wave >> 2, ti = wave & 3, m16 = lane & 15, g4 = lane >> 4;
    f32x4 acc[4];
#pragma unroll
    for (int tj = 0; tj < 4; ++tj) acc[tj] = (f32x4){0.f, 0.f, 0.f, 0.f};
    {
        bf16x8 Af[4], Bf[4][4];
#pragma unroll
        for (int s = 0; s < 4; ++s) { Af[s] = *(const LAS bf16x8*)(L + (kind == 0 ? KBI : QHI) + (16 * ti + m16) * IMS + (32 * s + 8 * g4) * 2);
#pragma unroll
            for (int tj = 0; tj < 4; ++tj) Bf[s][tj] = *(const LAS bf16x8*)(L + KHI + (16 * tj + m16) * IMS + (32 * s + 8 * g4) * 2); }
        __builtin_amdgcn_sched_barrier(0);
#pragma unroll
        for (int s = 0; s < 4; ++s)
#pragma unroll
            for (int tj = 0; tj < 4; ++tj) if (tj <= ti) acc[tj] = __builtin_amdgcn_mfma_f32_16x16x32_bf16(Af[s], Bf[s][tj], acc[tj], 0, 0, 0);
    }
    {
        unsigned char* AKD = fr_akd(F) + (size_t)ci * 16384;
#pragma unroll
        for (int rep = 0; rep < 2; ++rep) { const int lf = tid + 512 * rep, frag = lf >> 6, ln = lf & 63, Tt = frag >> 1, s2 = frag & 1, m = ln & 15, g = ln >> 4;
            float kd[8];
#pragma unroll
            for (int j = 0; j < 8; ++j) { const int tk = 32 * s2 + 16 * (j >> 2) + 4 * g + (j & 3);
                const unsigned short hv = *(const LAS unsigned short*)(L + KHI + tk * IMS + (16 * Tt + m) * 2);
                kd[j] = __builtin_bit_cast(float, (unsigned)hv << 16) * SCf[192 + tk]; }
            v4u o; o.x = pk2(kd[0], kd[1]); o.y = pk2(kd[2], kd[3]); o.z = pk2(kd[4], kd[5]); o.w = pk2(kd[6], kd[7]);
            *(GAS v4u*)(AKD + (size_t)lf * 16) = o; }
    }
    LDS_WAIT(); __syncthreads();
#pragma unroll
    for (int tj = 0; tj < 4; ++tj)
#pragma unroll
        for (int r = 0; r < 4; ++r) { const int i = 16 * ti + 4 * g4 + r, j = 16 * tj + m16;
            const float dec = (tj <= ti && i >= j) ? __expf(SCf[i] - SCf[j]) : 0.f;
            const float v = (tj <= ti) ? acc[tj][r] * dec : 0.f;
            if (kind == 0) { if (tj <= ti) *(LAS float*)(L + LM + ((i >> 2) * 64 + j) * 16 + (i & 3) * 4) = (i > j) ? v : 0.f; }
            else *(LAS unsigned short*)(L + QKI + i * QKS + j * 2) = (unsigned short)f2bf(v); }
    LDS_WAIT(); __syncthreads();
    if (wave < 4) {
        const int c = tid;
        const LAS unsigned char* rhsp = L + (c < 128 ? VB : KG) + (c & 127) * 4;
        typedef float f32x2s __attribute__((ext_vector_type(2)));
        {
        float x[64];
#pragma unroll
        for (int blk = 0; blk < 16; ++blk) { const int i0 = 4 * blk;
            f32x2s sa, sb;
            sa.x = *(const LAS float*)(rhsp + (i0 + 0) * 512); sa.y = *(const LAS float*)(rhsp + (i0 + 1) * 512);
            sb.x = *(const LAS float*)(rhsp + (i0 + 2) * 512); sb.y = *(const LAS float*)(rhsp + (i0 + 3) * 512);
            f32x2s ta = {0.f, 0.f}, tb = {0.f, 0.f};
#pragma unroll
            for (int jb = 0; jb < i0; jb += 16) {
                f32x4 l[16];
#pragma unroll
                for (int q = 0; q < 16; ++q) if (jb + q < i0) l[q] = *(const LAS f32x4*)(L + LM + (blk * 64 + jb + q) * 16);
                __builtin_amdgcn_sched_barrier(0);
#pragma unroll
                for (int q = 0; q < 16; q += 2) if (jb + q < i0) {
                    sa = sa - (f32x2s){l[q].x, l[q].y} * x[jb + q]; sb = sb - (f32x2s){l[q].z, l[q].w} * x[jb + q];
                    ta = ta - (f32x2s){l[q + 1].x, l[q + 1].y} * x[jb + q + 1]; tb = tb - (f32x2s){l[q + 1].z, l[q + 1].w} * x[jb + q + 1]; }
            }
            sa = sa + ta; sb = sb + tb;
            const f32x4 d0 = *(const LAS f32x4*)(L + LM + (blk * 64 + i0) * 16), d1 = *(const LAS f32x4*)(L + LM + (blk * 64 + i0 + 1) * 16), d2 = *(const LAS f32x4*)(L + LM + (blk * 64 + i0 + 2) * 16);
            x[i0] = sa.x;
            x[i0 + 1] = sa.y - d0.y * x[i0];
            sb = sb - (f32x2s){d0.z, d0.w} * x[i0];
            sb = sb - (f32x2s){d1.z, d1.w} * x[i0 + 1];
            x[i0 + 2] = sb.x;
            x[i0 + 3] = sb.y - d2.w * x[i0 + 2];
        }
        if (c < 128) {
            unsigned char* U = F.ws + FRB_U + (size_t)ci * 16384 + (size_t)(c >> 4) * 2048;
#pragma unroll
            for (int mt = 0; mt < 4; ++mt)
#pragma unroll
                for (int g = 0; g < 4; ++g) { const int t0 = 16 * mt + 4 * g; v2u o; o.x = pk2(x[t0], x[t0 + 1]); o.y = pk2(x[t0 + 2], x[t0 + 3]);
                    *(GAS v2u*)(U + (size_t)(mt * 64 + (c & 15) + 16 * g) * 8) = o; }
        } else {
            const int dk = c - 128;
#pragma unroll
            for (int i = 0; i < 64; ++i) *(LAS unsigned short*)(L + WIM + i * IMS + dk * 2) = (unsigned short)f2bf(x[i]);
        }
        }
#pragma unroll
        for (int it = 0; it < 13; ++it) asm volatile("" : "=v"(rv[it]));
    } else {
        unsigned char* AQK = F.ws + FRB_AQK + (size_t)ci * 8192;
#pragma unroll
        for (int rep = 0; rep < 2; ++rep) { const int lf = (tid - 256) + 256 * rep, frag = lf >> 6, ln = lf & 63, mt = frag >> 1, s2 = frag & 1, m = ln & 15, g = ln >> 4;
            const v2u a = *(const LAS v2u*)(L + QKI + (16 * mt + m) * QKS + (32 * s2 + 4 * g) * 2);
            const v2u bq = *(const LAS v2u*)(L + QKI + (16 * mt + m) * QKS + (32 * s2 + 16 + 4 * g) * 2);
            *(GAS v4u*)(AQK + (size_t)lf * 16) = (v4u){a.x, a.y, bq.x, bq.y}; }
        if (ci_next < 1024) { d1_prefetch_tile(F, ci_next, rv); if (wave == 4) d1_scalars(F, ci_next, SCf); }
        else {
#pragma unroll
            for (int it = 0; it < 13; ++it) asm volatile("" : "=v"(rv[it])); }
    }
    LDS_WAIT(); __syncthreads();
    {
        unsigned char* AW = F.ws + FRB_AW + (size_t)ci * 16384;
#pragma unroll
        for (int rep = 0; rep < 2; ++rep) { const int lf = tid + 512 * rep, frag = lf >> 6, ln = lf & 63, mt = frag >> 2, s = frag & 3, m = ln & 15, g = ln >> 4;
            const v2u a = *(const LAS v2u*)(L + WIM + (16 * mt + m) * IMS + (32 * s + 4 * g) * 2);
            const v2u bq = *(const LAS v2u*)(L + WIM + (16 * mt + m) * IMS + (32 * s + 16 + 4 * g) * 2);
            *(GAS v4u*)(AW + (size_t)lf * 16) = (v4u){a.x, a.y, bq.x, bq.y}; }
    }
    LDS_WAIT(); __syncthreads();
}
template <int ABL = 0>
__device__ __forceinline__ void scan_phase(Frame& F) {
    if ((int)blockIdx.x >= 64) return;
    constexpr int BUFB = 40960;
    const int unit = (int)blockIdx.x, bh = unit & 31, half = unit >> 5, lane = F.lane, wave = F.wave;
    LAS unsigned char* L = F.lds;
    if (wave >= 4) {
        __builtin_amdgcn_s_setprio(3);
        const int lw = wave - 4;
        const unsigned char* src[10];
#pragma unroll
        for (int i = 0; i < 10; ++i) { const int p = 10 * lw + i;
            src[i] = (p < 16 ? F.ws + FRB_AW + (size_t)p * 1024 : p < 32 ? fr_akd(F) + (size_t)(p - 16) * 1024 : F.ws + FRB_U + (size_t)half * 8192 + (size_t)(p - 32) * 1024) + (size_t)bh * 32 * 16384 + lane * 16; }
#define SCAN_ISSUE(c_, buf_) do { _Pragma("unroll") for (int i_ = 0; i_ < 10; ++i_) \
            __builtin_amdgcn_global_load_lds((const unsigned*)(src[i_] + (size_t)(c_) * 16384), (LAS unsigned*)(L + (buf_) * BUFB + (10 * lw + i_) * 1024), 16, 0, 0); } while (0)
        if (!(ABL & 8)) { SCAN_ISSUE(0, 0); SCAN_ISSUE(1, 1); }
        int nb = 2;
        for (int n = 0; n < 32; ++n) {
            if (!(ABL & 8)) asm volatile("s_waitcnt vmcnt(10)" ::: "memory");
            __builtin_amdgcn_s_barrier();
            asm volatile("" ::: "memory");
            const int c = n + 2 < 32 ? n + 2 : 31;
            if (!(ABL & 8)) SCAN_ISSUE(c, nb); nb = nb == 2 ? 0 : nb + 1;
        }
        asm volatile("s_waitcnt vmcnt(0)" ::: "memory");
#undef SCAN_ISSUE
    } else {
        const int dvl = lane & 15, g = lane >> 4, sl = 4 * half + wave;
        const float* GL = (const float*)(F.ws + FRB_GL) + bh * 32;
        unsigned char* SH = F.ws + FRB_SH + ((size_t)bh * 32 * 8 + sl) * 4096 + lane * 16;
        f32x4 St[8];
#pragma unroll
        for (int t = 0; t < 8; ++t) St[t] = (f32x4){0.f, 0.f, 0.f, 0.f};
        const float glv = __hip_atomic_load(GL + (lane & 31), __ATOMIC_RELAXED, __HIP_MEMORY_SCOPE_AGENT);
        int cb = 0;
        for (int n = 0; n < 32; ++n) {
            const float gl = __builtin_bit_cast(float, __builtin_amdgcn_readlane(__builtin_bit_cast(int, glv), n));
            v4u Bw[4];
#pragma unroll
            for (int s = 0; s < 4; ++s) { Bw[s].x = pk2(St[2 * s][0], St[2 * s][1]); Bw[s].y = pk2(St[2 * s][2], St[2 * s][3]); Bw[s].z = pk2(St[2 * s + 1][0], St[2 * s + 1][1]); Bw[s].w = pk2(St[2 * s + 1][2], St[2 * s + 1][3]);
                if (ABL & 1) asm volatile("" :: "v"(Bw[s])); else *(GAS v4u*)(SH + (size_t)n * 32768 + s * 1024) = Bw[s]; }
            __builtin_amdgcn_s_barrier();
            asm volatile("" ::: "memory");
            const LAS unsigned char* B = L + cb * BUFB + lane * 16;
            f32x4 accA[4];
#pragma unroll
            for (int mt = 0; mt < 4; ++mt) accA[mt] = (f32x4){0.f, 0.f, 0.f, 0.f};
#pragma unroll
            for (int s = 0; s < 4; ++s)
#pragma unroll
                for (int mt = 0; mt < 4; ++mt) accA[mt] = __builtin_amdgcn_mfma_f32_16x16x32_bf16(*(const LAS bf16x8*)(B + (mt * 4 + s) * 1024), __builtin_bit_cast(bf16x8, Bw[s]), accA[mt], 0, 0, 0);
            f32x4 vn[4];
#pragma unroll
            for (int mt = 0; mt < 4; ++mt) { const v2u uw = *(const LAS v2u*)(L + cb * BUFB + 32768 + wave * 2048 + (mt * 64 + lane) * 8);
                vn[mt] = (f32x4){bf_lo(uw.x), bf_hi(uw.x), bf_lo(uw.y), bf_hi(uw.y)} - accA[mt]; }
            bf16x8 Bv[2];
#pragma unroll
            for (int s2 = 0; s2 < 2; ++s2) { v4u w; w.x = pk2(vn[2 * s2][0], vn[2 * s2][1]); w.y = pk2(vn[2 * s2][2], vn[2 * s2][3]); w.z = pk2(vn[2 * s2 + 1][0], vn[2 * s2 + 1][1]); w.w = pk2(vn[2 * s2 + 1][2], vn[2 * s2 + 1][3]);
                Bv[s2] = __builtin_bit_cast(bf16x8, w); }
#pragma unroll
            for (int t = 0; t < 8; ++t) St[t] = St[t] * gl;
#pragma unroll
            for (int s2 = 0; s2 < 2; ++s2)
#pragma unroll
                for (int t = 0; t < 8; ++t) St[t] = __builtin_amdgcn_mfma_f32_16x16x32_bf16(*(const LAS bf16x8*)(B + 16384 + (t * 2 + s2) * 1024), Bv[s2], St[t], 0, 0, 0);
            cb = cb == 2 ? 0 : cb + 1;
        }
        float* So = F.out + O_SSM_P + (size_t)bh * 128 * 128;
#pragma unroll
        for (int t = 0; t < 8; ++t)
#pragma unroll
            for (int r = 0; r < 4; ++r) So[(size_t)(16 * t + 4 * g + r) * 128 + 16 * sl + dvl] = St[t][r];
    }
}
__device__ __forceinline__ float dpp_add(float v, const int ctrl_sel) {
    const int iv = __builtin_bit_cast(int, v); int o;
    if (ctrl_sel == 0) o = __builtin_amdgcn_update_dpp(0, iv, 0xB1, 0xF, 0xF, true);
    else if (ctrl_sel == 1) o = __builtin_amdgcn_update_dpp(0, iv, 0x4E, 0xF, 0xF, true);
    else if (ctrl_sel == 2) o = __builtin_amdgcn_update_dpp(0, iv, 0x141, 0xF, 0xF, true);
    else o = __builtin_amdgcn_update_dpp(0, iv, 0x140, 0xF, 0xF, true);
    return v + __builtin_bit_cast(float, o);
}
__device__ __forceinline__ f32x4 row16_sum4(f32x4 v) {
#pragma unroll
    for (int st = 0; st < 4; ++st) { v.x = dpp_add(v.x, st); v.y = dpp_add(v.y, st); v.z = dpp_add(v.z, st); v.w = dpp_add(v.w, st); }
    return v;
}
template <int ABL = 0>
__device__ __forceinline__ void d3_phase(Frame& F) {
    constexpr int BUFB = 57344, RED = 114688;
    int tid_l = F.tid; asm volatile("" : "+v"(tid_l));
    const int lane = tid_l & 63, wave = F.wave, dvl = lane & 15, g = lane >> 4;
    LAS unsigned char* L = F.lds;
    LAS float* red = (LAS float*)(L + RED);
    bf16* MIX = (bf16*)(F.ws + WS_XM); const bf16* PR = (const bf16*)(F.ws + WS_PR);
    const float gdn = F.a->in[21][16 * wave + dvl];
    const int nk = (1024 - (int)blockIdx.x + F.G - 1) / F.G;
#define D3_ISSUE(ci_, buf_) do { _Pragma("unroll") for (int i_ = 0; i_ < 7; ++i_) { const int p_ = 7 * wave + i_; \
            const unsigned char* s_ = (p_ < 16 ? F.ws + FRB_AW + (size_t)(ci_) * 16384 + (size_t)p_ * 1024 : p_ < 32 ? F.ws + FRB_AQD + (size_t)(ci_) * 16384 + (size_t)(p_ - 16) * 1024 : \
                                       p_ < 40 ? F.ws + FRB_AQK + (size_t)(ci_) * 8192 + (size_t)(p_ - 32) * 1024 : F.ws + FRB_U + (size_t)(ci_) * 16384 + (size_t)(p_ - 40) * 1024) + lane * 16; \
            __builtin_amdgcn_global_load_lds((const unsigned*)s_, (LAS unsigned*)(L + (buf_) * BUFB + p_ * 1024), 16, 0,   2); } } while (0)
#define D3_LOADS(ci_, dst_) do { const unsigned char* sh_ = F.ws + FRB_SH + ((size_t)(ci_) * 8 + wave) * 4096 + lane * 16; \
            _Pragma("unroll") for (int s_ = 0; s_ < 4; ++s_) dst_[s_] = *(const GAS v4u*)(sh_ + s_ * 1024); } while (0)
#define D3_OG(ci_) do { const int bh_ = (ci_) >> 5, n_ = (ci_) & 31, r0_ = (bh_ >> 2) * T + 64 * n_, h_ = bh_ & 3; \
            _Pragma("unroll") for (int mt_ = 0; mt_ < 4; ++mt_) _Pragma("unroll") for (int r_ = 0; r_ < 4; ++r_) ogn[mt_][r_] = PR[(size_t)(r0_ + 16 * mt_ + 4 * g + r_) * PR_LD + PR_OG + h_ * 128 + 16 * wave + dvl]; } while (0)
    v4u Bn[4]; unsigned short ogn[4][4];
    if (nk > 0) { if (!(ABL & 8)) D3_ISSUE((int)blockIdx.x, 0); D3_LOADS((int)blockIdx.x, Bn); D3_OG((int)blockIdx.x); }
    for (int k = 0; k < nk; ++k) {
        const int ci = (int)blockIdx.x + k * F.G, bh = ci >> 5, n = ci & 31, b = bh >> 2, h = bh & 3, row0 = b * T + 64 * n;
        asm volatile("s_waitcnt vmcnt(0)" ::: "memory");
        __builtin_amdgcn_s_barrier();
        asm volatile("" ::: "memory");
        v4u Bw[4];
#pragma unroll
        for (int s = 0; s < 4; ++s) Bw[s] = Bn[s];
        if (k + 1 < nk) { if (!(ABL & 8)) D3_ISSUE(ci + F.G, (k + 1) & 1); if (!(ABL & 16)) D3_LOADS(ci + F.G, Bn); }
        unsigned short ogv[4][4];
#pragma unroll
        for (int mt = 0; mt < 4; ++mt)
#pragma unroll
            for (int r = 0; r < 4; ++r) ogv[mt][r] = ogn[mt][r];
        if (k + 1 < nk) D3_OG(ci + F.G);
        const LAS unsigned char* B = L + (k & 1) * BUFB + lane * 16;
        f32x4 accA[4], accO[4];
#pragma unroll
        for (int mt = 0; mt < 4; ++mt) { accA[mt] = (f32x4){0.f, 0.f, 0.f, 0.f}; accO[mt] = (f32x4){0.f, 0.f, 0.f, 0.f};
#pragma unroll
            for (int s = 0; s < 4; ++s) { accA[mt] = __builtin_amdgcn_mfma_f32_16x16x32_bf16(*(const LAS bf16x8*)(B + (mt * 4 + s) * 1024), __builtin_bit_cast(bf16x8, Bw[s]), accA[mt], 0, 0, 0);
                accO[mt] = __builtin_amdgcn_mfma_f32_16x16x32_bf16(*(const LAS bf16x8*)(B + 16384 + (mt * 4 + s) * 1024), __builtin_bit_cast(bf16x8, Bw[s]), accO[mt], 0, 0, 0); } }
        f32x4 vn[4];
#pragma unroll
        for (int mt = 0; mt < 4; ++mt) { const v2u uw = *(const LAS v2u*)(L + (k & 1) * BUFB + 40960 + wave * 2048 + (mt * 64 + lane) * 8);
            vn[mt] = (f32x4){bf_lo(uw.x), bf_hi(uw.x), bf_lo(uw.y), bf_hi(uw.y)} - accA[mt]; }
        bf16x8 Bv[2];
#pragma unroll
        for (int s2 = 0; s2 < 2; ++s2) { v4u w; w.x = pk2(vn[2 * s2][0], vn[2 * s2][1]); w.y = pk2(vn[2 * s2][2], vn[2 * s2][3]); w.z = pk2(vn[2 * s2 + 1][0], vn[2 * s2 + 1][1]); w.w = pk2(vn[2 * s2 + 1][2], vn[2 * s2 + 1][3]);
            Bv[s2] = __builtin_bit_cast(bf16x8, w); }
#pragma unroll
        for (int mt = 0; mt < 4; ++mt)
#pragma unroll
            for (int s2 = 0; s2 < 2; ++s2) accO[mt] = __builtin_amdgcn_mfma_f32_16x16x32_bf16(*(const LAS bf16x8*)(B + 32768 + (mt * 2 + s2) * 1024), Bv[s2], accO[mt], 0, 0, 0);
#pragma unroll
        for (int mt = 0; mt < 4; ++mt) { f32x4 ss = accO[mt] * accO[mt];
            ss = row16_sum4(ss);
            if (dvl == 0) *(LAS f32x4*)(red + wave * 64 + 16 * mt + 4 * g) = ss; }
        asm volatile("s_waitcnt lgkmcnt(0)" ::: "memory"); __builtin_amdgcn_s_barrier(); asm volatile("" ::: "memory");
        f32x4 tot[4];
#pragma unroll
        for (int mt = 0; mt < 4; ++mt) { f32x4 pr[8];
#pragma unroll
            for (int w = 0; w < 8; ++w) pr[w] = *(const LAS f32x4*)(red + w * 64 + 16 * mt + 4 * g);
            tot[mt] = ((pr[0] + pr[1]) + (pr[2] + pr[3])) + ((pr[4] + pr[5]) + (pr[6] + pr[7])); }
#pragma unroll
        for (int mt = 0; mt < 4; ++mt)
#pragma unroll
            for (int r = 0; r < 4; ++r) { const int tk = 16 * mt + 4 * g + r;
                const float rn = rsqrtf(tot[mt][r] * (1.f / 128.f) + 1e-6f);
                const float ogf = __builtin_bit_cast(float, (unsigned)ogv[mt][r] << 16);
                const unsigned ov = pk2(accO[mt][r] * rn * gdn * silu_f(ogf), 0.f) & 0xffffu;
                if (ABL & 1) asm volatile("" :: "v"(ov));
                else if (F8_WOUT) ((unsigned char*)MIX)[(size_t)(row0 + tk) * D + h * 128 + 16 * wave + dvl] = (unsigned char)__builtin_amdgcn_cvt_pk_fp8_f32(accO[mt][r] * rn * gdn * silu_f(ogf), 0.f, 0, false);
                else MIX[(size_t)(row0 + tk) * D + h * 128 + 16 * wave + dvl] = (bf16)ov; }
    }
    asm volatile("s_waitcnt vmcnt(0) lgkmcnt(0)" ::: "memory"); __builtin_amdgcn_s_barrier();
#undef D3_ISSUE
#undef D3_LOADS
#undef D3_OG
}
__device__ __forceinline__ void sc_rows(Frame& F, int first_wg) {
    const int gw = ((int)blockIdx.x - first_wg) * NWAVES + F.wave, NGW = (F.G - first_wg) * NWAVES, lane = F.lane;
    if (gw < 0) return;
    bf16* MIX = (bf16*)(F.ws + WS_XM); const bf16* PR = (const bf16*)(F.ws + WS_PR);
    f32x4 w0[3], w1[3];
#pragma unroll
    for (int i = 0; i < 3; ++i) { w0[i] = *(const f32x4*)(F.a->in[22] + i * 512 + lane * 8); w1[i] = *(const f32x4*)(F.a->in[22] + i * 512 + lane * 8 + 4); }
    for (int m = gw; m < M; m += NGW) {
        const bool prm = m < MP; const int t = prm ? (m & (T - 1)) : ((m - MP) & 3), sq = prm ? (m >> 11) : ((m - MP) >> 2);
        v4u cw[3], hw[3]; f32x4 sa[2], sbq[2];
#pragma unroll
        for (int i = 0; i < 3; ++i) { const int tt = t - 2 + i; cw[i] = (v4u){0u, 0u, 0u, 0u}; hw[i] = cw[i];
            if (tt >= 0) { cw[i] = *(const GAS v4u*)(PR + (size_t)(m - 2 + i) * PR_LD + PR_SC + lane * 8); hw[i] = *(const GAS v4u*)(PR + (size_t)(m - 2 + i) * PR_LD + PR_SH + lane * 8); } }
        const v4u sbw = *(const GAS v4u*)(PR + (size_t)m * PR_LD + PR_SB + lane * 8);
        if (!prm && t < 2) {
#pragma unroll
            for (int i = 0; i < 2; ++i) { sa[i] = (f32x4){0.f, 0.f, 0.f, 0.f}; sbq[i] = sa[i];
                if (t - 2 + i < 0) { const float* sb = F.a->in[4] + ((size_t)sq * 2 + (t + i)) * 512 + lane * 8; sa[i] = *(const f32x4*)sb; sbq[i] = *(const f32x4*)(sb + 4); } } }
        float zc[8], z2[8];
#pragma unroll
        for (int e = 0; e < 8; ++e) zc[e] = 0.f;
#pragma unroll
        for (int i = 0; i < 3; ++i) { const int tt = t - 2 + i; float z[8];
            if (tt >= 0) { float c[8], hh[8]; unpack8(cw[i], c); unpack8(hw[i], hh);
#pragma unroll
                for (int e = 0; e < 8; ++e) z[e] = c[e] * hh[e]; }
            else if (!prm && i < 2) { z[0] = sa[i].x; z[1] = sa[i].y; z[2] = sa[i].z; z[3] = sa[i].w; z[4] = sbq[i].x; z[5] = sbq[i].y; z[6] = sbq[i].z; z[7] = sbq[i].w; }
            else {
#pragma unroll
                for (int e = 0; e < 8; ++e) z[e] = 0.f; }
            zc[0] += z[0] * w0[i].x; zc[1] += z[1] * w0[i].y; zc[2] += z[2] * w0[i].z; zc[3] += z[3] * w0[i].w; zc[4] += z[4] * w1[i].x; zc[5] += z[5] * w1[i].y; zc[6] += z[6] * w1[i].z; zc[7] += z[7] * w1[i].w;
            if (i == 2) {
#pragma unroll
                for (int e = 0; e < 8; ++e) z2[e] = z[e]; }
        }
        float sb[8]; unpack8(sbw, sb);
        if (F8_WOUT) *(GAS v2u*)((unsigned char*)MIX + (size_t)m * D + 512 + lane * 8) = (v2u){pg8::pk4_fp8(sb[0] * zc[0], sb[1] * zc[1], sb[2] * zc[2], sb[3] * zc[3]), pg8::pk4_fp8(sb[4] * zc[4], sb[5] * zc[5], sb[6] * zc[6], sb[7] * zc[7])};
        else *(GAS v4u*)(MIX + (size_t)m * D + 512 + lane * 8) = (v4u){pk2(sb[0] * zc[0], sb[1] * zc[1]), pk2(sb[2] * zc[2], sb[3] * zc[3]), pk2(sb[4] * zc[4], sb[5] * zc[5]), pk2(sb[6] * zc[6], sb[7] * zc[7])};
        const int Tg = prm ? T : TS;
        if (t >= Tg - 2) { float* cm = F.out + (prm ? O_CM_P : O_CM_S) + ((size_t)sq * 2 + (t - (Tg - 2))) * 512 + lane * 8;
            *(f32x4*)cm = (f32x4){z2[0], z2[1], z2[2], z2[3]}; *(f32x4*)(cm + 4) = (f32x4){z2[4], z2[5], z2[6], z2[7]}; }
    }
}
__device__ __forceinline__ void p8_sample_unit(Frame& F, int unit) {
    int tid_l = F.tid; asm volatile("" : "+v"(tid_l));
    const int sq = unit >> 2, h = unit & 3, tid = tid_l, lane = tid & 63, wave = F.wave;
    LAS float* Lf = (LAS float*)F.lds;
    LAS float* QKV_ = Lf;
    LAS float* RED = Lf + 1536;
    LAS float* SCAL = Lf + 2048;
    LAS float* OB = Lf + 2080;
    const bf16* P = (const bf16*)(F.ws + WS_PQ); const bf16* PR = (const bf16*)(F.ws + WS_PR); const float* GB = (const float*)(F.ws + WS_GB);
    const int m0 = MP + 4 * sq;
    const int kq = tid >> 7, dv = tid & 127;
    float S[32];
    const float* S0 = F.a->in[2] + ((size_t)(sq * 4 + h) * 128 + 32 * kq) * 128 + dv;
#pragma unroll
    for (int i = 0; i < 32; ++i) S[i] = __builtin_nontemporal_load(S0 + (size_t)i * 128);
    float decv[4], btv[4];
#pragma unroll
    for (int t = 0; t < 4; ++t) { decv[t] = GB[(size_t)(m0 + t) * 4 + h]; btv[t] = GB[(size_t)M * 4 + (size_t)(m0 + t) * 4 + h]; }
    if (tid < 384) { const int part = tid >> 7, ch = tid & 127, c = part * 512 + h * 128 + ch;
        float xp[7];
#pragma unroll
        for (int i = 0; i < 3; ++i) xp[i] = F.a->in[3][((size_t)sq * 3 + i) * QKV + c];
#pragma unroll
        for (int t = 0; t < 4; ++t) xp[3 + t] = __builtin_bit_cast(float, (unsigned)P[(size_t)(m0 + t) * PQ_LD + c] << 16);
#pragma unroll
        for (int t = 1; t < 4; ++t) F.out[O_CQ_S + ((size_t)sq * 3 + (t - 1)) * QKV + c] = xp[3 + t];
        const float w0 = F.a->in[18][c], w1 = F.a->in[18][QKV + c], w2 = F.a->in[18][2 * QKV + c], w3 = F.a->in[18][3 * QKV + c];
#pragma unroll
        for (int t = 0; t < 4; ++t) QKV_[(part * 4 + t) * 128 + ch] = silu_f(xp[t] * w0 + xp[t + 1] * w1 + xp[t + 2] * w2 + xp[t + 3] * w3); }
    LDS_WAIT(); __syncthreads();
    {
        const int part = wave >> 2, t = wave & 3; const float a = QKV_[(part * 4 + t) * 128 + lane], bq = QKV_[(part * 4 + t) * 128 + 64 + lane];
        const float ss = wave_sum(a * a + bq * bq); const float rn = rsqrtf(ss + 1e-6f) * (part == 0 ? 0.08838834764831845f : 1.0f);
        QKV_[(part * 4 + t) * 128 + lane] = a * rn; QKV_[(part * 4 + t) * 128 + 64 + lane] = bq * rn; }
    LDS_WAIT(); __syncthreads();
#pragma unroll
    for (int t = 0; t < 4; ++t) {
        const float dec = __expf(decv[t]), bt = btv[t];
        const LAS float* qv = QKV_ + (0 * 4 + t) * 128 + 32 * kq; const LAS float* kv = QKV_ + (1 * 4 + t) * 128 + 32 * kq;
        float ks = 0.f;
#pragma unroll
        for (int i = 0; i < 32; ++i) { S[i] *= dec; ks += kv[i] * S[i]; }
        RED[kq * 128 + dv] = ks;
        LDS_WAIT(); __syncthreads();
        const float kS = (RED[dv] + RED[128 + dv]) + (RED[256 + dv] + RED[384 + dv]);
        const float vn = bt * (QKV_[(2 * 4 + t) * 128 + dv] - kS);
        float o = 0.f;
#pragma unroll
        for (int i = 0; i < 32; ++i) { S[i] += kv[i] * vn; o += qv[i] * S[i]; }
        LDS_WAIT(); __syncthreads();
        RED[kq * 128 + dv] = o;
        LDS_WAIT(); __syncthreads();
        if (kq == 0) OB[t * 128 + dv] = (RED[dv] + RED[128 + dv]) + (RED[256 + dv] + RED[384 + dv]);
        LDS_WAIT(); __syncthreads();
    }
    float* So = F.out + O_SSM_S + ((size_t)(sq * 4 + h) * 128 + 32 * kq) * 128 + dv;
#pragma unroll
    for (int i = 0; i < 32; ++i) So[(size_t)i * 128] = S[i];
    if (wave < 4) { const int t = wave; const float a = OB[t * 128 + lane], bq = OB[t * 128 + 64 + lane];
        const float rn = rsqrtf(wave_sum(a * a + bq * bq) * (1.f / 128.f) + 1e-6f);
        bf16* MIX = (bf16*)(F.ws + WS_XM);
        const float og0 = __builtin_bit_cast(float, (unsigned)PR[(size_t)(m0 + t) * PR_LD + PR_OG + h * 128 + lane] << 16), og1 = __builtin_bit_cast(float, (unsigned)PR[(size_t)(m0 + t) * PR_LD + PR_OG + h * 128 + 64 + lane] << 16);
        const float o0 = a * rn * F.a->in[21][lane] * silu_f(og0), o1 = bq * rn * F.a->in[21][64 + lane] * silu_f(og1);
        if (F8_WOUT) { ((unsigned char*)MIX)[(size_t)(m0 + t) * D + h * 128 + lane] = (unsigned char)__builtin_amdgcn_cvt_pk_fp8_f32(o0, 0.f, 0, false);
                       ((unsigned char*)MIX)[(size_t)(m0 + t) * D + h * 128 + 64 + lane] = (unsigned char)__builtin_amdgcn_cvt_pk_fp8_f32(o1, 0.f, 0, false); }
        else { MIX[(size_t)(m0 + t) * D + h * 128 + lane] = (bf16)f2bf(o0); MIX[(size_t)(m0 + t) * D + h * 128 + 64 + lane] = (bf16)f2bf(o1); } }
    LDS_WAIT(); __syncthreads();
}
__device__ __forceinline__ int opaque_i(int v) { asm volatile("" : "+v"(v)); return __builtin_amdgcn_readfirstlane(v); }
constexpr int N_PHASES = 14;
__global__ void __launch_bounds__(NWAVES * 64, 2) mk_fwd(Args args) {
    extern __shared__ __attribute__((aligned(16))) unsigned char lds[];
    Frame F;
    F.lds = (LAS unsigned char*)lds;
    F.MISC = (volatile LAS unsigned*)(F.lds + MISC_OFF);
    F.tid = threadIdx.x; F.lane = F.tid & 63; F.wave = __builtin_amdgcn_readfirstlane(F.tid >> 6);
    F.G = gridDim.x; { const int bx = blockIdx.x; F.vcu = (F.G % 8 == 0) ? (bx % 8) * (F.G / 8) + bx / 8 : bx; }
    F.a = &args;
    F.out = args.out; F.ws = args.ws;
    F.ctl = (gu32*)(F.ws + WS_CTL);
    for (int u = F.tid; u < (LDS_BYTES - LDSCTL_OFF) / 4; u += NWAVES * 64) ((LAS unsigned*)(F.lds + LDSCTL_OFF))[u] = 0u;
    for (int e = ((int)blockIdx.x * NWAVES * 64 + F.tid) * 4; e < NSEQ * D; e += F.G * NWAVES * 64 * 4) {
        const int row = e >> 10, col = e & (D - 1); const float* c = (row < NB ? args.in[5] + (size_t)row * D : args.in[6] + (size_t)(row - NB) * D) + col;
        const f32x4 a = *(const f32x4*)c; v2u o; o.x = pk2(silu_f(a.x), silu_f(a.y)); o.y = pk2(silu_f(a.z), silu_f(a.w));
        __hip_atomic_store((GAS unsigned long long*)((bf16*)(F.ws + WS_SILU) + e), (unsigned long long)o.x | ((unsigned long long)o.y << 32), __ATOMIC_RELAXED, __HIP_MEMORY_SCOPE_AGENT); }
    asm volatile("s_waitcnt vmcnt(0)" ::: "memory");
    __syncthreads();
    XcdBarrier bar = xcd_barrier_post((unsigned*)(F.ctl + CW_BAR), F.MISC + 8);
    xcd_barrier_census(bar);
    constexpr int lo = 0, hi = N_PHASES;
#ifndef PHASE_MASK
#define PHASE_MASK 0xFFFFF
#endif
#define IN(k) (((PHASE_MASK >> (k)) & 1) && lo <= (k) && (k) < hi)
#ifndef REP_MASK
#define REP_MASK 0
#endif
#ifndef GEMM_ALIGN
#define GEMM_ALIGN true
#endif
#ifndef GEMM_SP2
#define GEMM_SP2 true
#endif
#ifndef SCAN_ABL
#define SCAN_ABL 0
#endif
#ifndef D3_ABL
#define D3_ABL 0
#endif
#ifndef REP_SUB
#define REP_SUB 0
#endif
#define FRESH() do { int t_ = threadIdx.x; asm volatile("" : "+v"(t_)); F.tid = t_; F.lane = t_ & 63; } while (0)
#if REP_MASK
#define PHASE_BEGIN(k) _Pragma("unroll 1") for (int rep_ = 0; rep_ < 1 + ((REP_MASK >> (k)) & 1); ++rep_) { if (rep_) xcd_barrier(bar); FRESH();
#else
#define PHASE_BEGIN(k) if (IN(k)) { const int rep_ = 0; (void)rep_; FRESH();
#endif
#define PHASE_END(k) } if (IN(k) && IN((k) + 1)) xcd_barrier(bar);
    bf16* const XM = (bf16*)(F.ws + WS_XM); bf16* const Yb = (bf16*)(F.ws + WS_Y); bf16* const HB = (bf16*)(F.ws + WS_HP);

    PHASE_BEGIN(0) p0_ada(F); PHASE_END(0)
    PHASE_BEGIN(1) p1_mod(F); PHASE_END(1)
    PHASE_BEGIN(2)
        pg8::StaticOrder S; S.init(M, NUP, F.G, (int)blockIdx.x);
#if F8_FFN1
        { pg8::Gemm g{XM, (const bf16*)(F.ws + WS_W1U), M, NUP, D / 2}; pg8::EpiSwiglu8 E{(unsigned char*)HB, FF};
          pg8::gemm_phase<pg8::EpiSwiglu8, pg8::StaticOrder, GEMM_ALIGN, GEMM_SP2, 127 - F8_UP_SH>(F.lds + RING_OFF, g, S, E); }
#else
        { pg8::Gemm g{XM, (const bf16*)(F.ws + WS_W1U), M, NUP, D}; pg8::EpiSwiglu E{HB, FF};
          pg8::gemm_phase<pg8::EpiSwiglu, pg8::StaticOrder, GEMM_ALIGN, GEMM_SP2>(F.lds + RING_OFF, g, S, E); }
#endif
        PHASE_END(2)
    PHASE_BEGIN(3)
        pg8::StaticOrder S; S.init(MP, D, F.G, (int)blockIdx.x);
        pg8::EpiFp8P E{(unsigned char*)Yb, D};
#if F8_FFN1
        { pg8::Gemm g{HB, (const bf16*)(F.ws + WS_W1D), MP, D, FF / 2};
          pg8::gemm_phase<pg8::EpiFp8P, pg8::StaticOrder, true, true, 127 - F8_DN_SH + Y8_SH>(F.lds + RING_OFF, g, S, E); }
        sample_gemm8s<FF>(F, (const unsigned char*)HB + (size_t)MP * FF, F.ws + WS_W1D, (bf16*)((unsigned char*)Yb + (size_t)MP * D), 127 - F8_DN_SH + Y8_SH); PHASE_END(3)
#else
        { pg8::Gemm g{HB, (const bf16*)(F.ws + WS_W1D), MP, D, FF};
          pg8::gemm_phase<pg8::EpiBf16P, pg8::StaticOrder, true, true>(F.lds + RING_OFF, g, S, E); }
        sample_gemm<FF>(F, HB + (size_t)MP * FF, (const bf16*)(F.ws + WS_W1D), Yb + (size_t)MP * D); PHASE_END(3)
#endif
    PHASE_BEGIN(4) ln_pass<0>(F, 0.5f); PHASE_END(4)
    PHASE_BEGIN(5)
        pg8::Gemm g{XM, (const bf16*)(F.ws + WS_WIN), M, NIN, D}; pg8::StaticOrder S; S.init(M, NIN, F.G, (int)blockIdx.x);
        pg8::EpiWin E{(bf16*)(F.ws + WS_PQ), (bf16*)(F.ws + WS_PR), (float*)(F.ws + WS_GB), F.a->in[19], F.a->in[20], M};
        pg8::gemm_phase<pg8::EpiWin, pg8::StaticOrder, true, true>(F.lds + RING_OFF, g, S, E); PHASE_END(5)
    PHASE_BEGIN(6) {
        v4u rv[13]; const int ci0 = (int)blockIdx.x;
        if (ci0 < 1024) {
            LAS float* CWf = (LAS float*)(F.lds + 118784); LAS float* SCf = (LAS float*)(F.lds + 117760); const int h = (ci0 >> 5) & 3;
            for (int e = F.tid; e < 4 * 384; e += NWAVES * 64) { const int i = e / 384, q = e % 384; CWf[e] = F.a->in[18][i * QKV + (q >> 7) * 512 + h * 128 + (q & 127)]; }
            if (F.wave >= 4) { d1_prefetch_tile(F, ci0, rv); if (F.wave == 4) d1_scalars(F, ci0, SCf); }
        }
        _Pragma("unroll 1") for (int ci = ci0; ci < 1024; ci += F.G) d1_unit(F, ci, ci + F.G, rv); } PHASE_END(6)
    PHASE_BEGIN(7) if (!(rep_ && (REP_SUB & 1))) { if (rep_) scan_phase<SCAN_ABL>(F); else scan_phase<0>(F); } if (!(rep_ && (REP_SUB & 2))) { sc_rows(F, 64); for (int u = (int)blockIdx.x - 64; u >= 0 && u < 4 * NS; u += F.G - 64) p8_sample_unit(F, u); } PHASE_END(7)
    PHASE_BEGIN(8) if (!(rep_ && (REP_SUB & 1))) { if (rep_) d3_phase<D3_ABL>(F); else d3_phase<0>(F); } if (!(rep_ && (REP_SUB & 2))) { LDS_WAIT(); __syncthreads(); convert_items(F, CV_W2U, CV_END, F.vcu * NWAVES + F.wave, F.G * NWAVES); } PHASE_END(8)
    PHASE_BEGIN(9)
        pg8::StaticOrder S; S.init(MP, D, F.G, (int)blockIdx.x);
        pg8::EpiFp8P E{(unsigned char*)Yb, D};
#if F8_WOUT
        { pg8::Gemm g{XM, (const bf16*)(F.ws + WS_WOUT), MP, D, D / 2};
          pg8::gemm_phase<pg8::EpiFp8P, pg8::StaticOrder, true, true, 127 - F8_WO_SH + Y8_SH>(F.lds + RING_OFF, g, S, E); }
        sample_gemm8s<D>(F, (const unsigned char*)XM + (size_t)MP * D, F.ws + WS_WOUT, (bf16*)((unsigned char*)Yb + (size_t)MP * D), 127 - F8_WO_SH + Y8_SH); PHASE_END(9)
#else
        { pg8::Gemm g{XM, (const bf16*)(F.ws + WS_WOUT), MP, D, D};
          pg8::gemm_phase<pg8::EpiBf16P, pg8::StaticOrder, true, true>(F.lds + RING_OFF, g, S, E); }
        sample_gemm<D>(F, XM + (size_t)MP * D, (const bf16*)(F.ws + WS_WOUT), Yb + (size_t)MP * D); PHASE_END(9)
#endif
    PHASE_BEGIN(10) ln_pass<1>(F, 1.0f); PHASE_END(10)
    PHASE_BEGIN(11)
        pg8::StaticOrder S; S.init(M, NUP, F.G, (int)blockIdx.x);
#if F8_FFN2
        { pg8::Gemm g{XM, (const bf16*)(F.ws + WS_W2U), M, NUP, D / 2}; pg8::EpiSwiglu8 E{(unsigned char*)HB, FF};
          pg8::gemm_phase<pg8::EpiSwiglu8, pg8::StaticOrder, GEMM_ALIGN, GEMM_SP2, 127 - F8_UP_SH>(F.lds + RING_OFF, g, S, E); } PHASE_END(11)
#else
        { pg8::Gemm g{XM, (const bf16*)(F.ws + WS_W2U), M, NUP, D}; pg8::EpiSwiglu E{HB, FF};
          pg8::gemm_phase<pg8::EpiSwiglu, pg8::StaticOrder, GEMM_ALIGN, GEMM_SP2>(F.lds + RING_OFF, g, S, E); } PHASE_END(11)
#endif
    PHASE_BEGIN(12)
        pg8::StaticOrder S; S.init(MP, D, F.G, (int)blockIdx.x);
        pg8::EpiFp8P E{(unsigned char*)Yb, D};
#if F8_FFN2
        { pg8::Gemm g{HB, (const bf16*)(F.ws + WS_W2D), MP, D, FF / 2};
          pg8::gemm_phase<pg8::EpiFp8P, pg8::StaticOrder, true, true, 127 - F8_DN_SH + Y8_SH>(F.lds + RING_OFF, g, S, E); }
        sample_gemm8s<FF>(F, (const unsigned char*)HB + (size_t)MP * FF, F.ws + WS_W2D, (bf16*)((unsigned char*)Yb + (size_t)MP * D), 127 - F8_DN_SH + Y8_SH);
        PHASE_END(12)
#else
        { pg8::Gemm g{HB, (const bf16*)(F.ws + WS_W2D), MP, D, FF};
          pg8::gemm_phase<pg8::EpiBf16P, pg8::StaticOrder, true, true>(F.lds + RING_OFF, g, S, E); }
        sample_gemm<FF>(F, HB + (size_t)MP * FF, (const bf16*)(F.ws + WS_W2D), Yb + (size_t)MP * D); PHASE_END(12)
#endif
    PHASE_BEGIN(13) ln_pass<2>(F, 0.5f); PHASE_END(13)
#undef IN
#undef SEAM
}
extern "C" void kernel_launch(void* const* d_in, const int* in_sizes, int n_in, void* d_out, int out_size, void* d_ws, size_t ws_size, hipStream_t stream) {
    static int ok = 0;
    if (ok == 0) {
        int dev = 0, cus = 0;
        if (n_in != 24 || out_size != (int)O_END || ws_size < WS_END || hipGetDevice(&dev) != hipSuccess || hipDeviceGetAttribute(&cus, hipDeviceAttributeMultiprocessorCount, dev) != hipSuccess || cus < 256 ||
            hipFuncSetAttribute((const void*)mk_fwd, hipFuncAttributeMaxDynamicSharedMemorySize, LDS_BYTES) != hipSuccess) {
            fprintf(stderr, "kernel_launch: unexpected problem/device (n_in %d out %d ws %zu cus %d); nothing launched\n", n_in, out_size, ws_size, cus); ok = -1; return; }
        ok = 1;
    }
    if (ok < 0) return;
    (void)hipMemsetAsync((char*)d_ws + WS_CTL, 0, CTL_ZERO_BYTES, stream);
    Args a{};
    for (int i = 0; i < 24; ++i) a.in[i] = (const float*)d_in[i];
    a.out = (float*)d_out; a.ws = (unsigned char*)d_ws; a.ph_lo = 0; a.ph_hi = N_PHASES;
    hipLaunchKernelGGL(mk_fwd, dim3(256), dim3(NWAVES * 64), LDS_BYTES, stream, a);
}
```
